# Optimizing an MI355X kernel written in HIP

```python
import math
import numpy as np
import jax, jax.numpy as jnp
from jax import lax

D_MODEL = 2048
BATCH = 2
SEQ = 8192
DEPTH = 1

F32 = jnp.float32
D_MIX = D_MODEL
SSM_WIDTH = D_MIX // 2
SSM_CH_PER_GROUP = 16
SSM_GROUPS = SSM_WIDTH // SSM_CH_PER_GROUP
SSM_STATE = 64
DT_MIN = 1e-3
DT_MAX = 1e-1
NSA_HEADS = 16
NSA_KV_HEADS = 2
HEAD_DIM = 64
Q_PER_KV = NSA_HEADS // NSA_KV_HEADS
NSA_WIDTH = NSA_HEADS * HEAD_DIM
KV_WIDTH = NSA_KV_HEADS * HEAD_DIM
N_BRANCH = 3
IN_COLS = SSM_WIDTH + NSA_WIDTH + 6 * KV_WIDTH + NSA_HEADS * N_BRANCH
CMP_BLOCK = 32
CMP_STRIDE = 16
CMP_HIDDEN = 128
SEL_BLOCK = 64
SEL_TOPK = 16
WINDOW = 512
Q_BLOCK = 128
ROPE_THETA = 10000.0
N_EXPERTS = 64
TOP_K = 8
N_EXPERT_GROUPS = 8
TOPK_GROUPS = 4
EXPERT_FF = 512
SHARED_FF = 512
ROUTED_SCALE = 2.5
MOE_BLOCK = 128
DEEPNORM_ALPHA = (2.0 * DEPTH) ** 0.25
DEEPNORM_BETA = (8.0 * DEPTH) ** -0.25
LN_EPS = 1e-5
NEG = -1e30
FORCE = 1e4

kernel_name = 'hymba_s5_nsa_moe_deepnorm'


def layer_norm(x, g, b):
    xf = x.astype(F32)
    mu = jnp.mean(xf, -1, keepdims=True)
    var = jnp.mean(jnp.square(xf - mu), -1, keepdims=True)
    return ((xf - mu) * lax.rsqrt(var + LN_EPS) * g.astype(F32) + b.astype(F32)).astype(x.dtype)


def rope(x, pos):
    half = HEAD_DIM // 2
    inv = ROPE_THETA ** (-jnp.arange(half, dtype=F32) / half)
    ang = pos[..., None, None] * inv
    cos, sin = jnp.cos(ang), jnp.sin(ang)
    xf = x.astype(F32)
    x1, x2 = xf[..., :half], xf[..., half:]
    return jnp.concatenate([x1 * cos - x2 * sin, x2 * cos + x1 * sin], -1).astype(x.dtype)


def s5_mixer(u, lam_re, lam_im, log_dt, b_re, b_im, c_re, c_im, d_skip, w_glu):
    bsz, L, _ = u.shape
    uf = u.astype(F32).reshape(bsz, L, SSM_GROUPS, SSM_CH_PER_GROUP)
    lr, li = lam_re.astype(F32), lam_im.astype(F32)
    dt = jnp.exp(log_dt.astype(F32))[:, None]
    mag = jnp.exp(lr * dt)
    ar, ai = mag * jnp.cos(li * dt), mag * jnp.sin(li * dt)
    zr, zi = ar - 1.0, ai
    den = lr * lr + li * li
    fr, fi = (zr * lr + zi * li) / den, (zi * lr - zr * li) / den
    br_, bi_ = b_re.astype(F32), b_im.astype(F32)
    bbr = fr[..., None] * br_ - fi[..., None] * bi_
    bbi = fr[..., None] * bi_ + fi[..., None] * br_
    xr = jnp.einsum('blgh,gph->lbgp', uf, bbr)
    xi = jnp.einsum('blgh,gph->lbgp', uf, bbi)
    ar_t = jnp.broadcast_to(ar[None, None], (L, 1) + ar.shape)
    ai_t = jnp.broadcast_to(ai[None, None], (L, 1) + ai.shape)

    def combine(e1, e2):
        a1r, a1i, b1r, b1i = e1
        a2r, a2i, b2r, b2i = e2
        return (a1r * a2r - a1i * a2i, a1r * a2i + a1i * a2r,
                a2r * b1r - a2i * b1i + b2r, a2r * b1i + a2i * b1r + b2i)

    _, _, sr, si = lax.associative_scan(combine, (ar_t, ai_t, xr, xi), axis=0)
    y = jnp.einsum('lbgp,ghp->blgh', sr, c_re.astype(F32)) - jnp.einsum('lbgp,ghp->blgh', si, c_im.astype(F32))
    y = y + d_skip.astype(F32) * uf
    y = jax.nn.gelu(y.reshape(bsz, L, SSM_WIDTH).astype(u.dtype))
    return y * jax.nn.sigmoid(y @ w_glu)


def attend(scores, mask):
    s = jnp.where(mask, scores.astype(F32), NEG)
    return jax.nn.softmax(s, axis=-1) * mask


def nsa_mixer(q, k_cmp, v_cmp, k_sel, v_sel, k_win, v_win, gate_logits, positions,
              cmp_pos_k, cmp_pos_v, w_cmp_k1, w_cmp_k2, w_cmp_v1, w_cmp_v2):
    bsz, L = q.shape[:2]
    pos = positions.astype(F32)
    n_cmp = (L - CMP_BLOCK) // CMP_STRIDE + 1
    n_sel = L // SEL_BLOCK
    topk = min(SEL_TOPK, n_sel)
    n_qblk = L // Q_BLOCK
    scale = HEAD_DIM ** -0.5
    cidx = np.arange(n_cmp)[:, None] * CMP_STRIDE + np.arange(CMP_BLOCK)[None, :]

    def compress(kv, pe, w1, w2):
        blk = kv[:, cidx] + pe[:, None, :]
        blk = jnp.moveaxis(blk, 3, 2).reshape(bsz, n_cmp, NSA_KV_HEADS, CMP_BLOCK * HEAD_DIM)
        return jax.nn.gelu(blk @ w1) @ w2

    kc = rope(compress(k_cmp, cmp_pos_k, w_cmp_k1, w_cmp_k2), jnp.mean(pos[:, cidx], -1))
    vc = compress(v_cmp, cmp_pos_v, w_cmp_v1, w_cmp_v2)
    q = rope(q, pos)
    ks_t = jnp.transpose(rope(k_sel, pos), (0, 2, 1, 3))
    vs_t = jnp.transpose(v_sel, (0, 2, 1, 3))
    pad = ((0, 0), (WINDOW, 0), (0, 0), (0, 0))
    kw_p = jnp.pad(rope(k_win, pos), pad)
    vw_p = jnp.pad(v_win, pad)

    cs = np.arange(n_cmp) * CMP_STRIDE
    ce = cs + CMP_BLOCK - 1
    ss = np.arange(n_sel) * SEL_BLOCK
    se = ss + SEL_BLOCK - 1
    overlap = jnp.asarray(((cs[:, None] <= se[None, :]) & (ce[:, None] >= ss[None, :])).astype(np.float32))
    cmp_end = jnp.asarray(ce)
    sel_start = jnp.asarray(ss)
    blk_ids = jnp.arange(n_sel)
    b_ix = jnp.arange(bsz)[:, None, None]
    h_ix = jnp.arange(NSA_KV_HEADS)[None, :, None]

    q_blk = jnp.moveaxis(q.reshape(bsz, n_qblk, Q_BLOCK, NSA_KV_HEADS, Q_PER_KV, HEAD_DIM), 1, 0)
    gates = jax.nn.sigmoid(gate_logits)
    g_blk = jnp.moveaxis(gates.reshape(bsz, n_qblk, Q_BLOCK, NSA_KV_HEADS, Q_PER_KV, N_BRANCH), 1, 0)

    def block_fn(args):
        qi, qb, gb = args
        t = qi * Q_BLOCK + jnp.arange(Q_BLOCK)
        s_c = jnp.einsum('bqkgd,bnkd->bkgqn', qb, kc) * scale
        p_c = attend(s_c, cmp_end[None, :] <= t[:, None])
        o_c = jnp.einsum('bkgqn,bnkd->bqkgd', p_c.astype(vc.dtype), vc)
        imp = jnp.einsum('bkgqn,ns->bkqs', p_c, overlap)
        cur = t // SEL_BLOCK
        forced = (blk_ids[None, :] == 0) | (blk_ids[None, :] == cur[:, None]) | (blk_ids[None, :] == cur[:, None] - 1)
        valid = sel_start[None, :] <= t[:, None]
        score = jnp.where(forced, FORCE, jnp.where(valid, imp, -1.0))
        _, sel = lax.top_k(score, topk)
        tok = (sel[..., None] * SEL_BLOCK + jnp.arange(SEL_BLOCK)).reshape(bsz, NSA_KV_HEADS, Q_BLOCK * topk * SEL_BLOCK)
        kg = ks_t[b_ix, h_ix, tok].reshape(bsz, NSA_KV_HEADS, Q_BLOCK, topk * SEL_BLOCK, HEAD_DIM)
        vg = vs_t[b_ix, h_ix, tok].reshape(bsz, NSA_KV_HEADS, Q_BLOCK, topk * SEL_BLOCK, HEAD_DIM)
        tok = tok.reshape(bsz, NSA_KV_HEADS, Q_BLOCK, topk * SEL_BLOCK)
        s_s = jnp.einsum('bqkgd,bkqsd->bkgqs', qb, kg) * scale
        p_s = attend(s_s, (tok <= t[:, None])[:, :, None])
        o_s = jnp.einsum('bkgqs,bkqsd->bqkgd', p_s.astype(vg.dtype), vg)
        kwb = lax.dynamic_slice_in_dim(kw_p, qi * Q_BLOCK, Q_BLOCK + WINDOW, axis=1)
        vwb = lax.dynamic_slice_in_dim(vw_p, qi * Q_BLOCK, Q_BLOCK + WINDOW, axis=1)
        kpos = qi * Q_BLOCK - WINDOW + jnp.arange(Q_BLOCK + WINDOW)
        diff = t[:, None] - kpos[None, :]
        wmask = (diff >= 0) & (diff < WINDOW) & (kpos[None, :] >= 0)
        s_w = jnp.einsum('bqkgd,bskd->bkgqs', qb, kwb) * scale
        p_w = attend(s_w, wmask)
        o_w = jnp.einsum('bkgqs,bskd->bqkgd', p_w.astype(vwb.dtype), vwb)
        return gb[..., 0:1] * o_c + gb[..., 1:2] * o_s + gb[..., 2:3] * o_w

    out = lax.map(block_fn, (jnp.arange(n_qblk), q_blk, g_blk))
    return jnp.moveaxis(out, 0, 1).reshape(bsz, L, NSA_WIDTH)


def swiglu(x, wg, wu, wd):
    return (jax.nn.silu(x @ wg) * (x @ wu)) @ wd


def moe_ffn(x, w_router, router_bias, w_gate, w_up, w_down, ws_gate, ws_up, ws_down):
    bsz, L, d = x.shape
    xt = x.reshape(-1, d)
    n_tok = xt.shape[0]
    affin = jax.nn.sigmoid((xt @ w_router).astype(F32))
    biased = affin + router_bias.astype(F32)
    grp = biased.reshape(n_tok, N_EXPERT_GROUPS, N_EXPERTS // N_EXPERT_GROUPS)
    grp_score = jnp.sum(lax.top_k(grp, 2)[0], -1)
    _, gsel = lax.top_k(grp_score, TOPK_GROUPS)
    gmask = jnp.sum(jax.nn.one_hot(gsel, N_EXPERT_GROUPS, dtype=F32), 1)
    gmask = jnp.repeat(gmask, N_EXPERTS // N_EXPERT_GROUPS, axis=1) > 0
    _, eidx = lax.top_k(jnp.where(gmask, biased, NEG), TOP_K)
    w = jnp.take_along_axis(affin, eidx, axis=1)
    w = w / jnp.sum(w, -1, keepdims=True) * ROUTED_SCALE
    n_asg = n_tok * TOP_K
    flat_e = eidx.reshape(-1)
    order = jnp.argsort(flat_e)
    e_sorted = flat_e[order]
    tok_sorted = (order // TOP_K).astype(jnp.int32)
    w_sorted = w.reshape(-1)[order]
    counts = jnp.zeros(N_EXPERTS, jnp.int32).at[flat_e].add(1)
    padded = (counts + MOE_BLOCK - 1) // MOE_BLOCK * MOE_BLOCK
    pad_end = jnp.cumsum(padded)
    pad_start = pad_end - padded
    start = jnp.cumsum(counts) - counts
    dest = pad_start[e_sorted] + jnp.arange(n_asg) - start[e_sorted]
    n_blk = -(-(n_asg + N_EXPERTS * (MOE_BLOCK - 1)) // MOE_BLOCK)
    buf_tok = jnp.zeros(n_blk * MOE_BLOCK, jnp.int32).at[dest].set(tok_sorted).reshape(n_blk, MOE_BLOCK)
    buf_w = jnp.zeros(n_blk * MOE_BLOCK, F32).at[dest].set(w_sorted).reshape(n_blk, MOE_BLOCK)
    blk_exp = jnp.minimum(jnp.searchsorted(pad_end, jnp.arange(n_blk) * MOE_BLOCK, side='right'), N_EXPERTS - 1)

    def step(acc, args):
        e, tk, wk = args
        yb = swiglu(xt[tk], w_gate[e], w_up[e], w_down[e])
        return acc.at[tk].add(yb * wk[:, None].astype(yb.dtype)), None

    routed, _ = lax.scan(step, jnp.zeros_like(xt), (blk_exp, buf_tok, buf_w))
    shared = swiglu(xt, ws_gate, ws_up, ws_down)
    return (routed + shared).reshape(bsz, L, d)


def hybrid_layer(x, positions, w_in, lam_re, lam_im, log_dt, ssm_b_re, ssm_b_im, ssm_c_re, ssm_c_im, ssm_d,
                 w_glu, cmp_pos_k, cmp_pos_v, w_cmp_k1, w_cmp_k2, w_cmp_v1, w_cmp_v2, w_out, ln1_g, ln1_b,
                 w_router, router_bias, w_gate, w_up, w_down, ws_gate, ws_up, ws_down, ln2_g, ln2_b):
    bsz, L, _ = x.shape
    sizes = [SSM_WIDTH, NSA_WIDTH] + [KV_WIDTH] * 6 + [NSA_HEADS * N_BRANCH]
    offsets = tuple(int(o) for o in np.cumsum(sizes)[:-1])
    proj = x @ w_in
    u, q, k_c, v_c, k_s, v_s, k_w, v_w, g = jnp.split(proj, offsets, axis=-1)
    kv = lambda t: t.reshape(bsz, L, NSA_KV_HEADS, HEAD_DIM)
    y_ssm = s5_mixer(u, lam_re, lam_im, log_dt, ssm_b_re, ssm_b_im, ssm_c_re, ssm_c_im, ssm_d, w_glu)
    y_nsa = nsa_mixer(q.reshape(bsz, L, NSA_HEADS, HEAD_DIM), kv(k_c), kv(v_c), kv(k_s), kv(v_s), kv(k_w), kv(v_w),
                      g.reshape(bsz, L, NSA_HEADS, N_BRANCH), positions,
                      cmp_pos_k, cmp_pos_v, w_cmp_k1, w_cmp_k2, w_cmp_v1, w_cmp_v2)
    mix = jnp.concatenate([y_ssm, y_nsa], -1) @ w_out
    x = layer_norm(DEEPNORM_ALPHA * x + mix, ln1_g, ln1_b)
    ffn = moe_ffn(x, w_router, router_bias, w_gate, w_up, w_down, ws_gate, ws_up, ws_down)
    return layer_norm(DEEPNORM_ALPHA * x + ffn, ln2_g, ln2_b)


def setup_inputs(seed: int = 0) -> dict:
    key = jax.random.key(seed)
    keys = iter(jax.random.split(key, 48))

    def nrm(shape, scale):
        return scale * jax.random.normal(next(keys), (DEPTH,) + shape, F32)

    x = jax.random.normal(next(keys), (BATCH, SEQ, D_MODEL), F32)
    offs = jax.random.randint(next(keys), (BATCH, 1), 0, 1024, jnp.int32)
    positions = offs + jnp.arange(SEQ, dtype=jnp.int32)[None, :]
    n_idx = jnp.arange(SSM_STATE, dtype=F32)
    lam_re = -0.5 + nrm((SSM_GROUPS, SSM_STATE), 0.01)
    lam_im = jnp.broadcast_to(math.pi * n_idx, (DEPTH, SSM_GROUPS, SSM_STATE)) + nrm((SSM_GROUPS, SSM_STATE), 0.01)
    log_dt = jax.random.uniform(next(keys), (DEPTH, SSM_GROUPS), F32, math.log(DT_MIN), math.log(DT_MAX))
    return {
        'x': x,
        'positions': positions,
        'w_in': nrm((D_MODEL, IN_COLS), D_MODEL ** -0.5),
        'lam_re': lam_re,
        'lam_im': lam_im,
        'log_dt': log_dt,
        'ssm_b_re': nrm((SSM_GROUPS, SSM_STATE, SSM_CH_PER_GROUP), (2.0 * SSM_CH_PER_GROUP) ** -0.5),
        'ssm_b_im': nrm((SSM_GROUPS, SSM_STATE, SSM_CH_PER_GROUP), (2.0 * SSM_CH_PER_GROUP) ** -0.5),
        'ssm_c_re': nrm((SSM_GROUPS, SSM_CH_PER_GROUP, SSM_STATE), (2.0 * SSM_STATE) ** -0.5),
        'ssm_c_im': nrm((SSM_GROUPS, SSM_CH_PER_GROUP, SSM_STATE), (2.0 * SSM_STATE) ** -0.5),
        'ssm_d': nrm((SSM_GROUPS, SSM_CH_PER_GROUP), 1.0),
        'w_glu': nrm((SSM_WIDTH, SSM_WIDTH), SSM_WIDTH ** -0.5),
        'cmp_pos_k': nrm((CMP_BLOCK, HEAD_DIM), 0.02),
        'cmp_pos_v': nrm((CMP_BLOCK, HEAD_DIM), 0.02),
        'w_cmp_k1': nrm((CMP_BLOCK * HEAD_DIM, CMP_HIDDEN), (CMP_BLOCK * HEAD_DIM) ** -0.5),
        'w_cmp_k2': nrm((CMP_HIDDEN, HEAD_DIM), CMP_HIDDEN ** -0.5),
        'w_cmp_v1': nrm((CMP_BLOCK * HEAD_DIM, CMP_HIDDEN), (CMP_BLOCK * HEAD_DIM) ** -0.5),
        'w_cmp_v2': nrm((CMP_HIDDEN, HEAD_DIM), CMP_HIDDEN ** -0.5),
        'w_out': nrm((D_MIX, D_MODEL), DEEPNORM_BETA * D_MIX ** -0.5),
        'ln1_g': 1.0 + nrm((D_MODEL,), 0.01),
        'ln1_b': nrm((D_MODEL,), 0.01),
        'w_router': nrm((D_MODEL, N_EXPERTS), D_MODEL ** -0.5),
        'router_bias': nrm((N_EXPERTS,), 0.01),
        'w_gate': nrm((N_EXPERTS, D_MODEL, EXPERT_FF), D_MODEL ** -0.5),
        'w_up': nrm((N_EXPERTS, D_MODEL, EXPERT_FF), D_MODEL ** -0.5),
        'w_down': nrm((N_EXPERTS, EXPERT_FF, D_MODEL), DEEPNORM_BETA * EXPERT_FF ** -0.5),
        'ws_gate': nrm((D_MODEL, SHARED_FF), D_MODEL ** -0.5),
        'ws_up': nrm((D_MODEL, SHARED_FF), D_MODEL ** -0.5),
        'ws_down': nrm((SHARED_FF, D_MODEL), DEEPNORM_BETA * SHARED_FF ** -0.5),
        'ln2_g': 1.0 + nrm((D_MODEL,), 0.01),
        'ln2_b': nrm((D_MODEL,), 0.01),
    }


def reference(x, positions, w_in, lam_re, lam_im, log_dt, ssm_b_re, ssm_b_im, ssm_c_re, ssm_c_im, ssm_d,
              w_glu, cmp_pos_k, cmp_pos_v, w_cmp_k1, w_cmp_k2, w_cmp_v1, w_cmp_v2, w_out, ln1_g, ln1_b,
              w_router, router_bias, w_gate, w_up, w_down, ws_gate, ws_up, ws_down, ln2_g, ln2_b):
    params = (w_in, lam_re, lam_im, log_dt, ssm_b_re, ssm_b_im, ssm_c_re, ssm_c_im, ssm_d,
              w_glu, cmp_pos_k, cmp_pos_v, w_cmp_k1, w_cmp_k2, w_cmp_v1, w_cmp_v2, w_out, ln1_g, ln1_b,
              w_router, router_bias, w_gate, w_up, w_down, ws_gate, ws_up, ws_down, ln2_g, ln2_b)
    for layer in range(DEPTH):
        x = hybrid_layer(x, positions, *(p[layer] for p in params))
    return x
```

```cpp
#include <hip/hip_runtime.h>
#include <hip/hip_cooperative_groups.h>
#include <cstdio>
#include <cstdint>
namespace cg = cooperative_groups;

#define LAS __attribute__((address_space(3)))
#define GAS __attribute__((address_space(1)))
typedef unsigned short bf16_t;
typedef short bf16x8 __attribute__((ext_vector_type(8)));
typedef float f32x4 __attribute__((ext_vector_type(4)));
typedef float f32x2 __attribute__((ext_vector_type(2)));
typedef unsigned u32x4 __attribute__((ext_vector_type(4)));
typedef unsigned u32x2 __attribute__((ext_vector_type(2)));

constexpr int NTHREADS = 512, NWAVES = 8;
constexpr int NB = 2, SEQ = 8192, T_TOK = NB * SEQ, DM = 2048;
constexpr int IN_COLS = 2864, PROJ_LD = 3072;
constexpr int SSM_W = 1024, NGRP = 64, NSTATE = 64;
constexpr int NHEAD = 16, NKVH = 2, HD = 64;
constexpr int COL_Q = 1024, COL_KC = 2048, COL_VC = 2176, COL_KS = 2304, COL_VS = 2432, COL_KW = 2560, COL_VW = 2688, COL_G = 2816;
constexpr int NCMP = 511, NSEL = 128, TOPK_SEL = 16, WINDOW = 512;
constexpr int NEXP = 64, TOPK_E = 8, EFF = 512, LISTCAP = T_TOK;
constexpr int NEXPS = NEXP + 1, NSLOT = TOPK_E + 1;
constexpr float ALPHA = 1.189207115002721f;
constexpr float LN_EPS = 1e-5f;
constexpr int S5_SEG = 256, S5_NSEG = SEQ / S5_SEG;

constexpr size_t MiB = 1ull << 20;
constexpr size_t OFF_CTL = 0;
constexpr size_t OFF_S5A = 1 * MiB;
constexpr size_t OFF_S5AC = OFF_S5A + 64 * 1024;
constexpr size_t OFF_S5BB = OFF_S5AC + 64 * 1024;
constexpr size_t OFF_S5CF = 2 * MiB;
constexpr size_t OFF_CBIAS = OFF_S5CF + 256 * 1024;
constexpr size_t OFF_WRT = 2 * MiB + 512 * 1024;
constexpr size_t OFF_KC = 3 * MiB;
constexpr size_t OFF_VCT = OFF_KC + 256 * 1024;
constexpr size_t OFF_SEL = 4 * MiB;
constexpr size_t OFF_E = 6 * MiB;
constexpr size_t OFF_LOGITS = 14 * MiB;
constexpr size_t OFF_LTOK = 14 * MiB;
constexpr size_t OFF_LW = 19 * MiB;
constexpr size_t OFF_LSLOT = 24 * MiB;
constexpr size_t OFF_LROW = 6 * MiB;
constexpr size_t OFF_WEDT = 30 * MiB;
constexpr size_t OFF_WSDT = 158 * MiB;
constexpr size_t OFF_X1 = 160 * MiB;
constexpr size_t OFF_X1B = 95 * MiB;
constexpr size_t OFF_HS = 288 * MiB;
constexpr size_t OFF_H = 304 * MiB;
constexpr size_t OFF_X1Q = 400 * MiB;
constexpr size_t OFF_YGELU = 304 * MiB;
constexpr size_t OFF_MIXIN = 336 * MiB;
constexpr size_t OFF_YSLOT = 433 * MiB;
constexpr size_t OFF_WEUPT = 433 * MiB;
constexpr size_t OFF_WINT = 689 * MiB;
constexpr size_t OFF_WGLUT = 701 * MiB;
constexpr size_t OFF_WOUTT = 703 * MiB;
constexpr size_t OFF_WSUPT = 711 * MiB;
constexpr size_t OFF_WC1T = 716 * MiB;
constexpr size_t OFF_SLOT64 = 717 * MiB;
constexpr size_t OFF_PROJ = 781 * MiB;
constexpr size_t OFF_QR = 877 * MiB;
constexpr size_t OFF_KSEL = 909 * MiB;
constexpr size_t OFF_VSELT = 913 * MiB;
constexpr size_t OFF_KWIN = 917 * MiB;
constexpr size_t OFF_VWINT = 921 * MiB;
constexpr size_t OFF_GATES = 925 * MiB;
constexpr size_t OFF_Q8 = 928 * MiB;
constexpr size_t OFF_XB = 945 * MiB;
constexpr size_t OFF_X8 = 877 * MiB;
constexpr size_t WS_NEED = 1009 * MiB;

constexpr int LDS_BYTES = 163840;

struct Params {
    const float* in[31];
    float* out;
    unsigned char* ws;
    size_t ws_size;
};

__device__ __forceinline__ int opq(int i) { asm volatile("" : "+s"(i)); return i; }
__device__ __forceinline__ unsigned char* opqp(unsigned char* q) { unsigned long long v = (unsigned long long)q; asm volatile("" : "+s"(v)); return (unsigned char*)(GAS unsigned char*)v; }
__device__ __forceinline__ int opqv(int v) { asm volatile("" : "+v"(v)); return v; }
__device__ __forceinline__ unsigned char* opqf(unsigned char* q) { unsigned long long v = (unsigned long long)q; asm volatile("" : "+s"(v)); return (unsigned char*)v; }
#define INP(i) (p.in[opq(i)])
__device__ __forceinline__ unsigned f2bf(float f) { unsigned u = __builtin_bit_cast(unsigned, f); return (u + 0x7fffu + ((u >> 16) & 1u)) >> 16; }
typedef __bf16 bf16x2_t __attribute__((ext_vector_type(2)));
__device__ __forceinline__ unsigned cvt_pk_bf16(float lo, float hi) { const f32x2 v = {lo, hi}; const bf16x2_t b = __builtin_convertvector(v, bf16x2_t); return __builtin_bit_cast(unsigned, b); }
__device__ __forceinline__ unsigned pk2(float lo, float hi) { return cvt_pk_bf16(lo, hi); }
__device__ __forceinline__ float bf2f(unsigned b) { return __builtin_bit_cast(float, b << 16); }
__device__ __forceinline__ float bflo(unsigned w) { return __builtin_bit_cast(float, w << 16); }
__device__ __forceinline__ float bfhi(unsigned w) { return __builtin_bit_cast(float, w & 0xffff0000u); }
__device__ __forceinline__ void swap16(float& a, float& b) { asm volatile("s_nop 1\n\tv_permlane16_swap_b32 %0, %1" : "+v"(a), "+v"(b)); }
__device__ __forceinline__ void swap32(float& a, float& b) { asm volatile("s_nop 1\n\tv_permlane32_swap_b32 %0, %1" : "+v"(a), "+v"(b)); }
__device__ __forceinline__ float wave_sum(float v) {
#pragma unroll
    for (int o = 1; o < 64; o <<= 1) v += __shfl_xor(v, o);
    return v;
}
__device__ __forceinline__ float gelu_tanh(float x) {
    const float z = 0.7978845608028654f * (x + 0.044715f * x * x * x);
    const float e = __expf(2.f * z);
    const float th = 1.f - 2.f * __builtin_amdgcn_rcpf(e + 1.f);
    return 0.5f * x * (1.f + th);
}
__device__ __forceinline__ unsigned pk4_fp8(float a, float b, float c2, float d) { unsigned w = 0; w = __builtin_amdgcn_cvt_pk_fp8_f32(a, b, w, false); w = __builtin_amdgcn_cvt_pk_fp8_f32(c2, d, w, true); return w; }
constexpr float W8_SCALE = 256.f, H8_SCALE = 8.f, SLOT_SCALE = 64.f, MIX8_SCALE = 8.f;
__device__ __forceinline__ float sigmoidf_(float x) { return __builtin_amdgcn_rcpf(1.f + __expf(-x)); }
#define LDS_WAIT() asm volatile("s_waitcnt lgkmcnt(0)" ::: "memory")
#define GAS __attribute__((address_space(1)))
#define XB_TMO      128
#define XB_XCNT(j)  (256  + 64 * (j))
#define XB_XSUB(j)  (1280 + 64 * (j))
#define XB_XGEN(j)  (2304 + 64 * (j))
#define XB_TOP      3328
#define XB_TOPGEN   3392
#define XCD_BAR_WORDS 3456
#define XB_SPIN_CAP (1u << 18)

__device__ __forceinline__ unsigned xb_ld(unsigned* p)              { return __hip_atomic_load(p, __ATOMIC_RELAXED, __HIP_MEMORY_SCOPE_AGENT); }
__device__ __forceinline__ unsigned xb_add(unsigned* p, unsigned v) { return __hip_atomic_fetch_add(p, v, __ATOMIC_RELAXED, __HIP_MEMORY_SCOPE_AGENT); }
__device__ __forceinline__ unsigned xb_xcc_id() { return (unsigned)__builtin_amdgcn_s_getreg((3 << 11) | 20) & 0xFu; }
#define XB_SPIN(cond, bar) do { unsigned _sp = 0; while (cond) { __builtin_amdgcn_s_sleep(1); \
    if ((++_sp & 255u) == 0u) { if (xb_ld(&(bar)[XB_TMO])) break; if (_sp > XB_SPIN_CAP) { atomicAdd(&(bar)[XB_TMO], 1u); break; } } } } while (0)

struct XcdBarrier {
    unsigned* bar; unsigned x;
    volatile LAS unsigned* st;
};

__device__ __forceinline__ XcdBarrier xcd_barrier_post(unsigned* bar, volatile LAS unsigned* st) {
    XcdBarrier b; b.bar = bar; b.x = xb_xcc_id(); b.st = st;
    if (threadIdx.x == 0) (void)xb_add(&bar[XB_XCNT(b.x)], 1u);
    return b;
}
__device__ __forceinline__ void xcd_barrier_complete(unsigned* bar, unsigned x, unsigned& nloc, unsigned& nx) {
    const unsigned G = gridDim.x * gridDim.y * gridDim.z;
    unsigned sum, cnt, mine, sp = 0u;
    for (;;) {
        sum = 0u; cnt = 0u; mine = 0u;
#pragma unroll
        for (unsigned j = 0; j < 16; ++j) { const unsigned c = xb_ld(&bar[XB_XCNT(j)]); sum += c; cnt += (c > 0u) ? 1u : 0u; mine = (j == x) ? c : mine; }
        if (sum == G) break;
        __builtin_amdgcn_s_sleep(1);
        if ((++sp & 255u) == 0u) { if (xb_ld(&bar[XB_TMO])) break; if (sp > XB_SPIN_CAP) { atomicAdd(&bar[XB_TMO], 1u); break; } }
    }
    nloc = mine > 0u ? mine : 1u; nx = cnt > 0u ? cnt : 1u;
}

__device__ __forceinline__ void xcd_barrier(const XcdBarrier& b) {
    asm volatile("s_waitcnt vmcnt(0)" ::: "memory");
    __syncthreads();
    if (threadIdx.x == 0) {
        unsigned* bar = b.bar;
        __builtin_amdgcn_s_waitcnt(0);
        unsigned nloc = b.st[0], nx = b.st[1];
        if (nloc == 0u) { xcd_barrier_complete(bar, b.x, nloc, nx); b.st[0] = nloc; b.st[1] = nx; }
        const unsigned old = xb_add(&bar[XB_XSUB(b.x)], 1u);
        const unsigned gen = old / nloc;
        if (old + 1u == (gen + 1u) * nloc) {
            __builtin_amdgcn_fence(__ATOMIC_RELEASE, "agent");
            asm volatile("s_waitcnt vmcnt(0)" ::: "memory");
            const unsigned og = xb_add(&bar[XB_TOP], 1u);
            const unsigned tg = og / nx;
            if (og + 1u == (tg + 1u) * nx) xb_add(&bar[XB_TOPGEN], 1u);
            else XB_SPIN(xb_ld(&bar[XB_TOPGEN]) == tg, bar);
            __builtin_amdgcn_fence(__ATOMIC_ACQUIRE, "agent");
            xb_add(&bar[XB_XGEN(b.x)], 1u);
            asm volatile("s_waitcnt vmcnt(0)" ::: "memory");
        } else {
            XB_SPIN(xb_ld(&bar[XB_XGEN(b.x)]) == gen, bar);
            __builtin_amdgcn_fence(__ATOMIC_ACQUIRE, "agent");
            asm volatile("s_waitcnt vmcnt(0)" ::: "memory");
        }
    }
    __syncthreads();
}

namespace pg8 {
#define PG8_LAS __attribute__((address_space(3)))
constexpr int BM = 256, BK = 64, HALF = 128, HTB = HALF * BK * 2  , STAGE_BYTES = 8 * HTB;

__host__ __device__ __forceinline__ int lds_byte(int r, int c) { const int st = (r >> 4) * 2 + (c >> 5), rr = r & 15, cc = c & 31, ob = rr * 64 + cc * 2; return st * 1024 + (ob ^ (((ob >> 9) & 1) << 5)); }
__host__ __device__ __forceinline__ void stage_rc(int b, int& R, int& C) { const int st = b / 1024, sb = b % 1024, swz = sb ^ (((sb >> 9) & 1) << 5); R = (st >> 1) * 16 + swz / 64; C = (st & 1) * 32 + (swz % 64) / 2; }
__host__ __device__ __forceinline__ int perm32(int rho) { const int n = rho >> 4, i = rho & 15; return 8 * (i >> 2) + 4 * n + (i & 3); }

struct Unit { int pm, pn; const char* bB; int e, nvalid, rowbase; };
struct Gemm { const char* A; };

typedef int v8i_t __attribute__((ext_vector_type(8)));
typedef int v4i_t __attribute__((ext_vector_type(4)));
__device__ __forceinline__ v8i_t cat8(const bf16x8 lo, const bf16x8 hi) { const v4i_t a = __builtin_bit_cast(v4i_t, lo), b = __builtin_bit_cast(v4i_t, hi); return __builtin_shufflevector(a, b, 0, 1, 2, 3, 4, 5, 6, 7); }
template <int K, int KSTEPA, bool FP8 = false, bool ALIGN = true, class Epi, class Sched>
__device__ __forceinline__ void gemm_phase(PG8_LAS unsigned char* lds, const Gemm g, const Sched& S, const Epi& E) {
    const int tid = opqv(threadIdx.x), wid = __builtin_amdgcn_readfirstlane(tid >> 6), lane = tid & 63, wr = wid >> 2, wc = wid & 3, fr = lane & 15, fq = lane >> 4;
    constexpr int nt = K / BK;
    constexpr int PERMI = (int)Epi::PERM;
    unsigned voffB[2], voffB1[2];
#pragma unroll
    for (int i = 0; i < 2; ++i) { int R, C; stage_rc(tid * 16 + i * 8192, R, C);
        if constexpr (PERMI == 2) { const int w0 = 64 * (R >> 5) + 16 * ((R & 15) >> 2) + 4 * ((R >> 4) & 1) + (R & 3); voffB[i] = (unsigned)(w0 * K + C) * 2u; voffB1[i] = (unsigned)((w0 + 8) * K + C) * 2u; }
        else { const int Rb = PERMI == 1 ? ((R & ~31) + perm32(R & 31)) : R; voffB[i] = (unsigned)(Rb * K + C) * 2u; voffB1[i] = voffB[i]; } }
#define PG8_AOFF2T(U, h, par, o0, o1) do { int R0_, C0_, R1_, C1_; const int t_ = opqv(tid); stage_rc(t_ * 16, R0_, C0_); stage_rc(t_ * 16 + 8192, R1_, C1_); o0 = (unsigned)opqv((int)S.a_off_tab(U, h, R0_, C0_, par, lds)); o1 = (unsigned)opqv((int)S.a_off_tab(U, h, R1_, C1_, par, lds)); } while (0)
#define PG8_AOFF2(U, h, o0, o1) do { int R0_, C0_, R1_, C1_; const int t_ = opqv(tid); stage_rc(t_ * 16, R0_, C0_); stage_rc(t_ * 16 + 8192, R1_, C1_); o0 = (unsigned)opqv((int)S.a_off(U, h, R0_, C0_)); o1 = (unsigned)opqv((int)S.a_off(U, h, R1_, C1_)); } while (0)
#define PG8_AOFFS(U, o00, o01, o10, o11) do { int R0_, C0_, R1_, C1_; const int t_ = opqv(tid); stage_rc(t_ * 16, R0_, C0_); stage_rc(t_ * 16 + 8192, R1_, C1_); \
        o00 = (unsigned)opqv((int)S.a_off(U, 0, R0_, C0_)); o01 = (unsigned)opqv((int)S.a_off(U, 0, R1_, C1_)); o10 = (unsigned)opqv((int)S.a_off(U, 1, R0_, C0_)); o11 = (unsigned)opqv((int)S.a_off(U, 1, R1_, C1_)); } while (0)
    constexpr size_t kstepA = (size_t)KSTEPA;
    const size_t kstep = (size_t)(BK * 2);
    const size_t hstep = (size_t)HALF * K * 2;
    const size_t hstepB = PERMI == 2 ? (size_t)0 : hstep;
    const unsigned ldsw = (unsigned)wid * 1024u;
    const int aoff = lds_byte(wr * 64 + fr, fq * 8), boff = lds_byte(wc * 32 + fr, fq * 8);
#define PG8_SA(b, h) (((b) * 2 + (h)) * HTB)
#define PG8_SB(b, h) ((4 + (b) * 2 + (h)) * HTB)
#define PG8_STAGE(bufoff, gbase, voff) do { _Pragma("unroll") for (int _i = 0; _i < 2; ++_i) \
        __builtin_amdgcn_global_load_lds((const unsigned*)((const char*)(gbase) + (voff)[_i]), (PG8_LAS unsigned*)(lds + (bufoff) + ldsw + _i * 8192), 16, 0, 0); } while (0)
#define PG8_STAGEA(bufoff, o0, o1, kb) do { \
        __builtin_amdgcn_global_load_lds((const unsigned*)(g.A + (kb) + (o0)), (PG8_LAS unsigned*)(lds + (bufoff) + ldsw), 16, 0, 0); \
        __builtin_amdgcn_global_load_lds((const unsigned*)(g.A + (kb) + (o1)), (PG8_LAS unsigned*)(lds + (bufoff) + ldsw + 8192), 16, 0, 0); } while (0)
#define PG8_LDA8(dst, b, h) do { _Pragma("unroll") for (int m = 0; m < 4; ++m) dst[m] = cat8(*(const PG8_LAS bf16x8*)(lds + PG8_SA(b, h) + aoff + m * 2048), *(const PG8_LAS bf16x8*)(lds + PG8_SA(b, h) + aoff + m * 2048 + 1024)); } while (0)
#define PG8_LDB8(dst, b, h) do { _Pragma("unroll") for (int n = 0; n < 2; ++n) dst[n] = cat8(*(const PG8_LAS bf16x8*)(lds + PG8_SB(b, h) + boff + n * 2048), *(const PG8_LAS bf16x8*)(lds + PG8_SB(b, h) + boff + n * 2048 + 1024)); } while (0)
#define PG8_LDA_(dst, dst8, b, h) do { if constexpr (FP8) PG8_LDA8(dst8, b, h); else PG8_LDA(dst, b, h); } while (0)
#define PG8_LDB_(dst, dst8, b, h) do { if constexpr (FP8) PG8_LDB8(dst8, b, h); else PG8_LDB(dst, b, h); } while (0)
#define PG8_LDA(dst, b, h) do { _Pragma("unroll") for (int m = 0; m < 4; ++m) _Pragma("unroll") for (int k = 0; k < 2; ++k) dst[m][k] = *(const PG8_LAS bf16x8*)(lds + PG8_SA(b, h) + aoff + m * 2048 + k * 1024); } while (0)
#define PG8_LDB(dst, b, h) do { _Pragma("unroll") for (int n = 0; n < 2; ++n) _Pragma("unroll") for (int k = 0; k < 2; ++k) dst[n][k] = *(const PG8_LAS bf16x8*)(lds + PG8_SB(b, h) + boff + n * 2048 + k * 1024); } while (0)
#define PG8_MMA(ai, bj, At, Bt) do { __builtin_amdgcn_s_setprio(1); if constexpr (FP8) { _Pragma("unroll") for (int m = 0; m < 4; ++m) _Pragma("unroll") for (int n = 0; n < 2; ++n) \
        acc[ai][bj][m][n] = __builtin_amdgcn_mfma_scale_f32_16x16x128_f8f6f4(Bt##8[n], At##8[m], acc[ai][bj][m][n], 0, 0, 0, 0x7f7f7f7f, 0, 0x7f7f7f7f); } else { \
        _Pragma("unroll") for (int m = 0; m < 4; ++m) _Pragma("unroll") for (int n = 0; n < 2; ++n) _Pragma("unroll") for (int k = 0; k < 2; ++k) \
        acc[ai][bj][m][n] = __builtin_amdgcn_mfma_f32_16x16x32_bf16(Bt[n][k], At[m][k], acc[ai][bj][m][n], 0, 0, 0); } __builtin_amdgcn_s_setprio(0); } while (0)
#define PG8_WAIT_V(n) asm volatile("s_waitcnt vmcnt(" #n ")" ::: "memory")
#define PG8_WAIT_L(n) asm volatile("s_waitcnt lgkmcnt(" #n ")" ::: "memory")
#define PG8_BAR __builtin_amdgcn_s_barrier()
#define PG8_SCHED __builtin_amdgcn_sched_barrier(0)
#define PG8_SCHED8 do { if constexpr (FP8) __builtin_amdgcn_sched_barrier(0); } while (0)
#define PG8_PIN(ai) do { if constexpr (FP8) { _Pragma("unroll") for (int bj_ = 0; bj_ < 2; ++bj_) _Pragma("unroll") for (int m_ = 0; m_ < 4; ++m_) _Pragma("unroll") for (int n_ = 0; n_ < 2; ++n_) asm volatile("" : "+v"(acc[ai][bj_][m_][n_])); } } while (0)
    Unit cur, nxt; int ui = 0;
    if (!S.next(0, cur)) return;
    f32x4 acc[2][2][4][2];
#pragma unroll
    for (int a = 0; a < 2; ++a)
#pragma unroll
        for (int b = 0; b < 2; ++b)
#pragma unroll
            for (int m = 0; m < 4; ++m)
#pragma unroll
                for (int n = 0; n < 2; ++n) acc[a][b][m][n] = (f32x4){0.f, 0.f, 0.f, 0.f};
    bf16x8 At[4][2], B0[2][2], B1[2][2]; v8i_t At8[4], B08[2], B18[2];
    unsigned ca00, ca01, ca10, ca11; PG8_AOFFS(cur, ca00, ca01, ca10, ca11);
    const char* cB = cur.bB;
    PG8_STAGE(PG8_SB(0, 0), cB, voffB); PG8_STAGE(PG8_SB(0, 1), cB + hstepB, voffB1); PG8_STAGEA(PG8_SA(0, 0), ca00, ca01, (size_t)0); PG8_STAGEA(PG8_SA(0, 1), ca10, ca11, (size_t)0);
    if (wr == 1) PG8_BAR;
    PG8_WAIT_V(2); PG8_BAR;
    PG8_STAGE(PG8_SB(1, 0), cB + kstep, voffB); PG8_STAGEA(PG8_SA(1, 0), ca00, ca01, kstepA); PG8_STAGE(PG8_SB(1, 1), cB + hstepB + kstep, voffB1);
    PG8_WAIT_V(6); PG8_BAR;
    for (;;) {
        const bool has_next = S.next(ui + 1, nxt);
        const char* nB = has_next ? nxt.bB : cB;
        const int npar = (ui + 1) & 1;
        if (has_next) S.prefetch(nxt, npar, lds);

#pragma unroll 1
        for (int t = 0; t < nt; t += 2) {
            const bool last = (t == nt - 2);
            const bool fromnext = last && has_next;
            const size_t k1 = (size_t)(t + 1) * kstepA;
            const size_t k2 = last ? (size_t)0 : (size_t)(t + 2) * kstepA;
            const size_t k3 = k2 + kstepA;
            const char* b2 = last ? nB : cB + (size_t)(t + 2) * kstep; const char* b3 = b2 + kstep;
            unsigned y0, y1;
            PG8_LDB_(B0, B08, 0, 0); PG8_LDB_(B1, B18, 0, 1); PG8_SCHED; PG8_LDA_(At, At8, 0, 0); PG8_STAGEA(PG8_SA(1, 1), ca10, ca11, k1);
            PG8_WAIT_V(8); PG8_WAIT_L(0); PG8_BAR; PG8_SCHED8; PG8_MMA(0, 0, At, B0); PG8_MMA(0, 1, At, B1); PG8_PIN(0); PG8_SCHED8; PG8_BAR; PG8_SCHED;
            y0 = ca00; y1 = ca01; if (fromnext) PG8_AOFF2T(nxt, 0, npar, y0, y1);
            PG8_LDA_(At, At8, 0, 1); PG8_STAGE(PG8_SB(0, 0), b2, voffB); PG8_STAGE(PG8_SB(0, 1), b2 + hstepB, voffB1); PG8_STAGEA(PG8_SA(0, 0), y0, y1, k2);
            PG8_WAIT_V(8); PG8_WAIT_L(0); PG8_BAR; PG8_SCHED8; PG8_MMA(1, 0, At, B0); PG8_MMA(1, 1, At, B1); PG8_PIN(1); PG8_SCHED8; PG8_BAR; PG8_SCHED;
            y0 = ca10; y1 = ca11; if (fromnext) PG8_AOFF2T(nxt, 1, npar, y0, y1);
            PG8_LDB_(B0, B08, 1, 0); PG8_LDB_(B1, B18, 1, 1); PG8_SCHED; PG8_LDA_(At, At8, 1, 0); PG8_STAGEA(PG8_SA(0, 1), y0, y1, k2);
            PG8_WAIT_V(8); PG8_WAIT_L(0); PG8_BAR; PG8_SCHED8; PG8_MMA(0, 0, At, B0); PG8_MMA(0, 1, At, B1); PG8_PIN(0); PG8_SCHED8; PG8_BAR; PG8_SCHED;
            y0 = ca00; y1 = ca01; if (fromnext) PG8_AOFF2T(nxt, 0, npar, y0, y1);
            PG8_LDA_(At, At8, 1, 1); PG8_STAGE(PG8_SB(1, 0), b3, voffB); PG8_STAGE(PG8_SB(1, 1), b3 + hstepB, voffB1); PG8_STAGEA(PG8_SA(1, 0), y0, y1, k3);
            PG8_WAIT_V(8); PG8_WAIT_L(0); PG8_BAR; PG8_SCHED8; PG8_MMA(1, 0, At, B0); PG8_MMA(1, 1, At, B1); PG8_PIN(1); PG8_SCHED8; PG8_BAR; PG8_SCHED;
        }
        if (ALIGN && wr == 0) PG8_BAR;
        if constexpr (!Epi::AFTER_DRAIN) { E(acc, cur, wr, wc, fr, fq); }
        if (!has_next) break;
#pragma unroll
        for (int a = 0; a < 2; ++a)
#pragma unroll
            for (int b = 0; b < 2; ++b)
#pragma unroll
                for (int m = 0; m < 4; ++m)
#pragma unroll
                    for (int n = 0; n < 2; ++n) acc[a][b][m][n] = (f32x4){0.f, 0.f, 0.f, 0.f};
        cur = nxt; cB = nB; ++ui; PG8_AOFF2T(cur, 0, npar, ca00, ca01); PG8_AOFF2T(cur, 1, npar, ca10, ca11);
        if (ALIGN && wr == 1) PG8_BAR;
    }
    PG8_WAIT_V(0);
    if (!ALIGN && wr == 0) PG8_BAR;
    PG8_BAR;
    if constexpr (Epi::AFTER_DRAIN) { E.fused(acc, cur, wr, wc, fr, fq, lds, wid, lane); }
#undef PG8_SA
#undef PG8_SB
#undef PG8_STAGE
#undef PG8_STAGEA
#undef PG8_AOFFS
#undef PG8_AOFF2
#undef PG8_AOFF2T
#undef PG8_LDA
#undef PG8_LDA8
#undef PG8_LDB8
#undef PG8_LDA_
#undef PG8_LDB_
#undef PG8_LDB
#undef PG8_MMA
#undef PG8_WAIT_V
#undef PG8_WAIT_L
#undef PG8_BAR
#undef PG8_SCHED
#undef PG8_SCHED8
#undef PG8_PIN
}

struct DenseOrder {
    int nM, nN, nwg, G, c, K; const char* Bt;
    __device__ void init(int M, int N, int K_, const void* Bt_, int G_, int c_) { nM = M / BM; nN = N / BM; nwg = nM * nN; G = G_; c = c_; K = K_; Bt = (const char*)Bt_; }
    __device__ __forceinline__ bool next(int i, Unit& u) const {
        const int L = i * G + c; if (L >= nwg) return false;
        int wgid = L; { const int q = nwg / 8, r = nwg % 8, xcd = wgid % 8, off = wgid / 8; wgid = (xcd < r ? xcd * (q + 1) : r * (q + 1) + (xcd - r) * q) + off; }
        const int nig = 8 * nN, gid = wgid / nig, fm = gid * 8, gsz = (nM - fm) < 8 ? (nM - fm) : 8;
        u.pm = fm + ((wgid % nig) % gsz); u.pn = (wgid % nig) / gsz; u.bB = Bt + (size_t)u.pn * BM * K * 2; u.e = 0; u.nvalid = 256; u.rowbase = 0; return true;
    }
    __device__ __forceinline__ unsigned a_off(const Unit& u, int h, int R, int C) const { return (unsigned)(((u.pm * BM + h * HALF + R) * K + C) * 2); }
    __device__ __forceinline__ void prefetch(const Unit&, int, PG8_LAS unsigned char*) const {}
    __device__ __forceinline__ unsigned a_off_tab(const Unit& u, int h, int R, int C, int, PG8_LAS unsigned char*) const { return a_off(u, h, R, C); }
};
}
template <class RowMap>
__device__ __forceinline__ void transpose_item(const float* W, int K, int N, bf16_t* dst, const RowMap& rowmap, LAS float* scr, int kb, int nb, int lane) {
    const int k0 = 64 * kb, n0 = 64 * nb;
    const int cc = 4 * (lane & 15), rr = lane >> 4;
    const bool ok = (n0 + cc) < N;
    f32x4 v[16];
#pragma unroll
    for (int i = 0; i < 16; ++i) { v[i] = (f32x4){0.f, 0.f, 0.f, 0.f}; if (ok) v[i] = __builtin_nontemporal_load((const f32x4*)(W + (size_t)(k0 + 4 * i + rr) * N + n0 + cc)); }
#pragma unroll
    for (int i = 0; i < 16; ++i) { LAS float* s = scr + (4 * i + rr) * 65 + cc; s[0] = v[i].x; s[1] = v[i].y; s[2] = v[i].z; s[3] = v[i].w; }
    LDS_WAIT();
    const int c = lane & 7;
#pragma unroll
    for (int j = 0; j < 8; ++j) {
        const int n = (lane >> 3) + 8 * j;
        const LAS float* s = scr + (8 * c) * 65 + n;
        u32x4 o; o.x = pk2(s[0 * 65], s[1 * 65]); o.y = pk2(s[2 * 65], s[3 * 65]); o.z = pk2(s[4 * 65], s[5 * 65]); o.w = pk2(s[6 * 65], s[7 * 65]);
        if (n0 + n < N) *(u32x4*)(dst + (size_t)rowmap(n0 + n) * K + k0 + 8 * c) = o;
    }
    LDS_WAIT();
}
template <class RowMap>
__device__ __forceinline__ void transpose_item_fp8(const float* W, int K, int N, unsigned char* dst, const RowMap& rowmap, float scale, LAS float* scr, int kb, int nb, int lane) {
    const int k0 = 64 * kb, n0 = 64 * nb;
    const int cc = 4 * (lane & 15), rr = lane >> 4;
    const bool ok = (n0 + cc) < N;
    f32x4 v[16];
#pragma unroll
    for (int i = 0; i < 16; ++i) { v[i] = (f32x4){0.f, 0.f, 0.f, 0.f}; if (ok) v[i] = __builtin_nontemporal_load((const f32x4*)(W + (size_t)(k0 + 4 * i + rr) * N + n0 + cc)); }
#pragma unroll
    for (int i = 0; i < 16; ++i) { LAS float* s = scr + (4 * i + rr) * 65 + cc; s[0] = v[i].x; s[1] = v[i].y; s[2] = v[i].z; s[3] = v[i].w; }
    LDS_WAIT();
    const int c = lane & 7;
#pragma unroll
    for (int j = 0; j < 8; ++j) {
        const int n = (lane >> 3) + 8 * j;
        const LAS float* s = scr + (8 * c) * 65 + n;
        u32x2 o; o.x = pk4_fp8(s[0 * 65] * scale, s[1 * 65] * scale, s[2 * 65] * scale, s[3 * 65] * scale); o.y = pk4_fp8(s[4 * 65] * scale, s[5 * 65] * scale, s[6 * 65] * scale, s[7 * 65] * scale);
        if (n0 + n < N) *(u32x2*)(dst + (size_t)rowmap(n0 + n) * K + k0 + 8 * c) = o;
    }
    LDS_WAIT();
}
struct MapId { int off; __device__ __forceinline__ int operator()(int n) const { return off + n; } };
struct MapGU { int off; __device__ __forceinline__ int operator()(int n) const { return (n >> 7) * 256 + off + (n & 127); } };

struct XItem { const float* src; unsigned char* dst; int N, K; };
__device__ __forceinline__ XItem xitem(const Params& p, unsigned char* ws, int id_, int lane) {
    const int id = __builtin_amdgcn_readfirstlane(id_);
    const int t = id & 255, ew = id >> 8, e = ew / 3, which = ew - 3 * e;
    XItem it;
    if (which < 2) {
        const int kb = t >> 3, nb = t & 7;
        it.N = EFF; it.K = DM;
        it.src = (e < NEXP ? INP(23 + which) + (size_t)e * DM * EFF : INP(26 + which)) + (size_t)(64 * kb) * EFF + 64 * nb;
        const int n0 = 64 * nb; const int r0 = (n0 >> 7) * 256 + which * 128 + (n0 & 127);
        it.dst = (unsigned char*)(ws + OFF_WEUPT) + (size_t)e * 1024 * DM + (size_t)r0 * DM + 64 * kb;
    } else {
        const int kb = t >> 5, nb = t & 31;
        it.N = DM; it.K = EFF;
        it.src = (e < NEXP ? INP(25) + (size_t)e * EFF * DM : INP(28)) + (size_t)(64 * kb) * DM + 64 * nb;
        it.dst = (unsigned char*)(ws + OFF_WEDT) + (size_t)e * DM * EFF + (size_t)(64 * nb) * EFF + 64 * kb;
    }
    return it;
}
__device__ __forceinline__ void xload(f32x4 (&v)[16], const XItem& it, int lane) {
    const int cc = 4 * (lane & 15), rr = lane >> 4;
#pragma unroll
    for (int i = 0; i < 16; ++i) v[i] = __builtin_nontemporal_load((const f32x4*)(it.src + (size_t)(4 * i + rr) * it.N + cc));
}
__device__ __forceinline__ void xstore(const f32x4 (&v)[16], const XItem& it, LAS float* scr, int lane) {
    const int cc = 4 * (lane & 15), rr = lane >> 4;
#pragma unroll
    for (int i = 0; i < 16; ++i) { LAS float* s = scr + (4 * i + rr) * 65 + cc; s[0] = v[i].x; s[1] = v[i].y; s[2] = v[i].z; s[3] = v[i].w; }
    LDS_WAIT();
    const int c = lane & 7;
#pragma unroll
    for (int j = 0; j < 8; ++j) {
        const int n = (lane >> 3) + 8 * j;
        const LAS float* s = scr + (8 * c) * 65 + n;
        u32x2 o; o.x = pk4_fp8(s[0 * 65] * W8_SCALE, s[1 * 65] * W8_SCALE, s[2 * 65] * W8_SCALE, s[3 * 65] * W8_SCALE); o.y = pk4_fp8(s[4 * 65] * W8_SCALE, s[5 * 65] * W8_SCALE, s[6 * 65] * W8_SCALE, s[7 * 65] * W8_SCALE);
        *(u32x2*)(it.dst + (size_t)n * it.K + 8 * c) = o;
    }
    LDS_WAIT();
}
__device__ __forceinline__ void expert_convert(const Params& p, LAS unsigned char* lds, int vcu, int G, int first, int count) {
    const int tid = opqv(threadIdx.x), lane = tid & 63, wave = tid >> 6;
    const int gw = vcu * NWAVES + wave, NGW = G * NWAVES;
    unsigned char* ws = opqf(p.ws);
    LAS float* scr = (LAS float*)(lds + wave * 16640);
    int j = gw;
    if (j >= count) return;
    f32x4 va[16], vb[16];
    XItem ia = xitem(p, ws, first + j, lane), ib = ia;
    xload(va, ia, lane);
    for (;;) {
        const int j1 = j + NGW; const bool m1 = j1 < count;
        if (m1) { ib = xitem(p, ws, first + j1, lane); xload(vb, ib, lane); }
        xstore(va, ia, scr, lane);
        if (!m1) break;
        const int j2 = j1 + NGW; const bool m2 = j2 < count;
        if (m2) { ia = xitem(p, ws, first + j2, lane); xload(va, ia, lane); }
        xstore(vb, ib, scr, lane);
        if (!m2) break;
        j = j2;
    }
}
__device__ __forceinline__ void p0_prep(const Params& p, LAS unsigned char* lds, int vcu, int G) {
    const int tid = opqv(threadIdx.x), lane = tid & 63, wave = tid >> 6;
    const int gw = vcu * NWAVES + wave, NGW = G * NWAVES;
    const int gt = vcu * NTHREADS + tid, NGT = G * NTHREADS;
    unsigned char* ws = opqf(p.ws);
    if (vcu == 0 && tid < 64) ((unsigned*)(ws + OFF_CTL))[tid] = 0u;
    {
        const f32x4* x4 = (const f32x4*)INP(0); u32x4* xb = (u32x4*)(ws + OFF_XB);
        const int n8 = T_TOK * DM / 8;
        for (int i0 = gt; i0 < n8; i0 += 4 * NGT) {
            f32x4 a[4], b[4];
#pragma unroll
            for (int k = 0; k < 4; ++k) { const int i = i0 + k * NGT; if (i < n8) { a[k] = x4[2 * i]; b[k] = x4[2 * i + 1]; } }
#pragma unroll
            for (int k = 0; k < 4; ++k) { const int i = i0 + k * NGT; if (i < n8) { u32x4 o; o.x = pk2(a[k].x, a[k].y); o.y = pk2(a[k].z, a[k].w); o.z = pk2(b[k].x, b[k].y); o.w = pk2(b[k].z, b[k].w); xb[i] = o;
                ((u32x2*)(ws + OFF_X8))[i] = (u32x2){pk4_fp8(a[k].x, a[k].y, a[k].z, a[k].w), pk4_fp8(b[k].x, b[k].y, b[k].z, b[k].w)}; } }
        }
    }
    {
        u32x4* z1 = (u32x4*)(ws + OFF_WINT + (size_t)IN_COLS * DM); const int n1 = (PROJ_LD - IN_COLS) * DM / 16;
        for (int i = gt; i < n1; i += NGT) z1[i] = (u32x4){0u, 0u, 0u, 0u};

    }
    for (int i = gt; i < NGRP * NSTATE; i += NGT) {
        const int g = i >> 6, pp = i & 63;
        const float lr = INP(3)[i], li = INP(4)[i], dt = expf(INP(5)[g]);
        const float mag = expf(lr * dt); float sn, cs; sincosf(li * dt, &sn, &cs);
        const float ar = mag * cs, ai = mag * sn;
        const float zr = ar - 1.f, zi = ai, den = lr * lr + li * li;
        const float fr = (zr * lr + zi * li) / den, fi = (zi * lr - zr * li) / den;
        ((f32x2*)(ws + OFF_S5A))[i] = (f32x2){ar, ai};
        float pr = ar, pi = ai;
#pragma unroll
        for (int k = 0; k < 8; ++k) { const float nr = pr * pr - pi * pi, ni = 2.f * pr * pi; pr = nr; pi = ni; }
        ((f32x2*)(ws + OFF_S5AC))[i] = (f32x2){pr, pi};
        (void)fr; (void)fi;
    }
    for (int i = gt; i < NGRP * 4 * 64; i += NGT) {
        const int g = i >> 8, v = (i >> 6) & 3, l = i & 63, pp = 32 * (v >> 1) + (l & 31), h0 = 8 * (l >> 5), gp = g * 64 + pp;
        const float lr = INP(3)[gp], li = INP(4)[gp], dt = expf(INP(5)[g]);
        const float mag = expf(lr * dt); float sn, cs; sincosf(li * dt, &sn, &cs);
        const float ar = mag * cs, ai = mag * sn, zr = ar - 1.f, zi = ai, den = lr * lr + li * li;
        const float fr = (zr * lr + zi * li) / den, fi = (zi * lr - zr * li) / den;
        const float* br = INP(6) + (size_t)gp * 16 + h0; const float* bi = INP(7) + (size_t)gp * 16 + h0;
        unsigned w[4];
#pragma unroll
        for (int jj = 0; jj < 4; ++jj) {
            const float r0 = fr * br[2 * jj] - fi * bi[2 * jj], i0 = fr * bi[2 * jj] + fi * br[2 * jj], r1 = fr * br[2 * jj + 1] - fi * bi[2 * jj + 1], i1 = fr * bi[2 * jj + 1] + fi * br[2 * jj + 1];
            w[jj] = (v & 1) ? pk2(i0, i1) : pk2(r0, r1);
        }
        ((u32x4*)(ws + OFF_S5BB))[i] = (u32x4){w[0], w[1], w[2], w[3]};
    }
    for (int i = gt; i < NGRP * 4 * 64; i += NGT) {
        const int g = i >> 8, ks = (i >> 6) & 3, l = i & 63, h = l & 15, q = l >> 4;
        const float* cre = INP(8) + ((size_t)g * 16 + h) * 64; const float* cim = INP(9) + ((size_t)g * 16 + h) * 64;
        unsigned w[4];
#pragma unroll
        for (int jj = 0; jj < 4; ++jj) { const int k = 32 * ks + 8 * q + 2 * jj, pp = k >> 1; w[jj] = pk2(cre[pp], -cim[pp]); }
        ((u32x4*)(ws + OFF_S5CF))[i] = (u32x4){w[0], w[1], w[2], w[3]};
    }
    if (vcu < 32) {
        const int which = vcu >> 4, pt = vcu & 15;
        const float* pe = INP(12 + which); const float* w1 = INP(which == 0 ? 14 : 16);
        LAS float* red = (LAS float*)lds;
        const int j = tid & 127, sub = tid >> 7; float s = 0.f;
        const int kb0 = pt * 128 + sub * 32;
        float wv[32];
#pragma unroll
        for (int k = 0; k < 32; ++k) wv[k] = w1[(size_t)(kb0 + k) * 128 + j];
#pragma unroll
        for (int k = 0; k < 32; ++k) s += pe[kb0 + k] * wv[k];
        red[tid] = s; __syncthreads();
        if (tid < 128) ((float*)(ws + OFF_CBIAS))[(which * 16 + pt) * 128 + tid] = red[tid] + red[tid + 128] + red[tid + 256] + red[tid + 384];
        __syncthreads();
    }
    LAS float* scr = (LAS float*)(lds + wave * 16640);
    auto run = [&](const float* W, int K, int N, bf16_t* dst, auto map, int& base) {
        const int nkb = K / 64, nnb = (N + 63) / 64, items = nkb * nnb;
        int j0 = (gw - (base % NGW) + NGW) % NGW;
        for (int j = j0; j < items; j += NGW) transpose_item(W, K, N, dst, map, scr, j / nnb, j % nnb, lane);
        base += items;
    };
    auto run8 = [&](const float* W, int K, int N, unsigned char* dst, auto map, int& base) {
        const int nnb = (N + 63) / 64, items = (K / 64) * nnb;
        int j0 = (gw - (base % NGW) + NGW) % NGW;
        for (int j = j0; j < items; j += NGW) transpose_item_fp8(W, K, N, dst, map, W8_SCALE, scr, j / nnb, j % nnb, lane);
        base += items;
    };
    int base = 0;
    run8(INP(2), DM, IN_COLS, (unsigned char*)(ws + OFF_WINT), MapId{0}, base);
    run(INP(11), 1024, 1024, (bf16_t*)(ws + OFF_WGLUT), MapId{0}, base);
    run8(INP(18), DM, DM, (unsigned char*)(ws + OFF_WOUTT), MapId{0}, base);
    run(INP(14), DM, 128, (bf16_t*)(ws + OFF_WC1T), MapId{0}, base);
    run(INP(16), DM, 128, (bf16_t*)(ws + OFF_WC1T), MapId{128}, base);
    run(INP(21), DM, NEXP, (bf16_t*)(ws + OFF_WRT), MapId{0}, base);
    (void)run8;
}
using pg8::Unit;
struct EpiStoreBf16 {
    static constexpr int PERM = 1; static constexpr bool AFTER_DRAIN = false;
    bf16_t* O; int ldc; float sc;
    __device__ __forceinline__ void operator()(const f32x4 (&acc)[2][2][4][2], const Unit& u, int wr, int wc, int fr, int fq) const {
        const int row0 = u.pm * 256 + wr * 64 + fr, col0 = u.pn * 256 + wc * 32 + 8 * fq;
#pragma unroll
        for (int ai = 0; ai < 2; ++ai)
#pragma unroll
            for (int m = 0; m < 4; ++m) { bf16_t* rowp = O + (size_t)(row0 + ai * 128 + m * 16) * ldc + col0;
#pragma unroll
                for (int bj = 0; bj < 2; ++bj) { const f32x4 v0 = acc[ai][bj][m][0] * sc, v1 = acc[ai][bj][m][1] * sc;
                    u32x4 w; w.x = cvt_pk_bf16(v0[0], v0[1]); w.y = cvt_pk_bf16(v0[2], v0[3]); w.z = cvt_pk_bf16(v1[0], v1[1]); w.w = cvt_pk_bf16(v1[2], v1[3]);
                    *(u32x4*)(rowp + bj * 128) = w; } }
    }
};
struct EpiGlu {
    static constexpr int PERM = 1; static constexpr bool AFTER_DRAIN = false;
    const bf16_t* Y; unsigned char* O;
    __device__ __forceinline__ void operator()(const f32x4 (&acc)[2][2][4][2], const Unit& u, int wr, int wc, int fr, int fq) const {
        const int row0 = u.pm * 256 + wr * 64 + fr, col0 = u.pn * 256 + wc * 32 + 8 * fq;
#pragma unroll
        for (int ai = 0; ai < 2; ++ai) {
            u32x4 yv[4][2];
#pragma unroll
            for (int m = 0; m < 4; ++m)
#pragma unroll
                for (int bj = 0; bj < 2; ++bj) yv[m][bj] = *(const u32x4*)(Y + (size_t)(row0 + ai * 128 + m * 16) * 1024 + col0 + bj * 128);
#pragma unroll
            for (int m = 0; m < 4; ++m) { const size_t r = (size_t)(row0 + ai * 128 + m * 16);
#pragma unroll
                for (int bj = 0; bj < 2; ++bj) { const f32x4 v0 = acc[ai][bj][m][0], v1 = acc[ai][bj][m][1];
                    const u32x4 y = yv[m][bj];
                    u32x2 w;
                    w.x = pk4_fp8(bflo(y.x) * sigmoidf_(v0[0]) * MIX8_SCALE, bfhi(y.x) * sigmoidf_(v0[1]) * MIX8_SCALE, bflo(y.y) * sigmoidf_(v0[2]) * MIX8_SCALE, bfhi(y.y) * sigmoidf_(v0[3]) * MIX8_SCALE);
                    w.y = pk4_fp8(bflo(y.z) * sigmoidf_(v1[0]) * MIX8_SCALE, bfhi(y.z) * sigmoidf_(v1[1]) * MIX8_SCALE, bflo(y.w) * sigmoidf_(v1[2]) * MIX8_SCALE, bfhi(y.w) * sigmoidf_(v1[3]) * MIX8_SCALE);
                    *(u32x2*)(O + r * 2048 + col0 + bj * 128) = w; } }
        }
    }
};
struct EpiResF32 {
    static constexpr int PERM = 0; static constexpr bool AFTER_DRAIN = false;
    const float* X; float* O;
    __device__ __forceinline__ void operator()(const f32x4 (&acc)[2][2][4][2], const Unit& u, int wr, int wc, int fr, int fq) const {
        const int row0 = u.pm * 256 + wr * 64 + fr, col0 = u.pn * 256 + wc * 32 + 4 * fq;
#pragma unroll
        for (int ai = 0; ai < 2; ++ai)
#pragma unroll
            for (int m = 0; m < 4; ++m) { const size_t off = (size_t)(row0 + ai * 128 + m * 16) * DM + col0;
#pragma unroll
                for (int bj = 0; bj < 2; ++bj)
#pragma unroll
                    for (int n = 0; n < 2; ++n) { const f32x4 xv = *(const f32x4*)(X + off + bj * 128 + n * 16); *(f32x4*)(O + off + bj * 128 + n * 16) = xv * ALPHA + acc[ai][bj][m][n]; } }
    }
};

struct EpiResBf16 {
    static constexpr int PERM = 1; static constexpr bool AFTER_DRAIN = false;
    const bf16_t* X; bf16_t* O;
    __device__ __forceinline__ void operator()(const f32x4 (&acc)[2][2][4][2], const Unit& u, int wr, int wc, int fr, int fq) const {
        const int row0 = u.pm * 256 + wr * 64 + fr, col0 = u.pn * 256 + wc * 32 + 8 * fq;
#pragma unroll
        for (int ai = 0; ai < 2; ++ai) {
            u32x4 xv[4][2];
#pragma unroll
            for (int m = 0; m < 4; ++m)
#pragma unroll
                for (int bj = 0; bj < 2; ++bj) xv[m][bj] = *(const u32x4*)(X + (size_t)(row0 + ai * 128 + m * 16) * DM + col0 + bj * 128);
#pragma unroll
            for (int m = 0; m < 4; ++m) { const size_t off = (size_t)(row0 + ai * 128 + m * 16) * DM + col0;
#pragma unroll
                for (int bj = 0; bj < 2; ++bj) { const f32x4 v0 = acc[ai][bj][m][0] * (1.f / (W8_SCALE * MIX8_SCALE)), v1 = acc[ai][bj][m][1] * (1.f / (W8_SCALE * MIX8_SCALE));
                    const u32x4 x = xv[m][bj];
                    u32x4 w; w.x = cvt_pk_bf16(bflo(x.x) * ALPHA + v0[0], bfhi(x.x) * ALPHA + v0[1]); w.y = cvt_pk_bf16(bflo(x.y) * ALPHA + v0[2], bfhi(x.y) * ALPHA + v0[3]);
                    w.z = cvt_pk_bf16(bflo(x.z) * ALPHA + v1[0], bfhi(x.z) * ALPHA + v1[1]); w.w = cvt_pk_bf16(bflo(x.w) * ALPHA + v1[2], bfhi(x.w) * ALPHA + v1[3]);
                    *(u32x4*)(O + off + bj * 128) = w; } }
        }
    }
};

template <int NSL>
__device__ __forceinline__ void ln_row(const bf16_t* inrow, float inscale, const unsigned char* slots  , const f32x4 (&gv)[8], const f32x4 (&bv)[8]  , float* outrow, bf16_t* outb, unsigned char* outq, int lane) {
    const u32x2* xr = (const u32x2*)inrow + lane;
    f32x4 v[8]; float s = 0.f;
#pragma unroll
    for (int j = 0; j < 8; ++j) { const u32x2 w = xr[64 * j]; v[j] = (f32x4){bflo(w.x), bfhi(w.x), bflo(w.y), bfhi(w.y)} * inscale; }
    if (NSL > 0) {
#pragma unroll
        for (int k = 0; k < NSL; ++k) { const unsigned* sr = (const unsigned*)(slots + (size_t)k * DM) + lane;
#pragma unroll
            for (int j = 0; j < 8; ++j) { const unsigned w = sr[64 * j]; const f32x2 lo = __builtin_amdgcn_cvt_pk_f32_fp8(w, false), hi = __builtin_amdgcn_cvt_pk_f32_fp8(w, true);
                v[j].x += lo.x * (1.f / SLOT_SCALE); v[j].y += lo.y * (1.f / SLOT_SCALE); v[j].z += hi.x * (1.f / SLOT_SCALE); v[j].w += hi.y * (1.f / SLOT_SCALE); } }
    }
#pragma unroll
    for (int j = 0; j < 8; ++j) s += (v[j].x + v[j].y) + (v[j].z + v[j].w);
    const float mean = wave_sum(s) * (1.f / DM); float s2 = 0.f;
#pragma unroll
    for (int j = 0; j < 8; ++j) { v[j] = v[j] - mean; s2 += (v[j].x * v[j].x + v[j].y * v[j].y) + (v[j].z * v[j].z + v[j].w * v[j].w); }
    const float rstd = 1.f / sqrtf(wave_sum(s2) * (1.f / DM) + LN_EPS);
    f32x4* o = (f32x4*)outrow + lane;
    u32x2* ob = (u32x2*)outb + lane; unsigned* oq = (unsigned*)outq + lane;
#pragma unroll
    for (int j = 0; j < 8; ++j) { const f32x4 r = v[j] * rstd * gv[j] + bv[j]; __builtin_nontemporal_store(r, &o[64 * j]); if (outb) ob[64 * j] = (u32x2){pk2(r.x, r.y), pk2(r.z, r.w)}; if (outq) oq[64 * j] = pk4_fp8(r.x, r.y, r.z, r.w); }
}
typedef float f32x16 __attribute__((ext_vector_type(16)));
constexpr int S5_WAVE_LDS = 2 * 16 * 272;
template <bool PASS2>
__device__ __forceinline__ void s5_pass(const Params& p, LAS unsigned char* lds, int vcu, int G) {
    const int tid = opqv(threadIdx.x), lane = tid & 63, wave = __builtin_amdgcn_readfirstlane(tid >> 6);
    const int gw = vcu * NWAVES + wave, NGW = G * NWAVES;
    unsigned char* ws = opqf(p.ws);
    const bf16_t* proj = (const bf16_t*)(ws + OFF_PROJ);
    LAS unsigned char* sl = lds + wave * S5_WAVE_LDS;
    f32x2* Ebuf = (f32x2*)(ws + OFF_E);
    const int c = lane & 31, hh = lane >> 5;
    const int arow = lane & 31, ab = (arow >> 2) & 1, atok = (arow & 3) + 4 * (arow >> 3), ak = 8 * (lane >> 5);
    const int h = lane & 15, q = lane >> 4;
    for (int task = gw; task < NGRP * S5_NSEG; task += NGW) {
        const int g = task % NGRP, sg = task / NGRP;
        bf16x8 bf[4];
#pragma unroll
        for (int v = 0; v < 4; ++v) bf[v] = ((const bf16x8*)(ws + OFF_S5BB))[(g * 4 + v) * 64 + lane];
        const f32x2 a0 = ((const f32x2*)(ws + OFF_S5A))[g * 64 + c], a1 = ((const f32x2*)(ws + OFF_S5A))[g * 64 + 32 + c];
        float s0r = 0.f, s0i = 0.f, s1r = 0.f, s1i = 0.f;
        bf16x8 cf[4]; float dsk = 0.f;
        if (PASS2) {
            const f32x2 c0 = ((const f32x2*)(ws + OFF_S5AC))[g * 64 + c], c1 = ((const f32x2*)(ws + OFF_S5AC))[g * 64 + 32 + c];
            const f32x2* Ep = Ebuf + ((size_t)(hh * NGRP + g) * S5_NSEG) * 64 + c;
#pragma unroll 1
            for (int cc = 0; cc < sg; cc += 4) {
                f32x2 e0[4], e1[4];
#pragma unroll
                for (int k = 0; k < 4; ++k) { e0[k] = (f32x2){0.f, 0.f}; e1[k] = e0[k]; if (cc + k < sg) { e0[k] = Ep[(size_t)(cc + k) * 64]; e1[k] = Ep[(size_t)(cc + k) * 64 + 32]; } }
#pragma unroll
                for (int k = 0; k < 4; ++k) if (cc + k < sg) {
                    const float n0r = c0.x * s0r - c0.y * s0i + e0[k].x, n0i = c0.x * s0i + c0.y * s0r + e0[k].y; s0r = n0r; s0i = n0i;
                    const float n1r = c1.x * s1r - c1.y * s1i + e1[k].x, n1i = c1.x * s1i + c1.y * s1r + e1[k].y; s1r = n1r; s1i = n1i;
                }
            }
#pragma unroll
            for (int ks = 0; ks < 4; ++ks) cf[ks] = ((const bf16x8*)(ws + OFF_S5CF))[(g * 4 + ks) * 64 + lane];
            dsk = INP(10)[g * 16 + h];
        }
        const bf16_t* ubase = proj + (size_t)(ab * SEQ + sg * S5_SEG + atok) * PROJ_LD + g * 16 + ak;
        bf16x8 ua = *(const bf16x8*)ubase;
#pragma unroll 1
        for (int st = 0; st < S5_SEG / 16; ++st) {
            const bf16x8 ucur = ua;
            if (st + 1 < S5_SEG / 16) ua = *(const bf16x8*)(ubase + (size_t)(st + 1) * 16 * PROJ_LD);
            unsigned short uraw[2][4];
            if (PASS2) {
#pragma unroll
                for (int bb = 0; bb < 2; ++bb)
#pragma unroll
                    for (int r = 0; r < 4; ++r) uraw[bb][r] = proj[(size_t)(bb * SEQ + sg * S5_SEG + st * 16 + 4 * q + r) * PROJ_LD + g * 16 + h];
            }
            f32x16 x0r = {0.f, 0.f, 0.f, 0.f, 0.f, 0.f, 0.f, 0.f, 0.f, 0.f, 0.f, 0.f, 0.f, 0.f, 0.f, 0.f}, x0i = x0r, x1r = x0r, x1i = x0r;
            asm volatile("" : "+v"(x0r), "+v"(x0i), "+v"(x1r), "+v"(x1i));
            x0r = __builtin_amdgcn_mfma_f32_32x32x16_bf16(ucur, bf[0], x0r, 0, 0, 0); x0i = __builtin_amdgcn_mfma_f32_32x32x16_bf16(ucur, bf[1], x0i, 0, 0, 0);
            x1r = __builtin_amdgcn_mfma_f32_32x32x16_bf16(ucur, bf[2], x1r, 0, 0, 0); x1i = __builtin_amdgcn_mfma_f32_32x32x16_bf16(ucur, bf[3], x1i, 0, 0, 0);
#pragma unroll
            for (int t = 0; t < 16; ++t) {
                const float n0r = a0.x * s0r - a0.y * s0i + x0r[t], n0i = a0.x * s0i + a0.y * s0r + x0i[t]; s0r = n0r; s0i = n0i;
                const float n1r = a1.x * s1r - a1.y * s1i + x1r[t], n1i = a1.x * s1i + a1.y * s1r + x1i[t]; s1r = n1r; s1i = n1i;
                if (PASS2) { *(LAS unsigned*)(sl + (hh * 16 + t) * 272 + c * 4) = cvt_pk_bf16(s0r, s0i); *(LAS unsigned*)(sl + (hh * 16 + t) * 272 + 128 + c * 4) = cvt_pk_bf16(s1r, s1i); }
            }
            if (PASS2) {
                LDS_WAIT();
#pragma unroll
                for (int bb = 0; bb < 2; ++bb) {
                    f32x4 acc = (f32x4){0.f, 0.f, 0.f, 0.f};
#pragma unroll
                    for (int ks = 0; ks < 4; ++ks) { const bf16x8 av = *(const LAS bf16x8*)(sl + (bb * 16 + h) * 272 + ks * 64 + q * 16); acc = __builtin_amdgcn_mfma_f32_16x16x32_bf16(av, cf[ks], acc, 0, 0, 0); }
                    const size_t trow = (size_t)(bb * SEQ + sg * S5_SEG + st * 16 + 4 * q);
                    bf16_t* yo = (bf16_t*)(ws + OFF_YGELU) + trow * SSM_W + g * 16 + h;
#pragma unroll
                    for (int r = 0; r < 4; ++r) { const float uu = bf2f(uraw[bb][r]); const float y = gelu_tanh(acc[r] + dsk * uu); yo[(size_t)r * SSM_W] = (bf16_t)f2bf(y); }
                }
                LDS_WAIT();
            }
        }
        if (!PASS2) { f32x2* Eo = Ebuf + ((size_t)(hh * NGRP + g) * S5_NSEG + sg) * 64 + c; Eo[0] = (f32x2){s0r, s0i}; Eo[32] = (f32x2){s1r, s1i}; }
    }
}
__device__ __forceinline__ int vperm32(int k) { return 8 * ((k >> 2) & 3) + 4 * (k >> 4) + (k & 3); }

__device__ __forceinline__ void rope8(const u32x4 a, const u32x4 b, const float* cs, const float* sn, float (&o1)[8], float (&o2)[8]) {
    const unsigned aw[4] = {a.x, a.y, a.z, a.w}, bw[4] = {b.x, b.y, b.z, b.w};
#pragma unroll
    for (int k = 0; k < 4; ++k) {
        const float x1l = bflo(aw[k]), x1h = bfhi(aw[k]), x2l = bflo(bw[k]), x2h = bfhi(bw[k]);
        o1[2 * k] = x1l * cs[2 * k] - x2l * sn[2 * k]; o2[2 * k] = x2l * cs[2 * k] + x1l * sn[2 * k];
        o1[2 * k + 1] = x1h * cs[2 * k + 1] - x2h * sn[2 * k + 1]; o2[2 * k + 1] = x2h * cs[2 * k + 1] + x1h * sn[2 * k + 1];
    }
}
__device__ __forceinline__ void nsa_rope_layout(const Params& p, LAS unsigned char* lds, int vcu, int G) {
    const int tid = opqv(threadIdx.x), lane = tid & 63, wave = __builtin_amdgcn_readfirstlane(tid >> 6);
    const int gw = vcu * NWAVES + wave, NGW = G * NWAVES;
    unsigned char* ws = opqp(p.ws);
    const bf16_t* proj = (const bf16_t*)(ws + OFF_PROJ);
    bf16_t* Qr = (bf16_t*)(ws + OFF_QR);
    unsigned char* Q8 = (unsigned char*)(ws + OFF_Q8);
    const int* positions = (const int*)INP(1);
    LAS float* tab = (LAS float*)(lds + wave * 256);
    const float inv = powf(10000.f, -(float)(lane & 31) * (1.f / 32.f));
    const int hd = lane >> 2, qq = lane & 3;
    const int kidx = (lane >> 2) & 3, ktype = kidx >> 1, kkvh = kidx & 1, kcol = (ktype == 0 ? COL_KS : COL_KW) + kkvh * 64;
    u32x4 qa, qb, ka, kb; unsigned short gr = 0;
    auto fetch = [&](int t, u32x4& qa_, u32x4& qb_, u32x4& ka_, u32x4& kb_, unsigned short& g_) {
        const bf16_t* prow = proj + (size_t)t * PROJ_LD;
        qa_ = *(const u32x4*)(prow + COL_Q + hd * 64 + 8 * qq); qb_ = *(const u32x4*)(prow + COL_Q + hd * 64 + 32 + 8 * qq);
        ka_ = (u32x4){0u, 0u, 0u, 0u}; kb_ = ka_;
        if (lane < 16) { ka_ = *(const u32x4*)(prow + kcol + 8 * qq); kb_ = *(const u32x4*)(prow + kcol + 32 + 8 * qq); }
        g_ = lane < 48 ? prow[COL_G + lane] : (unsigned short)0;
    };
    if (gw < T_TOK) fetch(gw, qa, qb, ka, kb, gr);
    for (int t = gw; t < T_TOK; t += NGW) {
        const int b = t / SEQ, tl = t % SEQ;
        const float pos = (float)positions[t];
        u32x4 nqa = qa, nqb = qb, nka = ka, nkb = kb; unsigned short ngr = gr;
        if (t + NGW < T_TOK) fetch(t + NGW, nqa, nqb, nka, nkb, ngr);
        if (lane < 32) { float sn, cs; sincosf(pos * inv, &sn, &cs); tab[lane] = cs; tab[32 + lane] = sn; }
        LDS_WAIT();
        float cs[8], sn[8];
        { const f32x4 c0 = *(const LAS f32x4*)(tab + 8 * qq), c1 = *(const LAS f32x4*)(tab + 8 * qq + 4), s0 = *(const LAS f32x4*)(tab + 32 + 8 * qq), s1 = *(const LAS f32x4*)(tab + 32 + 8 * qq + 4);
#pragma unroll
          for (int k = 0; k < 4; ++k) { cs[k] = c0[k]; cs[4 + k] = c1[k]; sn[k] = s0[k]; sn[4 + k] = s1[k]; } }
        {
            float o1[8], o2[8]; rope8(qa, qb, cs, sn, o1, o2);
            bf16_t* qd = Qr + (size_t)t * 1024 + hd * 64 + 8 * qq;
            *(u32x4*)qd = (u32x4){pk2(o1[0] * 0.125f, o1[1] * 0.125f), pk2(o1[2] * 0.125f, o1[3] * 0.125f), pk2(o1[4] * 0.125f, o1[5] * 0.125f), pk2(o1[6] * 0.125f, o1[7] * 0.125f)};
            *(u32x4*)(qd + 32) = (u32x4){pk2(o2[0] * 0.125f, o2[1] * 0.125f), pk2(o2[2] * 0.125f, o2[3] * 0.125f), pk2(o2[4] * 0.125f, o2[5] * 0.125f), pk2(o2[6] * 0.125f, o2[7] * 0.125f)};
            unsigned char* q8 = Q8 + (size_t)t * 1024 + hd * 64 + 8 * qq;
            *(u32x2*)q8 = (u32x2){pk4_fp8(o1[0], o1[1], o1[2], o1[3]), pk4_fp8(o1[4], o1[5], o1[6], o1[7])};
            *(u32x2*)(q8 + 32) = (u32x2){pk4_fp8(o2[0], o2[1], o2[2], o2[3]), pk4_fp8(o2[4], o2[5], o2[6], o2[7])};
        }
        if (lane < 16) {
            float o1[8], o2[8]; rope8(ka, kb, cs, sn, o1, o2);
            if (ktype == 0) {
                unsigned char* dst = (unsigned char*)(ws + OFF_KSEL) + ((size_t)(b * 2 + kkvh) * SEQ + (tl & ~63)) * 64 + ((tl & 63) >> 4) * 1024 + (qq * 16 + (tl & 15)) * 16;
                *(u32x4*)dst = (u32x4){pk4_fp8(o1[0], o1[1], o1[2], o1[3]), pk4_fp8(o1[4], o1[5], o1[6], o1[7]), pk4_fp8(o2[0], o2[1], o2[2], o2[3]), pk4_fp8(o2[4], o2[5], o2[6], o2[7])};
            } else {
                bf16_t* dst = (bf16_t*)(ws + OFF_KWIN) + ((size_t)(b * 2 + kkvh) * SEQ + tl) * 64 + 8 * qq;
                *(u32x4*)dst = (u32x4){pk2(o1[0], o1[1]), pk2(o1[2], o1[3]), pk2(o1[4], o1[5]), pk2(o1[6], o1[7])};
                *(u32x4*)(dst + 32) = (u32x4){pk2(o2[0], o2[1]), pk2(o2[2], o2[3]), pk2(o2[4], o2[5]), pk2(o2[6], o2[7])};
            }
        }
        if (lane < 48) ((float*)(ws + OFF_GATES))[(size_t)t * 48 + lane] = sigmoidf_(bf2f(gr));
        LDS_WAIT();
        qa = nqa; qb = nqb; ka = nka; kb = nkb; gr = ngr;
    }
}

__device__ __forceinline__ void nsa_vtranspose(const Params& p, LAS unsigned char* lds, int vcu, int G) {
    const int tid = opqv(threadIdx.x), lane = tid & 63, wave = __builtin_amdgcn_readfirstlane(tid >> 6);
    const int gw = vcu * NWAVES + wave, NGW = G * NWAVES;
    unsigned char* ws = opqp(p.ws);
    const bf16_t* proj = (const bf16_t*)(ws + OFF_PROJ);
    LAS unsigned char* sl = lds + wave * 9216;
    for (int task = gw; task < 2 * 4 * 128; task += NGW) {
        const int blk = task & 127, bk = (task >> 7) & 3, type = task >> 9, b = bk >> 1, kvh = bk & 1;
        const bf16_t* src = proj + (size_t)(b * SEQ + blk * 64 + lane) * PROJ_LD + (type == 0 ? COL_VS : COL_VW) + kvh * 64;
#pragma unroll
        for (int i = 0; i < 8; ++i) *(LAS u32x4*)(sl + lane * 144 + 16 * i) = *(const u32x4*)(src + 8 * i);
        LDS_WAIT();
        if (type == 0) {
            unsigned char* dst8 = (unsigned char*)(ws + OFF_VSELT) + (size_t)(bk * 128 + blk) * 4096 + (lane >> 4) * 1024 + (lane & 15) * 16;
#pragma unroll
            for (int qv = 0; qv < 4; ++qv) {
                unsigned w[4];
#pragma unroll
                for (int jj = 0; jj < 4; ++jj) {
                    float f[4];
#pragma unroll
                    for (int e = 0; e < 4; ++e) { const int p0 = 32 * (jj >> 1) + 8 * qv + 4 * (jj & 1) + e; const int k0 = 32 * (p0 >> 5) + ((p0 & 7) >> 2) * 16 + 4 * ((p0 >> 3) & 3) + (p0 & 3); f[e] = bf2f(*(const LAS bf16_t*)(sl + k0 * 144 + lane * 2)); }
                    w[jj] = pk4_fp8(f[0], f[1], f[2], f[3]);
                }
                *(u32x4*)(dst8 + 256 * qv) = (u32x4){w[0], w[1], w[2], w[3]};
            }
            LDS_WAIT();
            continue;
        }
        bf16_t* dst = (bf16_t*)(ws + OFF_VWINT) + ((size_t)(bk * 128 + blk) * 64 + lane) * 64;
#pragma unroll
        for (int c8 = 0; c8 < 8; ++c8) {
            unsigned w[4];
#pragma unroll
            for (int jj = 0; jj < 4; ++jj) {
                const int p0 = c8 * 8 + 2 * jj, p1 = p0 + 1;
                const int k0 = 32 * (p0 >> 5) + ((p0 & 7) >> 2) * 16 + 4 * ((p0 >> 3) & 3) + (p0 & 3), k1 = 32 * (p1 >> 5) + ((p1 & 7) >> 2) * 16 + 4 * ((p1 >> 3) & 3) + (p1 & 3);
                const unsigned lo = *(const LAS bf16_t*)(sl + k0 * 144 + lane * 2), hi = *(const LAS bf16_t*)(sl + k1 * 144 + lane * 2);
                w[jj] = lo | (hi << 16);
            }
            *(u32x4*)(dst + 8 * c8) = (u32x4){w[0], w[1], w[2], w[3]};
        }
        LDS_WAIT();
    }
}

__device__ __forceinline__ void nsa_compress(const Params& p, LAS unsigned char* lds, int vcu, int G) {
    const int tid = opqv(threadIdx.x), lane = tid & 63, wave = __builtin_amdgcn_readfirstlane(tid >> 6), fr = lane & 15, fq = lane >> 4;
    unsigned char* ws = opqp(p.ws);
    const bf16_t* proj = (const bf16_t*)(ws + OFF_PROJ);
    LAS float* hid = (LAS float*)lds;
    LAS float* w2s = (LAS float*)(lds + 16384);
    for (int rt = vcu; rt < 256; rt += G) {
        const int rr0 = rt * 16, which = rr0 >> 11, bk = (rr0 >> 9) & 3, b = bk >> 1, kvh = bk & 1, n0 = rr0 & 511;
        const int na = (n0 + fr) > (NCMP - 1) ? (NCMP - 1) : (n0 + fr);
        const bf16_t* arow = proj + (size_t)(b * SEQ + 16 * na) * PROJ_LD + COL_KC + which * 128 + kvh * 64 + 8 * fq;
        const bf16_t* brow = (const bf16_t*)(ws + OFF_WC1T) + (size_t)(which * 128 + wave * 16 + fr) * DM + 8 * fq;
        {
            const float* w2 = INP(which ? 17 : 15);
            f32x4 wv[4];
#pragma unroll
            for (int i = 0; i < 4; ++i) wv[i] = *(const f32x4*)(w2 + 4 * (tid + i * NTHREADS));
#pragma unroll
            for (int i = 0; i < 4; ++i) *(LAS f32x4*)(w2s + 4 * (tid + i * NTHREADS)) = wv[i];
        }
        f32x4 acc = (f32x4){0.f, 0.f, 0.f, 0.f};
#pragma unroll 8
        for (int ks = 0; ks < 64; ++ks) {
            const bf16x8 a = *(const bf16x8*)(arow + (size_t)(ks >> 1) * PROJ_LD + (ks & 1) * 32);
            const bf16x8 bv = *(const bf16x8*)(brow + ks * 32);
            acc = __builtin_amdgcn_mfma_f32_16x16x32_bf16(a, bv, acc, 0, 0, 0);
        }
        float bias = 0.f;
#pragma unroll
        for (int pt = 0; pt < 16; ++pt) bias += ((const float*)(ws + OFF_CBIAS))[(which * 16 + pt) * 128 + wave * 16 + fr];
#pragma unroll
        for (int r = 0; r < 4; ++r) hid[(4 * fq + r) * 132 + wave * 16 + fr] = gelu_tanh(acc[r] + bias);
        __syncthreads();
        {
            const int row = tid >> 5, d = tid & 31;
            float o1 = 0.f, o2 = 0.f;
#pragma unroll 8
            for (int c = 0; c < 128; ++c) { const float hv = hid[row * 132 + c]; o1 += hv * w2s[c * 64 + d]; o2 += hv * w2s[c * 64 + 32 + d]; }
            const int n = n0 + row; const bool valid = n < NCMP;
            if (which == 0) {
                const int* positions = (const int*)INP(1);
                const int nn = valid ? n : NCMP - 1;
                float ps = 0.f;
#pragma unroll
                for (int t = 0; t < 32; ++t) ps += (float)positions[b * SEQ + 16 * nn + t];
                const float posm = ps * (1.f / 32.f);
                const float inv = powf(10000.f, -(float)d * (1.f / 32.f));
                float sn, cs; sincosf(posm * inv, &sn, &cs);
                bf16_t* dst = (bf16_t*)(ws + OFF_KC) + ((size_t)bk * 512 + n) * 64;
                dst[d] = valid ? (bf16_t)f2bf(o1 * cs - o2 * sn) : (bf16_t)0;
                dst[32 + d] = valid ? (bf16_t)f2bf(o2 * cs + o1 * sn) : (bf16_t)0;
            } else {
                const int pos = 32 * (n >> 5) + vperm32(n & 31);
                bf16_t* dst = (bf16_t*)(ws + OFF_VCT) + (size_t)bk * 64 * 512 + pos;
                dst[(size_t)d * 512] = valid ? (bf16_t)f2bf(o1) : (bf16_t)0;
                dst[(size_t)(d + 32) * 512] = valid ? (bf16_t)f2bf(o2) : (bf16_t)0;
            }
        }
        __syncthreads();
    }
}
__device__ __forceinline__ bf16x8 pack_p(const f32x4 a, const f32x4 b) {
    u32x4 w; w.x = cvt_pk_bf16(a[0], a[1]); w.y = cvt_pk_bf16(a[2], a[3]); w.z = cvt_pk_bf16(b[0], b[1]); w.w = cvt_pk_bf16(b[2], b[3]);
    return __builtin_bit_cast(bf16x8, w);
}
__device__ __forceinline__ f32x4 mfma16(const bf16x8 a, const bf16x8 b, const f32x4 c) { return __builtin_amdgcn_mfma_f32_16x16x32_bf16(a, b, c, 0, 0, 0); }
#define ZERO4 ((f32x4){0.f, 0.f, 0.f, 0.f})
__device__ __forceinline__ float xq_max(float x) {
    float a = x, b = x; swap16(a, b); float y = fmaxf(a, b);
    a = y; b = y; swap32(a, b); return fmaxf(a, b);
}
__device__ __forceinline__ float xq_sum(float x) {
    float a = x, b = x; swap16(a, b); float y = a + b;
    a = y; b = y; swap32(a, b); return a + b;
}
__device__ __forceinline__ float oct_sum(float x) {
    x += __builtin_bit_cast(float, __builtin_amdgcn_update_dpp(0, __builtin_bit_cast(int, x), 0xB1, 0xf, 0xf, false));
    x += __builtin_bit_cast(float, __builtin_amdgcn_update_dpp(0, __builtin_bit_cast(int, x), 0x4E, 0xf, 0xf, false));
    x += __builtin_bit_cast(float, __builtin_amdgcn_update_dpp(0, __builtin_bit_cast(int, x), 0x141, 0xf, 0xf, false));
    return x;
}
__device__ __forceinline__ unsigned wave_umax(unsigned x) {
    unsigned t;
    t = (unsigned)__builtin_amdgcn_update_dpp(0, (int)x, 0xB1, 0xf, 0xf, false); x = t > x ? t : x;
    t = (unsigned)__builtin_amdgcn_update_dpp(0, (int)x, 0x4E, 0xf, 0xf, false); x = t > x ? t : x;
    t = (unsigned)__builtin_amdgcn_update_dpp(0, (int)x, 0x141, 0xf, 0xf, false); x = t > x ? t : x;
    t = (unsigned)__builtin_amdgcn_update_dpp(0, (int)x, 0x140, 0xf, 0xf, false); x = t > x ? t : x;
    const unsigned a = __builtin_amdgcn_readlane(x, 0), b = __builtin_amdgcn_readlane(x, 16), c = __builtin_amdgcn_readlane(x, 32), d = __builtin_amdgcn_readlane(x, 48);
    const unsigned ab = a > b ? a : b, cd = c > d ? c : d; return ab > cd ? ab : cd;
}
__device__ __forceinline__ int swz128(int row, int ch) { return row * 128 + ((ch ^ ((row >> 1) & 7)) << 4); }
__device__ __forceinline__ int swz1024(int row, int ch) { return row * 1024 + ((ch ^ (row & 15)) << 4); }

constexpr int CMP_LDS_K = 0, CMP_LDS_V = 65536, CMP_LDS_IMP = 131072, CMP_LDS_SC = 131072 + 8192;
__device__ __forceinline__ void nsa_cmp_stage(const Params& p, LAS unsigned char* lds, int bk) {
    const int tid = opqv(threadIdx.x);
    const u32x4* kc = (const u32x4*)(opqp(p.ws) + OFF_KC) + (size_t)bk * 4096;
    const u32x4* vc = (const u32x4*)(opqp(p.ws) + OFF_VCT) + (size_t)bk * 4096;
    for (int i = tid; i < 4096; i += NTHREADS) {
        *(LAS u32x4*)(lds + CMP_LDS_K + swz128(i >> 3, i & 7)) = kc[i];
        *(LAS u32x4*)(lds + CMP_LDS_V + swz1024(i >> 6, i & 63)) = vc[i];
    }
}
__device__ __forceinline__ void nsa_cmp_unit(const Params& p, LAS unsigned char* lds, int bk, int qt) {
    const int tid = opqv(threadIdx.x), lane = tid & 63, wave = __builtin_amdgcn_readfirstlane(tid >> 6);
    const int qrow = lane & 15, q = lane >> 4, b = bk >> 1, kvh = bk & 1;
    unsigned char* ws = opqp(p.ws);
    const int t0 = qt * 16 + wave * 2, tok = t0 + (qrow >> 3), head = kvh * 8 + (qrow & 7);
    const bf16_t* qp = (const bf16_t*)(ws + OFF_QR) + (size_t)(b * SEQ + tok) * 1024 + head * 64 + 8 * q;
    const bf16x8 qf0 = *(const bf16x8*)qp, qf1 = *(const bf16x8*)(qp + 32);
    const int nv = tok >= 31 ? ((tok - 31) >> 4) + 1 : 0;
    const int nvmax = (t0 + 1) >= 31 ? ((t0 + 1 - 31) >> 4) + 1 : 0;
    const int NBk = (nvmax + 15) >> 4;
    f32x4 S[32];
#pragma unroll
    for (int jb = 0; jb < 32; ++jb) {
        S[jb] = ZERO4;
        if (jb < NBk) {
            const bf16x8 a0 = *(const LAS bf16x8*)(lds + CMP_LDS_K + swz128(16 * jb + qrow, q)), a1 = *(const LAS bf16x8*)(lds + CMP_LDS_K + swz128(16 * jb + qrow, 4 + q));
            S[jb] = mfma16(a1, qf1, mfma16(a0, qf0, ZERO4));
        }
        if ((jb & 3) == 3) __builtin_amdgcn_sched_barrier(0);
    }
    float m = -1e30f;
    int c0 = opqv(4 * q), c1 = opqv(4 * q + 1), c2 = opqv(4 * q + 2), c3 = opqv(4 * q + 3);
    const int cr[4] = {c0, c1, c2, c3};
    const int nv0 = t0 >= 31 ? ((t0 - 31) >> 4) + 1 : 0;
#pragma unroll
    for (int jb = 0; jb < 32; ++jb) if (jb < NBk) {
        if (16 * jb + 16 > nv0) {
            const int rem = nv - 16 * jb;
#pragma unroll
            for (int r = 0; r < 4; ++r) S[jb][r] = (cr[r] < rem) ? S[jb][r] : -1e30f;
        }
        m = fmaxf(m, fmaxf(fmaxf(S[jb][0], S[jb][1]), fmaxf(S[jb][2], S[jb][3])));
        if ((jb & 7) == 7) __builtin_amdgcn_sched_barrier(0);
    }
    m = xq_max(m);
    float l = 0.f;
    constexpr float L2E = 1.4426950408889634f;
#pragma unroll
    for (int jb = 0; jb < 32; ++jb) if (jb < NBk) {
#pragma unroll
        for (int r = 0; r < 4; ++r) { const float e = __builtin_amdgcn_exp2f((S[jb][r] - m) * L2E); S[jb][r] = e; l += e; }
        if ((jb & 3) == 3) __builtin_amdgcn_sched_barrier(0);
    }
    l = xq_sum(l);
    const float linv = (l > 0.f && nv > 0) ? 1.f / l : 0.f;
#pragma unroll
    for (int jb = 0; jb < 32; ++jb) if (jb < NBk) S[jb] = S[jb] * linv;
    LAS float* impL = (LAS float*)(lds + CMP_LDS_IMP + wave * 1024);
#pragma unroll
    for (int jb = 0; jb < 32; ++jb) {
        const float rs = (S[jb][0] + S[jb][1]) + (S[jb][2] + S[jb][3]);
        const float prev3 = jb > 0 ? S[jb > 0 ? jb - 1 : 0][3] : 0.f;
        const float prov = (q == 3) ? prev3 : S[jb][3];
        const float nbv = __shfl(prov, (lane - 16) & 63);
        float im = rs + nbv;
        im = oct_sum(im);
        if ((lane & 7) == 0) impL[(qrow >> 3) * 128 + 4 * jb + q] = im;
        if ((jb & 3) == 3) __builtin_amdgcn_sched_barrier(0);
    }
    LDS_WAIT();
    int* selo = (int*)(ws + OFF_SEL);
#pragma unroll 1
    for (int tk = 0; tk < 2; ++tk) {
        const int tokn = t0 + tk, cur = tokn >> 6;
        const int sa = lane, sb = lane + 64;
        const bool fa = (sa == 0) | (sa == cur) | (sa == cur - 1), fb = (sb == cur) | (sb == cur - 1);
        const float ia = impL[tk * 128 + sa], ib = impL[tk * 128 + sb];
        unsigned ka = (!fa && sa <= cur) ? (0x80000000u | ((__builtin_bit_cast(unsigned, ia) >> 8) << 7) | (unsigned)(127 - sa)) : 0u;
        unsigned kb = (!fb && sb <= cur) ? (0x80000000u | ((__builtin_bit_cast(unsigned, ib) >> 8) << 7) | (unsigned)(127 - sb)) : 0u;
        int* so = selo + ((size_t)bk * SEQ + tokn) * 16;
        int nf = 1;
        if (lane == 0) { so[0] = 0; if (cur >= 2) { so[1] = cur - 1; so[2] = cur; } else if (cur == 1) so[1] = 1; }
        nf = cur >= 2 ? 3 : (cur == 1 ? 2 : 1);
#pragma unroll 1
        for (int r = nf; r < 16; ++r) {
            const unsigned k = wave_umax(ka > kb ? ka : kb);
            if (k == 0u) { if (lane == 0) so[r] = 127; continue; }
            if (ka == k) ka = 0u;
            if (kb == k) kb = 0u;
            if (lane == 0) so[r] = 127 - (int)(k & 127u);
        }
    }
    f32x4 O[4] = {ZERO4, ZERO4, ZERO4, ZERO4};
#pragma unroll
    for (int s32 = 0; s32 < 16; ++s32) if (2 * s32 < NBk) {
        const bf16x8 pb = pack_p(S[2 * s32], S[2 * s32 + 1]);
#pragma unroll
        for (int dg = 0; dg < 4; ++dg) { const bf16x8 va = *(const LAS bf16x8*)(lds + CMP_LDS_V + swz1024(16 * dg + qrow, 4 * s32 + q)); O[dg] = mfma16(va, pb, O[dg]); }
    }
    const float gate = ((const float*)(ws + OFF_GATES))[(size_t)(b * SEQ + tok) * 48 + head * 3 + 0];
    bf16_t* yo = (bf16_t*)(ws + OFF_SLOT64) + (size_t)(b * SEQ + tok) * 1024 + head * 64 + 4 * q;
#pragma unroll
    for (int dg = 0; dg < 4; ++dg) *(u32x2*)(yo + 16 * dg) = (u32x2){pk2(O[dg][0] * gate, O[dg][1] * gate), pk2(O[dg][2] * gate, O[dg][3] * gate)};
}

__device__ __forceinline__ void nsa_win_unit(const Params& p, LAS unsigned char* lds, int bk, int kb64) {
    const int tid = opqv(threadIdx.x), lane = tid & 63, wave = __builtin_amdgcn_readfirstlane(tid >> 6);
    const int qrow = lane & 15, q = lane >> 4, b = bk >> 1, kvh = bk & 1;
    unsigned char* ws = opqp(p.ws);
    const int t0 = kb64 * 64, kt_lo = kb64 > 8 ? kb64 - 8 : 0, ntile = kb64 - kt_lo + 1;
    const u32x4* Kg = (const u32x4*)(ws + OFF_KWIN) + (size_t)bk * SEQ * 8 + (size_t)kt_lo * 512;
    const u32x4* Vg = (const u32x4*)(ws + OFF_VWINT) + (size_t)bk * 128 * 512 + (size_t)kt_lo * 512;
    __syncthreads();
    for (int i = 0; i < ntile; ++i) {
        *(LAS u32x4*)(lds + i * 16384 + swz128(tid >> 3, tid & 7)) = Kg[(size_t)i * 512 + tid];
        *(LAS u32x4*)(lds + i * 16384 + 8192 + swz128(tid >> 3, tid & 7)) = Vg[(size_t)i * 512 + tid];
    }
    __syncthreads();
#pragma unroll 1
    for (int ss = 0; ss < 4; ++ss) {
        const int tok = t0 + 16 * ss + wave * 2 + (qrow >> 3), head = kvh * 8 + (qrow & 7);
        const bf16_t* qp = (const bf16_t*)(ws + OFF_QR) + (size_t)(b * SEQ + tok) * 1024 + head * 64 + 8 * q;
        const bf16x8 qf0 = *(const bf16x8*)qp, qf1 = *(const bf16x8*)(qp + 32);
        float m_run = -1e30f, l_run = 0.f;
        f32x4 O[4] = {ZERO4, ZERO4, ZERO4, ZERO4};
#pragma unroll 1
        for (int i = 0; i < ntile; ++i) {
            const int kt = kt_lo + i;
            LAS unsigned char* kl = lds + i * 16384; LAS unsigned char* vl = kl + 8192;
            f32x4 S[4]; float mt = -1e30f;
#pragma unroll
            for (int kb = 0; kb < 4; ++kb) {
                const bf16x8 a0 = *(const LAS bf16x8*)(kl + swz128(16 * kb + qrow, q)), a1 = *(const LAS bf16x8*)(kl + swz128(16 * kb + qrow, 4 + q));
                S[kb] = mfma16(a1, qf1, mfma16(a0, qf0, ZERO4));
            }
            if (kt == kb64 || kt + 8 <= kb64) {
#pragma unroll
                for (int kb = 0; kb < 4; ++kb)
#pragma unroll
                    for (int r = 0; r < 4; ++r) { const int kp = kt * 64 + 16 * kb + 4 * q + r; const bool ok = (kp <= tok) & (kp > tok - WINDOW); S[kb][r] = ok ? S[kb][r] : -1e30f; }
            }
#pragma unroll
            for (int kb = 0; kb < 4; ++kb) mt = fmaxf(mt, fmaxf(fmaxf(S[kb][0], S[kb][1]), fmaxf(S[kb][2], S[kb][3])));
            mt = xq_max(mt);
            constexpr float L2E = 1.4426950408889634f;
            const float m_new = fmaxf(m_run, mt), alpha = __builtin_amdgcn_exp2f((m_run - m_new) * L2E);
            float ls = 0.f;
            if (m_new > -1e29f) {
#pragma unroll
                for (int kb = 0; kb < 4; ++kb)
#pragma unroll
                    for (int r = 0; r < 4; ++r) { const float e = __builtin_amdgcn_exp2f((S[kb][r] - m_new) * L2E); S[kb][r] = e; ls += e; }
            } else {
#pragma unroll
                for (int kb = 0; kb < 4; ++kb) S[kb] = ZERO4;
            }
            l_run = l_run * alpha + ls; m_run = m_new;
#pragma unroll
            for (int dg = 0; dg < 4; ++dg) O[dg] = O[dg] * alpha;
#pragma unroll
            for (int s32 = 0; s32 < 2; ++s32) {
                const bf16x8 pb = pack_p(S[2 * s32], S[2 * s32 + 1]);
#pragma unroll
                for (int dg = 0; dg < 4; ++dg) { const bf16x8 va = *(const LAS bf16x8*)(vl + swz128(16 * dg + qrow, 4 * s32 + q)); O[dg] = mfma16(va, pb, O[dg]); }
            }
        }
        l_run = xq_sum(l_run);
        const float gate = ((const float*)(ws + OFF_GATES))[(size_t)(b * SEQ + tok) * 48 + head * 3 + 2];
        const float sc = l_run > 0.f ? gate / l_run : 0.f;
        bf16_t* yo = (bf16_t*)(ws + OFF_SLOT64) + (size_t)T_TOK * 1024 + (size_t)(b * SEQ + tok) * 1024 + head * 64 + 4 * q;
#pragma unroll
        for (int dg = 0; dg < 4; ++dg) *(u32x2*)(yo + 16 * dg) = (u32x2){pk2(O[dg][0] * sc, O[dg][1] * sc), pk2(O[dg][2] * sc, O[dg][3] * sc)};
    }
}

typedef long l2 __attribute__((ext_vector_type(2)));
__device__ __forceinline__ f32x4 mfma8(long a, long b, const f32x4 c) { return __builtin_amdgcn_mfma_f32_16x16x32_fp8_fp8(a, b, c, 0, 0, 0); }
__device__ __forceinline__ long pack_p8(const f32x4 a, const f32x4 b) { const unsigned lo = pk4_fp8(a[0], a[1], a[2], a[3]), hi = pk4_fp8(b[0], b[1], b[2], b[3]); return (long)(((unsigned long long)hi << 32) | lo); }
__device__ __forceinline__ void sel_ld(l2 (&d)[4], const char* gblk, int lane) {
    const GAS l2* src = (const GAS l2*)(unsigned long long)gblk + lane;
#pragma unroll
    for (int i = 0; i < 4; ++i) d[i] = src[64 * i];
}
__device__ __forceinline__ void sel_iter(l2 (&kA)[4], l2 (&kB)[4], l2 (&vA)[4], l2 (&vB)[4], const long (&qA)[2], const long (&qB)[2], f32x4 (&O)[4], float& m_run, float& l_run,
                                         int s0, int s1, int sn0, int sn1, const char* Kg, const char* Vg, int cur, int tokm, bool lo, int q, int lane) {
    constexpr float SC = 0.125f * 1.4426950408889634f;
    f32x4 S[4];
#pragma unroll
    for (int kb = 0; kb < 4; ++kb) S[kb] = mfma8(kA[kb][0], qA[0], ZERO4);
#pragma unroll
    for (int kb = 0; kb < 4; ++kb) S[kb] = mfma8(kA[kb][1], qA[1], S[kb]);
#pragma unroll
    for (int kb = 0; kb < 4; ++kb) S[kb] = mfma8(kB[kb][0], qB[0], S[kb]);
#pragma unroll
    for (int kb = 0; kb < 4; ++kb) S[kb] = mfma8(kB[kb][1], qB[1], S[kb]);
    __builtin_amdgcn_sched_barrier(0);
    sel_ld(kA, Kg + (size_t)sn0 * 4096, lane); sel_ld(kB, Kg + (size_t)sn1 * 4096, lane);
    __builtin_amdgcn_sched_barrier(0);
    if (s0 == cur || s1 == cur) {
        const int lim = tokm - (lo ? s0 : s1) * 64 - 4 * q;
#pragma unroll
        for (int kb = 0; kb < 4; ++kb)
#pragma unroll
            for (int r = 0; r < 4; ++r) S[kb][r] = (16 * kb + r <= lim) ? S[kb][r] : -1e30f;
    }
    float mt = -1e30f;
#pragma unroll
    for (int kb = 0; kb < 4; ++kb) mt = fmaxf(mt, fmaxf(fmaxf(S[kb][0], S[kb][1]), fmaxf(S[kb][2], S[kb][3])));
    mt = xq_max(mt);
    const float m_new = fmaxf(m_run, mt), alpha = __builtin_amdgcn_exp2f((m_run - m_new) * SC);
    const float mb = m_new * SC;
    float ls = 0.f;
#pragma unroll
    for (int kb = 0; kb < 4; ++kb)
#pragma unroll
        for (int r = 0; r < 4; ++r) { const float e = __builtin_amdgcn_exp2f(S[kb][r] * SC - mb); S[kb][r] = e; ls += e; }
    l_run = l_run * alpha + ls; m_run = m_new;
#pragma unroll
    for (int dg = 0; dg < 4; ++dg) O[dg] = O[dg] * alpha;
    const long pb0 = pack_p8(S[0], S[1]), pb1 = pack_p8(S[2], S[3]);
    const long pA0 = lo ? pb0 : 0l, pA1 = lo ? pb1 : 0l, pB0 = lo ? 0l : pb0, pB1 = lo ? 0l : pb1;
#pragma unroll
    for (int dg = 0; dg < 4; ++dg) O[dg] = mfma8(vA[dg][0], pA0, O[dg]);
#pragma unroll
    for (int dg = 0; dg < 4; ++dg) O[dg] = mfma8(vA[dg][1], pA1, O[dg]);
#pragma unroll
    for (int dg = 0; dg < 4; ++dg) O[dg] = mfma8(vB[dg][0], pB0, O[dg]);
#pragma unroll
    for (int dg = 0; dg < 4; ++dg) O[dg] = mfma8(vB[dg][1], pB1, O[dg]);
    __builtin_amdgcn_sched_barrier(0);
    sel_ld(vA, Vg + (size_t)sn0 * 4096, lane); sel_ld(vB, Vg + (size_t)sn1 * 4096, lane);
    __builtin_amdgcn_sched_barrier(0);
}
struct SelTask { int bk, tok0, b, kvh, cur, nval; const char* Kg; const char* Vg; };
__device__ __forceinline__ SelTask sel_task(unsigned char* ws, int task) {
    SelTask t; t.bk = task / (SEQ / 2); t.tok0 = (task % (SEQ / 2)) * 2; t.b = t.bk >> 1; t.kvh = t.bk & 1; t.cur = t.tok0 >> 6; t.nval = t.cur + 1 < 16 ? t.cur + 1 : 16;
    t.Kg = (const char*)(ws + OFF_KSEL) + (size_t)t.bk * SEQ * 64; t.Vg = (const char*)(ws + OFF_VSELT) + (size_t)t.bk * 128 * 4096;
    return t;
}
struct SelOps { long q0, q1; int l0, l1; };
__device__ __forceinline__ SelOps sel_ops(unsigned char* ws, const SelTask& t, int lane) {
    const int qrow = lane & 15, q = lane >> 4;
    const GAS int* selg = (const GAS int*)(unsigned long long)(ws + OFF_SEL);
    const GAS unsigned char* qp = (const GAS unsigned char*)(unsigned long long)(ws + OFF_Q8) + (size_t)(t.b * SEQ + t.tok0 + (qrow >> 3)) * 1024 + (t.kvh * 8 + (qrow & 7)) * 64 + 8 * q;
    SelOps o; o.q0 = *(const GAS long*)qp; o.q1 = *(const GAS long*)(qp + 32);
    o.l0 = selg[((size_t)t.bk * SEQ + t.tok0) * 16 + qrow]; o.l1 = selg[((size_t)t.bk * SEQ + t.tok0 + 1) * 16 + qrow];
    return o;
}
__device__ __forceinline__ void nsa_sel_phase(const Params& p, LAS unsigned char* lds, int vcu, int G) {
    const int tid = opqv(threadIdx.x), lane = tid & 63, wave = __builtin_amdgcn_readfirstlane(tid >> 6);
    const int gw = vcu * NWAVES + wave, NGW = G * NWAVES;
    const int qrow = lane & 15, q = lane >> 4;
    const bool lo = qrow < 8;
    unsigned char* ws = opqp(p.ws);
    l2 kA0[4], kB0[4], vA0[4], vB0[4], kA1[4], kB1[4], vA1[4], vB1[4];
    SelOps oc = {0l, 0l, 0, 0}, on = {0l, 0l, 0, 0};
    if (gw < 2 * SEQ) oc = sel_ops(ws, sel_task(ws, gw), lane);
    if (gw + NGW < 2 * SEQ) on = sel_ops(ws, sel_task(ws, gw + NGW), lane);
    asm volatile("" : "+v"(oc.q0), "+v"(oc.q1), "+v"(oc.l0), "+v"(oc.l1), "+v"(on.q0), "+v"(on.q1), "+v"(on.l0), "+v"(on.l1));
    bool have = false;
    for (int task = gw; task < 2 * SEQ; task += NGW) {
        const SelTask t = sel_task(ws, task);
        const int tok0 = t.tok0, b = t.b, head = t.kvh * 8 + (qrow & 7), cur = t.cur, nval = t.nval;
        const int tokm = tok0 + (qrow >> 3);
        const char* Kg = t.Kg; const char* Vg = t.Vg;
        long qA[2], qB[2];
        qA[0] = lo ? oc.q0 : 0l; qA[1] = lo ? oc.q1 : 0l; qB[0] = lo ? 0l : oc.q0; qB[1] = lo ? 0l : oc.q1;
        const int taskN = task + NGW; const bool hasN = taskN < 2 * SEQ;
        const SelTask tn = sel_task(ws, hasN ? taskN : task);
        const bool chain = hasN && nval == 16 && tn.nval == 16;
        const int selv0 = (lane & 16) ? on.l0 : oc.l0, selv1 = (lane & 16) ? on.l1 : oc.l1;
        if (!have) {
            const int a0 = __builtin_amdgcn_readlane(selv0, 0), a1 = __builtin_amdgcn_readlane(selv1, 0);
            const int j1 = nval > 1 ? 1 : 0;
            const int c0 = __builtin_amdgcn_readlane(selv0, j1), c1 = __builtin_amdgcn_readlane(selv1, j1);
            __builtin_amdgcn_sched_barrier(0);
            sel_ld(kA0, Kg + (size_t)a0 * 4096, lane); sel_ld(kB0, Kg + (size_t)a1 * 4096, lane);
            __builtin_amdgcn_sched_barrier(0);
            sel_ld(vA0, Vg + (size_t)a0 * 4096, lane); sel_ld(vB0, Vg + (size_t)a1 * 4096, lane);
            __builtin_amdgcn_sched_barrier(0);
            sel_ld(kA1, Kg + (size_t)c0 * 4096, lane); sel_ld(kB1, Kg + (size_t)c1 * 4096, lane);
            __builtin_amdgcn_sched_barrier(0);
            sel_ld(vA1, Vg + (size_t)c0 * 4096, lane); sel_ld(vB1, Vg + (size_t)c1 * 4096, lane);
            __builtin_amdgcn_sched_barrier(0);
        }
        float m_run = -1e30f, l_run = 0.f;
        f32x4 O[4] = {ZERO4, ZERO4, ZERO4, ZERO4};
        int j = 0;
#pragma unroll 1
        for (; j + 1 < nval; j += 2) {
            const bool in0 = j + 2 < nval, in1 = j + 3 < nval;
            const bool nx0 = !in0 && chain, nx1 = !in1 && chain;
            const int jn0 = in0 ? j + 2 : (chain ? 16 + j + 2 - nval : nval - 1), jn1 = in1 ? j + 3 : (chain ? 16 + j + 3 - nval : nval - 1);
            sel_iter(kA0, kB0, vA0, vB0, qA, qB, O, m_run, l_run, __builtin_amdgcn_readlane(selv0, j), __builtin_amdgcn_readlane(selv1, j),
                     __builtin_amdgcn_readlane(selv0, jn0), __builtin_amdgcn_readlane(selv1, jn0), nx0 ? tn.Kg : Kg, nx0 ? tn.Vg : Vg, cur, tokm, lo, q, lane);
            sel_iter(kA1, kB1, vA1, vB1, qA, qB, O, m_run, l_run, __builtin_amdgcn_readlane(selv0, j + 1), __builtin_amdgcn_readlane(selv1, j + 1),
                     __builtin_amdgcn_readlane(selv0, jn1), __builtin_amdgcn_readlane(selv1, jn1), nx1 ? tn.Kg : Kg, nx1 ? tn.Vg : Vg, cur, tokm, lo, q, lane);
        }
        if (j < nval) {
            const int sl0 = __builtin_amdgcn_readlane(selv0, j), sl1 = __builtin_amdgcn_readlane(selv1, j);
            sel_iter(kA0, kB0, vA0, vB0, qA, qB, O, m_run, l_run, sl0, sl1, sl0, sl1, Kg, Vg, cur, tokm, lo, q, lane);
        }
        SelOps onn = {0l, 0l, 0, 0};
        if (taskN + NGW < 2 * SEQ) onn = sel_ops(ws, sel_task(ws, taskN + NGW), lane);
        {
            const float lr = xq_sum(l_run);
            const float gate = ((const GAS float*)(unsigned long long)(ws + OFF_GATES))[(size_t)(b * SEQ + tokm) * 48 + head * 3 + 1];
            const float sc = lr > 0.f ? gate / lr : 0.f;
            const size_t ro = (size_t)(b * SEQ + tokm) * 1024 + head * 64 + 4 * q;
            const GAS bf16_t* yc = (const GAS bf16_t*)(unsigned long long)(ws + OFF_SLOT64) + ro; const GAS bf16_t* yw = yc + (size_t)T_TOK * 1024;
            GAS unsigned char* mo = (GAS unsigned char*)(unsigned long long)(ws + OFF_MIXIN) + (size_t)(b * SEQ + tokm) * 2048 + 1024 + head * 64 + 4 * q;
            u32x2 cv[4], wv[4];
#pragma unroll
            for (int dg = 0; dg < 4; ++dg) { cv[dg] = *(const GAS u32x2*)(yc + 16 * dg); wv[dg] = *(const GAS u32x2*)(yw + 16 * dg); }
#pragma unroll
            for (int dg = 0; dg < 4; ++dg) {
                const u32x2 c = cv[dg], w = wv[dg];
                const float o0 = O[dg][0] * sc + bflo(c.x) + bflo(w.x), o1 = O[dg][1] * sc + bfhi(c.x) + bfhi(w.x), o2 = O[dg][2] * sc + bflo(c.y) + bflo(w.y), o3 = O[dg][3] * sc + bfhi(c.y) + bfhi(w.y);
                *(GAS unsigned*)(mo + 16 * dg) = pk4_fp8(o0 * MIX8_SCALE, o1 * MIX8_SCALE, o2 * MIX8_SCALE, o3 * MIX8_SCALE);
            }
        }
        asm volatile("" : "+v"(onn.q0), "+v"(onn.q1), "+v"(onn.l0), "+v"(onn.l1));
        have = chain; oc = on; on = onn;
    }
}
__device__ __forceinline__ float rl(float v, int l) { return __builtin_bit_cast(float, __builtin_amdgcn_readlane(__builtin_bit_cast(int, v), l)); }

__device__ __forceinline__ void route_token(const Params& p, unsigned char* ws, int t, float logit, float rb, int lane) {
    unsigned* cnt = (unsigned*)(ws + OFF_CTL);
    int* ltok = (int*)(ws + OFF_LTOK); float* lw = (float*)(ws + OFF_LW); int* lslot = (int*)(ws + OFF_LSLOT);
    const float affin = sigmoidf_(logit);
    const float biased = affin + rb;
    float m1 = biased; m1 = fmaxf(m1, __shfl_xor(m1, 1)); m1 = fmaxf(m1, __shfl_xor(m1, 2)); m1 = fmaxf(m1, __shfl_xor(m1, 4));
    const unsigned long long bal = __ballot(biased == m1);
    const unsigned grpbits = (unsigned)((bal >> (lane & ~7)) & 0xffull);
    const int first = (lane & ~7) + __builtin_ctz(grpbits);
    float m2 = (lane == first) ? -3e38f : biased; m2 = fmaxf(m2, __shfl_xor(m2, 1)); m2 = fmaxf(m2, __shfl_xor(m2, 2)); m2 = fmaxf(m2, __shfl_xor(m2, 4));
    const float gs = m1 + m2; const int myg = lane >> 3;
    int grank = 0;
#pragma unroll
    for (int gg = 0; gg < 8; ++gg) { const float og = rl(gs, 8 * gg); grank += (og > gs) | ((og == gs) & (gg < myg)); }
    const float mv = grank < 4 ? biased : -1e30f;
    int er = 0;
#pragma unroll
    for (int e2 = 0; e2 < 64; ++e2) { const float o = rl(mv, e2); er += (o > mv) | ((o == mv) & (e2 < lane)); }
    const bool sel = er < TOPK_E;
    const float wsum = wave_sum(sel ? affin : 0.f);
    if (sel) {
        const unsigned pos = atomicAdd(&cnt[lane], 1u);
        const size_t li = (size_t)lane * LISTCAP + pos;
        ltok[li] = t; lw[li] = affin / wsum * 2.5f; lslot[li] = t * NSLOT + er;
    }
    if (lane == 0) { const size_t li = (size_t)NEXP * LISTCAP + t; ltok[li] = t; lw[li] = 1.f; lslot[li] = t * NSLOT + TOPK_E; }
}

constexpr int RT_ROWB = 4096 + 16, RT_PART = 16 * RT_ROWB;
template <bool ROUTE>
__device__ __forceinline__ void ln1_route_phase(const Params& p, LAS unsigned char* lds, int vcu, int G) {
    const int tid = opqv(threadIdx.x), lane = tid & 63, wave = __builtin_amdgcn_readfirstlane(tid >> 6);
    unsigned char* ws = opqp(p.ws);
    const bf16_t* x1 = (const bf16_t*)(ws + OFF_X1);
    const float* g1 = INP(19); const float* b1 = INP(20);
    const float rb = INP(22)[lane];
    const bf16_t* WrT = (const bf16_t*)(ws + OFF_WRT);
    LAS float* part = (LAS float*)(lds + RT_PART);
    bf16x8 wfr[8][4];
    {
        const int fr = lane & 15, q = lane >> 4;
#pragma unroll
        for (int k8 = 0; k8 < 8; ++k8)
#pragma unroll
            for (int nb = 0; nb < 4; ++nb) wfr[k8][nb] = *(const bf16x8*)(WrT + (size_t)(16 * nb + fr) * DM + 256 * wave + 32 * k8 + 8 * q);
    }
    for (int tile = vcu; tile < T_TOK / 16; tile += G) {
        const int r0 = tile * 16;
#pragma unroll
        for (int rr = 0; rr < 2; ++rr) {
            const int rl_ = 2 * wave + rr; const size_t row = (size_t)(r0 + rl_);
            const u32x2* xr = (const u32x2*)(x1 + row * DM) + lane;
            f32x4 v[8]; float s = 0.f;
#pragma unroll
            for (int j = 0; j < 8; ++j) { const u32x2 w = xr[64 * j]; v[j] = (f32x4){bflo(w.x), bfhi(w.x), bflo(w.y), bfhi(w.y)}; s += (v[j].x + v[j].y) + (v[j].z + v[j].w); }
            const float mean = wave_sum(s) * (1.f / DM); float s2 = 0.f;
#pragma unroll
            for (int j = 0; j < 8; ++j) { v[j] = v[j] - mean; s2 += (v[j].x * v[j].x + v[j].y * v[j].y) + (v[j].z * v[j].z + v[j].w * v[j].w); }
            const float rstd = 1.f / sqrtf(wave_sum(s2) * (1.f / DM) + LN_EPS);
            const f32x4* gr = (const f32x4*)g1 + lane; const f32x4* br = (const f32x4*)b1 + lane;
            u32x2* o = (u32x2*)((bf16_t*)(ws + OFF_X1B) + row * DM) + lane; unsigned* oq = (unsigned*)(ws + OFF_X1Q + row * DM) + lane;
#pragma unroll
            for (int j = 0; j < 8; ++j) {
                const f32x4 r = v[j] * rstd * gr[64 * j] + br[64 * j]; const u32x2 rb2 = (u32x2){pk2(r.x, r.y), pk2(r.z, r.w)};
                o[64 * j] = rb2; oq[64 * j] = pk4_fp8(r.x, r.y, r.z, r.w);
                *(LAS u32x2*)(lds + rl_ * RT_ROWB + (64 * j + lane) * 8) = rb2;
            }
        }
        __syncthreads();
        {
            const int fr = lane & 15, q = lane >> 4;
            f32x4 acc[4] = {(f32x4){0.f, 0.f, 0.f, 0.f}, (f32x4){0.f, 0.f, 0.f, 0.f}, (f32x4){0.f, 0.f, 0.f, 0.f}, (f32x4){0.f, 0.f, 0.f, 0.f}};
#pragma unroll
            for (int k8 = 0; k8 < 8; ++k8) {
                const int k0 = 256 * wave + 32 * k8 + 8 * q;
                const bf16x8 a = *(const LAS bf16x8*)(lds + fr * RT_ROWB + k0 * 2);
#pragma unroll
                for (int nb = 0; nb < 4; ++nb) acc[nb] = __builtin_amdgcn_mfma_f32_16x16x32_bf16(a, wfr[k8][nb], acc[nb], 0, 0, 0);
            }
#pragma unroll
            for (int nb = 0; nb < 4; ++nb)
#pragma unroll
                for (int r = 0; r < 4; ++r) part[(wave * 16 + 4 * q + r) * 64 + 16 * nb + fr] = acc[nb][r];
        }
        __syncthreads();
#pragma unroll 1
        for (int rr = 0; rr < 2; ++rr) {
            const int rl_ = 2 * wave + rr;
            float lg = 0.f;
#pragma unroll
            for (int w = 0; w < 8; ++w) lg += part[(w * 16 + rl_) * 64 + lane];
            if (ROUTE) route_token(p, ws, r0 + rl_, lg, rb, lane); else asm volatile("" :: "v"(lg));
        }
        __syncthreads();
    }
}

constexpr int MOE_LDS = 131072;
__device__ __forceinline__ void moe_tables(const Params& p, LAS unsigned char* lds) {
    const int tid = opqv(threadIdx.x);
    LAS int* tstart = (LAS int*)(lds + MOE_LDS); LAS int* roff = (LAS int*)(lds + MOE_LDS + 272); LAS int* cn = (LAS int*)(lds + MOE_LDS + 544);
    if (tid < 64) {
        const int c = (int)__hip_atomic_load((unsigned*)(opqp(p.ws) + OFF_CTL) + tid, __ATOMIC_RELAXED, __HIP_MEMORY_SCOPE_AGENT);
        const int tl = (c + 255) >> 8;
        int st = tl, sr = c;
#pragma unroll
        for (int o = 1; o < 64; o <<= 1) { const int a = __shfl_up(st, o), b = __shfl_up(sr, o); if (tid >= o) { st += a; sr += b; } }
        cn[tid] = c; tstart[tid + 1] = st; roff[tid + 1] = sr;
        if (tid == 0) { tstart[0] = 0; roff[0] = 0; }
        if (tid == 63) { cn[64] = T_TOK; tstart[65] = st + T_TOK / 256; roff[65] = sr + T_TOK; }
    }
    __syncthreads();
}
__device__ __forceinline__ void MoeOrder_prefetch_impl(const int* ltok, const Unit& u, int parity, LAS unsigned char* lds);
struct MoeOrder {
    LAS const int* tstart; LAS const int* roff; LAS const int* cn;
    int NT, nunits, G, c, K; const char* Bt; size_t bstride; const int* ltok; bool gather;
    __device__ void init(LAS unsigned char* lds, int NT_, int K_, const void* Bt_, size_t bstride_, const int* ltok_, bool gather_, int G_, int c_) {
        tstart = (LAS const int*)(lds + MOE_LDS); roff = (LAS const int*)(lds + MOE_LDS + 272); cn = (LAS const int*)(lds + MOE_LDS + 544);
        NT = NT_; K = K_; Bt = (const char*)Bt_; bstride = bstride_; ltok = ltok_; gather = gather_; G = G_; c = c_; nunits = __builtin_amdgcn_readfirstlane(tstart[NEXPS] * NT_);
    }
    __device__ __forceinline__ bool next(int i, Unit& u) const {
        const int L = i * G + c; if (L >= nunits) return false;
        const int ti = L / NT, nt = L - ti * NT;
        int e = 0;
        if (ti >= tstart[NEXP]) e = NEXP;
        else {
#pragma unroll
            for (int s = 32; s >= 1; s >>= 1) { if (tstart[e + s] <= ti) e += s; }
        }
        e = __builtin_amdgcn_readfirstlane(e);
        const int mt = __builtin_amdgcn_readfirstlane(ti - tstart[e]);
        u.e = e; u.pm = mt; u.pn = nt; u.nvalid = __builtin_amdgcn_readfirstlane(cn[e] - mt * 256); u.rowbase = __builtin_amdgcn_readfirstlane(roff[e] + mt * 256); u.bB = Bt + (size_t)e * bstride + (size_t)nt * 256 * K * 2; return true;
    }
    __device__ __forceinline__ void prefetch(const Unit& u, int parity, LAS unsigned char* lds) const { if (gather) MoeOrder_prefetch_impl(ltok, u, parity, lds); }
    __device__ __forceinline__ unsigned a_off_tab(const Unit& u, int h, int R, int C, int parity, LAS unsigned char* lds) const {
        if (!gather) return (unsigned)(((u.rowbase + h * 128 + R) * K + C) * 2);
        const int idx = *(const LAS int*)(lds + MOE_LDS + 1024 + parity * 1024 + (h * 128 + R) * 4); return (unsigned)((idx * K + C) * 2);
    }
    __device__ __forceinline__ unsigned a_off(const Unit& u, int h, int R, int C) const {
        const int r = h * 128 + R;
        if (gather) { const int tok = r < u.nvalid ? ltok[(size_t)u.e * LISTCAP + u.pm * 256 + r] : 0; return (unsigned)((tok * K + C) * 2); }
        return (unsigned)(((u.rowbase + r) * K + C) * 2);
    }
};
__device__ __forceinline__ void MoeOrder_prefetch_impl(const int* ltok, const Unit& u, int parity, LAS unsigned char* lds) {
    const int tid = threadIdx.x, wave = __builtin_amdgcn_readfirstlane(tid >> 6);
    if (wave < 4) {
        const int r = tid < u.nvalid ? tid : u.nvalid - 1;
        __builtin_amdgcn_global_load_lds((const unsigned*)(ltok + (size_t)u.e * LISTCAP + u.pm * 256 + r), (LAS unsigned*)(lds + MOE_LDS + 1024 + parity * 1024 + wave * 256), 4, 0, 0);
    }
}
__device__ __forceinline__ float silu_mul(float g, float u) { return g * u * __builtin_amdgcn_rcpf(1.f + __expf(-g)); }
template <bool SHARED> struct EpiUp {
    static constexpr int PERM = 1; static constexpr bool AFTER_DRAIN = false;
    bf16_t* H; float* logits;
    __device__ __forceinline__ void operator()(const f32x4 (&acc)[2][2][4][2], const Unit& u, int wr, int wc, int fr, int fq) const {
        const int rbase = SHARED ? u.pm * 256 : u.rowbase;
        if (SHARED && u.pn == 4) {
            if (wc < 2) {
#pragma unroll
                for (int ai = 0; ai < 2; ++ai)
#pragma unroll
                    for (int m = 0; m < 4; ++m) { float* lp = logits + (size_t)(rbase + 128 * ai + 64 * wr + 16 * m + fr) * 64 + 32 * wc + 8 * fq;
                        *(f32x4*)lp = acc[ai][0][m][0]; *(f32x4*)(lp + 4) = acc[ai][0][m][1]; }
            }
            return;
        }
#pragma unroll
        for (int ai = 0; ai < 2; ++ai)
#pragma unroll
            for (int m = 0; m < 4; ++m) {
                const int r = 128 * ai + 64 * wr + 16 * m + fr;
                if (!SHARED) {
                    if (r < u.nvalid) {
                        constexpr float IS = 1.f / W8_SCALE;
                        const f32x4 g0 = acc[ai][0][m][0] * IS, g1 = acc[ai][0][m][1] * IS, u0 = acc[ai][1][m][0] * (IS * H8_SCALE), u1 = acc[ai][1][m][1] * (IS * H8_SCALE);
                        u32x2 w; w.x = pk4_fp8(silu_mul(g0[0], u0[0]), silu_mul(g0[1], u0[1]), silu_mul(g0[2], u0[2]), silu_mul(g0[3], u0[3]));
                        w.y = pk4_fp8(silu_mul(g1[0], u1[0]), silu_mul(g1[1], u1[1]), silu_mul(g1[2], u1[2]), silu_mul(g1[3], u1[3]));
                        *(u32x2*)((unsigned char*)H + (size_t)(rbase + r) * EFF + 128 * u.pn + 32 * wc + 8 * fq) = w;
                    }
                } else {
                    const f32x4 g0 = acc[ai][0][m][0], g1 = acc[ai][0][m][1], u0 = acc[ai][1][m][0], u1 = acc[ai][1][m][1];
                    u32x4 w; w.x = cvt_pk_bf16(silu_mul(g0[0], u0[0]), silu_mul(g0[1], u0[1])); w.y = cvt_pk_bf16(silu_mul(g0[2], u0[2]), silu_mul(g0[3], u0[3]));
                    w.z = cvt_pk_bf16(silu_mul(g1[0], u1[0]), silu_mul(g1[1], u1[1])); w.w = cvt_pk_bf16(silu_mul(g1[2], u1[2]), silu_mul(g1[3], u1[3]));
                    *(u32x4*)(H + (size_t)(rbase + r) * EFF + 128 * u.pn + 32 * wc + 8 * fq) = w;
                }
            }
    }
};
struct EpiMoeDown {
    static constexpr int PERM = 2; static constexpr bool AFTER_DRAIN = false;
    unsigned char* Y; const int* lslot; const float* lw;
    __device__ __forceinline__ void operator()(const f32x4 (&acc)[2][2][4][2], const Unit& u, int wr, int wc, int fr, int fq) const {
        const int col0 = u.pn * 256 + wc * 64 + 16 * fq;
        const size_t lb = (size_t)u.e * LISTCAP + u.pm * 256 + 64 * wr + fr;
        int slot[8]; float w[8];
#pragma unroll
        for (int i = 0; i < 8; ++i) { const int r = 128 * (i >> 2) + 16 * (i & 3); const bool ok = (r + 64 * wr + fr) < u.nvalid; slot[i] = ok ? lslot[lb + r] : -1; w[i] = ok ? lw[lb + r] * (SLOT_SCALE / (W8_SCALE * H8_SCALE)) : 0.f; }
#pragma unroll
        for (int ai = 0; ai < 2; ++ai)
#pragma unroll
            for (int m = 0; m < 4; ++m) {
                const int i = ai * 4 + m;
                if (slot[i] >= 0) {
                    const f32x4 a0 = acc[ai][0][m][0] * w[i], a1 = acc[ai][0][m][1] * w[i], b0 = acc[ai][1][m][0] * w[i], b1 = acc[ai][1][m][1] * w[i];
                    u32x4 o; o.x = pk4_fp8(a0[0], a0[1], a0[2], a0[3]); o.y = pk4_fp8(a1[0], a1[1], a1[2], a1[3]); o.z = pk4_fp8(b0[0], b0[1], b0[2], b0[3]); o.w = pk4_fp8(b1[0], b1[1], b1[2], b1[3]);
                    __builtin_nontemporal_store(o, (u32x4*)(Y + (size_t)slot[i] * DM + col0));
                }
            }
    }
};
struct EpiNull {
    static constexpr int PERM = 1; static constexpr bool AFTER_DRAIN = false;
    __device__ __forceinline__ void operator()(const f32x4 (&acc)[2][2][4][2], const Unit&, int, int, int, int) const {
#pragma unroll
        for (int ai = 0; ai < 2; ++ai)
#pragma unroll
            for (int bj = 0; bj < 2; ++bj)
#pragma unroll
                for (int mm = 0; mm < 4; ++mm)
#pragma unroll
                    for (int n = 0; n < 2; ++n) asm volatile("" :: "v"(acc[ai][bj][mm][n]));
    }
};
constexpr int XC_ALL = NEXPS * 3 * 256, XC0 = 0, XC1 = XC_ALL / 4, XC2 = XC1 + (XC_ALL * 35) / 100, XC3 = XC2 + XC_ALL / 4, XC4 = XC_ALL;
#ifndef PROBE_PH
#define PROBE_PH (-1)
#endif
__global__ void __launch_bounds__(NTHREADS, 2) mega_fwd(Params p) {
    extern __shared__ __attribute__((aligned(16))) unsigned char lds_raw[];
    LAS unsigned char* lds = (LAS unsigned char*)lds_raw;
    cg::grid_group grid = cg::this_grid();
    const int G = gridDim.x, bx = blockIdx.x;
    volatile LAS unsigned* bst = (volatile LAS unsigned*)(lds + LDS_BYTES - 16);
    if (threadIdx.x < 4) bst[threadIdx.x] = 0u;
    __syncthreads();
    const XcdBarrier xbar = xcd_barrier_post((unsigned*)(opqp(p.ws) + OFF_CTL) + 4096, bst);
#define GRID_BAR() xcd_barrier(xbar)
    const int vcu = (G % 8 == 0) ? (bx % 8) * (G / 8) + bx / 8 : bx;
    const int NGW = G * NWAVES;
    unsigned char* ws = opqp(p.ws);

    for (int rep = 0; rep < (PROBE_PH == 0 ? 2 : 1); ++rep) {
    p0_prep(p, lds, vcu, G);
    asm volatile("s_waitcnt vmcnt(0)" ::: "memory");
    grid.sync();
    }
    for (int rep = 0; rep < (PROBE_PH == 1 ? 2 : 1); ++rep)
    {
        pg8::Gemm g{(const char*)(ws + OFF_X8)}; constexpr int K_g = DM / 2, KS_g = 128; pg8::DenseOrder S; S.init(T_TOK, PROJ_LD, DM / 2, ws + OFF_WINT, G, bx);
        EpiStoreBf16 E{(bf16_t*)(ws + OFF_PROJ), PROJ_LD, 1.f / W8_SCALE};
        if ((vcu & 1) && rep == 0) { expert_convert(p, lds, vcu, G, XC0, XC1 - XC0); __syncthreads(); }
        pg8::gemm_phase<K_g, KS_g, true>(lds, g, S, E);
        if (!(vcu & 1) && rep == 0) { __syncthreads(); expert_convert(p, lds, vcu, G, XC0, XC1 - XC0); }
        GRID_BAR();
    }
    for (int rep = 0; rep < (PROBE_PH == 2 ? 2 : 1); ++rep) {
    nsa_rope_layout(p, lds, vcu, G);
    if (PROBE_PH == 20) nsa_rope_layout(p, lds, vcu, G);
    __syncthreads();
    nsa_vtranspose(p, lds, vcu, G);
    __syncthreads();
    s5_pass<false>(p, lds, vcu, G);
    if (PROBE_PH == 22) s5_pass<false>(p, lds, vcu, G);
    __syncthreads();
    nsa_compress(p, lds, vcu, G);
    if (PROBE_PH == 23) nsa_compress(p, lds, vcu, G);
    GRID_BAR();
    }
    for (int rep = 0; rep < (PROBE_PH == 4 ? 2 : 1); ++rep) {
    if ((vcu & 1) && rep == 0) { expert_convert(p, lds, vcu, G, XC1, XC2 - XC1); __syncthreads(); }
    s5_pass<true>(p, lds, vcu, G);
    if (PROBE_PH == 40) s5_pass<true>(p, lds, vcu, G);
    for (int r1 = 0; r1 < (PROBE_PH == 41 ? 2 : 1); ++r1) {
        if (G == 256) {
            const int bk = vcu >> 6, w6 = vcu & 63;
            __syncthreads();
            nsa_cmp_stage(p, lds, bk);
            __syncthreads();
#pragma unroll 1
            for (int k = 0; k < 8; ++k) nsa_cmp_unit(p, lds, bk, 64 * k + ((k & 1) ? 63 - w6 : w6));
        } else {
            for (int bk = 0; bk < 4; ++bk) {
                __syncthreads();
                nsa_cmp_stage(p, lds, bk);
                __syncthreads();
                for (int qt = vcu; qt < 512; qt += G) nsa_cmp_unit(p, lds, bk, qt);
            }
        }
    }
    for (int r2 = 0; r2 < (PROBE_PH == 42 ? 2 : 1); ++r2)
    for (int k = 0; k < 2; ++k) { const int u = k ? 511 - vcu : vcu; if (G == 256 || k == 0) for (int uu = u; uu < 512; uu += (G == 256 ? 512 : G)) nsa_win_unit(p, lds, uu >> 7, uu & 127); }
    if (!(vcu & 1) && rep == 0) { __syncthreads(); expert_convert(p, lds, vcu, G, XC1, XC2 - XC1); }
    GRID_BAR();
    }
    for (int rep = 0; rep < (PROBE_PH == 5 ? 2 : 1); ++rep) {
    if ((vcu & 1) && rep == 0) { expert_convert(p, lds, vcu, G, XC2, XC3 - XC2); __syncthreads(); }
    {
        pg8::Gemm g{(const char*)(ws + OFF_YGELU)}; constexpr int K_g = 1024, KS_g = 128; pg8::DenseOrder S; S.init(T_TOK, 1024, 1024, ws + OFF_WGLUT, G, bx);
        EpiGlu E{(const bf16_t*)(ws + OFF_YGELU), (unsigned char*)(ws + OFF_MIXIN)};
        pg8::gemm_phase<K_g, KS_g>(lds, g, S, E);
    }
    nsa_sel_phase(p, lds, vcu, G);
    if (PROBE_PH == 51) nsa_sel_phase(p, lds, vcu, G);
    if (!(vcu & 1) && rep == 0) { __syncthreads(); expert_convert(p, lds, vcu, G, XC2, XC3 - XC2); }
    GRID_BAR();
    }
    {
        pg8::Gemm g{(const char*)(ws + OFF_MIXIN)}; constexpr int K_g = DM / 2, KS_g = 128; pg8::DenseOrder S; S.init(T_TOK, DM, DM / 2, ws + OFF_WOUTT, G, bx);
        EpiResBf16 E{(const bf16_t*)(ws + OFF_XB), (bf16_t*)(ws + OFF_X1)};
        if (vcu & 1) { expert_convert(p, lds, vcu, G, XC3, XC4 - XC3); __syncthreads(); }
        pg8::gemm_phase<K_g, KS_g, true>(lds, g, S, E);
        if (!(vcu & 1)) { __syncthreads(); expert_convert(p, lds, vcu, G, XC3, XC4 - XC3); }
        if (PROBE_PH == 6) { GRID_BAR(); pg8::gemm_phase<K_g, KS_g, true>(lds, g, S, E); }
    }
    GRID_BAR();
    if (PROBE_PH == 7) { ln1_route_phase<false>(p, lds, vcu, G); GRID_BAR(); }
    ln1_route_phase<true>(p, lds, vcu, G);
    GRID_BAR();
    for (int rep = 0; rep < (PROBE_PH == 11 ? 2 : 1); ++rep) {
    {
        moe_tables(p, lds);
        pg8::Gemm g{(const char*)(ws + OFF_X1Q)}; constexpr int K_g = DM / 2, KS_g = 128; MoeOrder S; S.init(lds, 4, DM / 2, ws + OFF_WEUPT, (size_t)1024 * DM, (const int*)(ws + OFF_LTOK), true, G, bx);
        EpiUp<false> E{(bf16_t*)(ws + OFF_H), nullptr};
        pg8::gemm_phase<K_g, KS_g, true>(lds, g, S, E);
        if (PROBE_PH == 112) { EpiNull EN; pg8::gemm_phase<K_g, KS_g, true>(lds, g, S, EN); }
    }
    GRID_BAR();
    }
    for (int rep = 0; rep < (PROBE_PH == 12 ? 2 : 1); ++rep) {
    {
        pg8::Gemm g{(const char*)(ws + OFF_H)}; constexpr int K_g = EFF / 2, KS_g = 128; MoeOrder S; S.init(lds, 8, EFF / 2, ws + OFF_WEDT, (size_t)DM * EFF, nullptr, false, G, bx);
        EpiMoeDown E{(unsigned char*)(ws + OFF_YSLOT), (const int*)(ws + OFF_LSLOT), (const float*)(ws + OFF_LW)};
        pg8::gemm_phase<K_g, KS_g, true>(lds, g, S, E);
        if (PROBE_PH == 120) pg8::gemm_phase<K_g, KS_g, true>(lds, g, S, E);
        if (PROBE_PH == 122) { EpiNull EN; pg8::gemm_phase<K_g, KS_g, true>(lds, g, S, EN); }
    }
    GRID_BAR();
    }
    const int tid = opqv(threadIdx.x), lane = tid & 63, gw = vcu * NWAVES + (tid >> 6);
    f32x4 g2v[8], b2v[8];
#pragma unroll
    for (int j = 0; j < 8; ++j) { g2v[j] = ((const f32x4*)INP(29))[lane + 64 * j]; b2v[j] = ((const f32x4*)INP(30))[lane + 64 * j]; }
    for (int rep = 0; rep < (PROBE_PH == 14 ? 2 : 1); ++rep)
    for (int m = gw; m < T_TOK; m += NGW) ln_row<NSLOT>((const bf16_t*)(ws + OFF_X1B) + (size_t)m * DM, ALPHA, (const unsigned char*)(ws + OFF_YSLOT) + (size_t)m * NSLOT * DM, g2v, b2v, p.out + (size_t)m * DM, nullptr, nullptr, lane);
}
extern "C" void kernel_launch(void* const* d_in, const int* in_sizes, int n_in, void* d_out, int out_size, void* d_ws, size_t ws_size, hipStream_t stream) {
    static int grid = 0;
    if (grid == 0) {
        int dev = 0, cus = 0, per_cu = 0;
        (void)hipGetDevice(&dev);
        (void)hipDeviceGetAttribute(&cus, hipDeviceAttributeMultiprocessorCount, dev);
        (void)hipFuncSetAttribute((const void*)mega_fwd, hipFuncAttributeMaxDynamicSharedMemorySize, LDS_BYTES);
        (void)hipOccupancyMaxActiveBlocksPerMultiprocessor(&per_cu, (const void*)mega_fwd, NTHREADS, LDS_BYTES);
        if (per_cu < 1) { fprintf(stderr, "kernel_launch: occupancy query says %d blocks/CU\n", per_cu); }
        grid = cus;
        if (n_in != 31 || ws_size < WS_NEED) { fprintf(stderr, "kernel_launch: n_in %d ws %zu (need %zu): nothing launched\n", n_in, ws_size, (size_t)WS_NEED); grid = -1; }
    }
    if (grid < 0) return;
    if (hipMemsetAsync(d_ws, 0, 65536, stream) != hipSuccess) { fprintf(stderr, "kernel_launch: memset failed\n"); return; }
    Params p{};
    for (int i = 0; i < 31; ++i) p.in[i] = (const float*)d_in[i];
    p.out = (float*)d_out; p.ws = (unsigned char*)d_ws; p.ws_size = ws_size;
    void* args[] = {&p};
    hipError_t e = hipLaunchCooperativeKernel((const void*)mega_fwd, dim3(grid), dim3(NTHREADS), args, LDS_BYTES, stream);
    if (e != hipSuccess) fprintf(stderr, "kernel_launch: cooperative launch failed: %s (grid %d)\n", hipGetErrorString(e), grid);
}
```

```cpp
#include <hip/hip_runtime.h>
#include <hip/hip_cooperative_groups.h>
#include <cstdio>
#include <cstdint>
namespace cg = cooperative_groups;

#define LAS __attribute__((address_space(3)))
#define GAS __attribute__((address_space(1)))
typedef unsigned short bf16_t;
typedef short bf16x8 __attribute__((ext_vector_type(8)));
typedef float f32x4 __attribute__((ext_vector_type(4)));
typedef float f32x2 __attribute__((ext_vector_type(2)));
typedef unsigned u32x4 __attribute__((ext_vector_type(4)));
typedef unsigned u32x2 __attribute__((ext_vector_type(2)));

constexpr int NTHREADS = 512, NWAVES = 8;
constexpr int NB = 2, SEQ = 8192, T_TOK = NB * SEQ, DM = 2048;
constexpr int IN_COLS = 2864, PROJ_LD = 3072;
constexpr int SSM_W = 1024, NGRP = 64, NSTATE = 64;
constexpr int NHEAD = 16, NKVH = 2, HD = 64;
constexpr int COL_Q = 1024, COL_KC = 2048, COL_VC = 2176, COL_KS = 2304, COL_VS = 2432, COL_KW = 2560, COL_VW = 2688, COL_G = 2816;
constexpr int NCMP = 511, NSEL = 128, TOPK_SEL = 16, WINDOW = 512;
constexpr int NEXP = 64, TOPK_E = 8, EFF = 512, LISTCAP = T_TOK;
constexpr int NEXPS = NEXP + 1, NSLOT = TOPK_E + 1;
constexpr float ALPHA = 1.189207115002721f;
constexpr float LN_EPS = 1e-5f;
constexpr int S5_SEG = 256, S5_NSEG = SEQ / S5_SEG;

constexpr size_t MiB = 1ull << 20;
constexpr size_t OFF_CTL = 0;
constexpr size_t OFF_S5A = 1 * MiB;
constexpr size_t OFF_S5AC = OFF_S5A + 64 * 1024;
constexpr size_t OFF_S5BB = OFF_S5AC + 64 * 1024;
constexpr size_t OFF_S5CF = 2 * MiB;
constexpr size_t OFF_CBIAS = OFF_S5CF + 256 * 1024;
constexpr size_t OFF_WRT = 2 * MiB + 512 * 1024;
constexpr size_t OFF_KC = 3 * MiB;
constexpr size_t OFF_VCT = OFF_KC + 256 * 1024;
constexpr size_t OFF_SEL = 4 * MiB;
constexpr size_t OFF_E = 6 * MiB;
constexpr size_t OFF_LOGITS = 14 * MiB;
constexpr size_t OFF_LTOK = 14 * MiB;
constexpr size_t OFF_LW = 19 * MiB;
constexpr size_t OFF_LSLOT = 24 * MiB;
constexpr size_t OFF_LROW = 6 * MiB;
constexpr size_t OFF_WEDT = 30 * MiB;
constexpr size_t OFF_WSDT = 158 * MiB;
constexpr size_t OFF_X1 = 160 * MiB;
constexpr size_t OFF_X1B = 95 * MiB;
constexpr size_t OFF_HS = 288 * MiB;
constexpr size_t OFF_H = 304 * MiB;
constexpr size_t OFF_X1Q = 400 * MiB;
constexpr size_t OFF_YGELU = 304 * MiB;
constexpr size_t OFF_MIXIN = 336 * MiB;
constexpr size_t OFF_YSLOT = 433 * MiB;
constexpr size_t OFF_WEUPT = 433 * MiB;
constexpr size_t OFF_WINT = 689 * MiB;
constexpr size_t OFF_WGLUT = 701 * MiB;
constexpr size_t OFF_WOUTT = 703 * MiB;
constexpr size_t OFF_WSUPT = 711 * MiB;
constexpr size_t OFF_WC1T = 716 * MiB;
constexpr size_t OFF_SLOT64 = 717 * MiB;
constexpr size_t OFF_PROJ = 781 * MiB;
constexpr size_t OFF_QR = 877 * MiB;
constexpr size_t OFF_KSEL = 909 * MiB;
constexpr size_t OFF_VSELT = 913 * MiB;
constexpr size_t OFF_KWIN = 917 * MiB;
constexpr size_t OFF_VWINT = 921 * MiB;
constexpr size_t OFF_GATES = 925 * MiB;
constexpr size_t OFF_Q8 = 928 * MiB;
constexpr size_t OFF_XB = 945 * MiB;
constexpr size_t OFF_X8 = 877 * MiB;
constexpr size_t WS_NEED = 1009 * MiB;

constexpr int LDS_BYTES = 163840;

struct Params {
    const float* in[31];
    float* out;
    unsigned char* ws;
    size_t ws_size;
};

__device__ __forceinline__ int opq(int i) { asm volatile("" : "+s"(i)); return i; }
__device__ __forceinline__ unsigned char* opqp(unsigned char* q) { unsigned long long v = (unsigned long long)q; asm volatile("" : "+s"(v)); return (unsigned char*)(GAS unsigned char*)v; }
__device__ __forceinline__ int opqv(int v) { asm volatile("" : "+v"(v)); return v; }
__device__ __forceinline__ unsigned char* opqf(unsigned char* q) { unsigned long long v = (unsigned long long)q; asm volatile("" : "+s"(v)); return (unsigned char*)v; }
#define INP(i) (p.in[opq(i)])
__device__ __forceinline__ unsigned f2bf(float f) { unsigned u = __builtin_bit_cast(unsigned, f); return (u + 0x7fffu + ((u >> 16) & 1u)) >> 16; }
typedef __bf16 bf16x2_t __attribute__((ext_vector_type(2)));
__device__ __forceinline__ unsigned cvt_pk_bf16(float lo, float hi) { const f32x2 v = {lo, hi}; const bf16x2_t b = __builtin_convertvector(v, bf16x2_t); return __builtin_bit_cast(unsigned, b); }
__device__ __forceinline__ unsigned pk2(float lo, float hi) { return cvt_pk_bf16(lo, hi); }
__device__ __forceinline__ float bf2f(unsigned b) { return __builtin_bit_cast(float, b << 16); }
__device__ __forceinline__ float bflo(unsigned w) { return __builtin_bit_cast(float, w << 16); }
__device__ __forceinline__ float bfhi(unsigned w) { return __builtin_bit_cast(float, w & 0xffff0000u); }
__device__ __forceinline__ void swap16(float& a, float& b) { asm volatile("s_nop 1\n\tv_permlane16_swap_b32 %0, %1" : "+v"(a), "+v"(b)); }
__device__ __forceinline__ void swap32(float& a, float& b) { asm volatile("s_nop 1\n\tv_permlane32_swap_b32 %0, %1" : "+v"(a), "+v"(b)); }
__device__ __forceinline__ float wave_sum(float v) {
#pragma unroll
    for (int o = 1; o < 64; o <<= 1) v += __shfl_xor(v, o);
    return v;
}
__device__ __forceinline__ float gelu_tanh(float x) {
    const float z = 0.7978845608028654f * (x + 0.044715f * x * x * x);
    const float e = __expf(2.f * z);
    const float th = 1.f - 2.f * __builtin_amdgcn_rcpf(e + 1.f);
    return 0.5f * x * (1.f + th);
}
__device__ __forceinline__ unsigned pk4_fp8(float a, float b, float c2, float d) { unsigned w = 0; w = __builtin_amdgcn_cvt_pk_fp8_f32(a, b, w, false); w = __builtin_amdgcn_cvt_pk_fp8_f32(c2, d, w, true); return w; }
constexpr float W8_SCALE = 256.f, H8_SCALE = 8.f, SLOT_SCALE = 64.f, MIX8_SCALE = 8.f;
__device__ __forceinline__ float sigmoidf_(float x) { return __builtin_amdgcn_rcpf(1.f + __expf(-x)); }
#define LDS_WAIT() asm volatile("s_waitcnt lgkmcnt(0)" ::: "memory")
#define GAS __attribute__((address_space(1)))
#define XB_TMO      128
#define XB_XCNT(j)  (256  + 64 * (j))
#define XB_XSUB(j)  (1280 + 64 * (j))
#define XB_XGEN(j)  (2304 + 64 * (j))
#define XB_TOP      3328
#define XB_TOPGEN   3392
#define XCD_BAR_WORDS 3456
#define XB_SPIN_CAP (1u << 18)

__device__ __forceinline__ unsigned xb_ld(unsigned* p)              { return __hip_atomic_load(p, __ATOMIC_RELAXED, __HIP_MEMORY_SCOPE_AGENT); }
__device__ __forceinline__ unsigned xb_add(unsigned* p, unsigned v) { return __hip_atomic_fetch_add(p, v, __ATOMIC_RELAXED, __HIP_MEMORY_SCOPE_AGENT); }
__device__ __forceinline__ unsigned xb_xcc_id() { return (unsigned)__builtin_amdgcn_s_getreg((3 << 11) | 20) & 0xFu; }
#define XB_SPIN(cond, bar) do { unsigned _sp = 0; while (cond) { __builtin_amdgcn_s_sleep(1); \
    if ((++_sp & 255u) == 0u) { if (xb_ld(&(bar)[XB_TMO])) break; if (_sp > XB_SPIN_CAP) { atomicAdd(&(bar)[XB_TMO], 1u); break; } } } } while (0)

struct XcdBarrier {
    unsigned* bar; unsigned x;
    volatile LAS unsigned* st;
};

__device__ __forceinline__ XcdBarrier xcd_barrier_post(unsigned* bar, volatile LAS unsigned* st) {
    XcdBarrier b; b.bar = bar; b.x = xb_xcc_id(); b.st = st;
    if (threadIdx.x == 0) (void)xb_add(&bar[XB_XCNT(b.x)], 1u);
    return b;
}
__device__ __forceinline__ void xcd_barrier_complete(unsigned* bar, unsigned x, unsigned& nloc, unsigned& nx) {
    const unsigned G = gridDim.x * gridDim.y * gridDim.z;
    unsigned sum, cnt, mine, sp = 0u;
    for (;;) {
        sum = 0u; cnt = 0u; mine = 0u;
#pragma unroll
        for (unsigned j = 0; j < 16; ++j) { const unsigned c = xb_ld(&bar[XB_XCNT(j)]); sum += c; cnt += (c > 0u) ? 1u : 0u; mine = (j == x) ? c : mine; }
        if (sum == G) break;
        __builtin_amdgcn_s_sleep(1);
        if ((++sp & 255u) == 0u) { if (xb_ld(&bar[XB_TMO])) break; if (sp > XB_SPIN_CAP) { atomicAdd(&bar[XB_TMO], 1u); break; } }
    }
    nloc = mine > 0u ? mine : 1u; nx = cnt > 0u ? cnt : 1u;
}

__device__ __forceinline__ void xcd_barrier(const XcdBarrier& b) {
    asm volatile("s_waitcnt vmcnt(0)" ::: "memory");
    __syncthreads();
    if (threadIdx.x == 0) {
        unsigned* bar = b.bar;
        __builtin_amdgcn_s_waitcnt(0);
        unsigned nloc = b.st[0], nx = b.st[1];
        if (nloc == 0u) { xcd_barrier_complete(bar, b.x, nloc, nx); b.st[0] = nloc; b.st[1] = nx; }
        const unsigned old = xb_add(&bar[XB_XSUB(b.x)], 1u);
        const unsigned gen = old / nloc;
        if (old + 1u == (gen + 1u) * nloc) {
            __builtin_amdgcn_fence(__ATOMIC_RELEASE, "agent");
            asm volatile("s_waitcnt vmcnt(0)" ::: "memory");
            const unsigned og = xb_add(&bar[XB_TOP], 1u);
            const unsigned tg = og / nx;
            if (og + 1u == (tg + 1u) * nx) xb_add(&bar[XB_TOPGEN], 1u);
            else XB_SPIN(xb_ld(&bar[XB_TOPGEN]) == tg, bar);
            __builtin_amdgcn_fence(__ATOMIC_ACQUIRE, "agent");
            xb_add(&bar[XB_XGEN(b.x)], 1u);
            asm volatile("s_waitcnt vmcnt(0)" ::: "memory");
        } else {
            XB_SPIN(xb_ld(&bar[XB_XGEN(b.x)]) == gen, bar);
            __builtin_amdgcn_fence(__ATOMIC_ACQUIRE, "agent");
            asm volatile("s_waitcnt vmcnt(0)" ::: "memory");
        }
    }
    __syncthreads();
}

namespace pg8 {
#define PG8_LAS __attribute__((address_space(3)))
constexpr int BM = 256, BK = 64, HALF = 128, HTB = HALF * BK * 2  , STAGE_BYTES = 8 * HTB;

__host__ __device__ __forceinline__ int lds_byte(int r, int c) { const int st = (r >> 4) * 2 + (c >> 5), rr = r & 15, cc = c & 31, ob = rr * 64 + cc * 2; return st * 1024 + (ob ^ (((ob >> 9) & 1) << 5)); }
__host__ __device__ __forceinline__ void stage_rc(int b, int& R, int& C) { const int st = b / 1024, sb = b % 1024, swz = sb ^ (((sb >> 9) & 1) << 5); R = (st >> 1) * 16 + swz / 64; C = (st & 1) * 32 + (swz % 64) / 2; }
__host__ __device__ __forceinline__ int perm32(int rho) { const int n = rho >> 4, i = rho & 15; return 8 * (i >> 2) + 4 * n + (i & 3); }

struct Unit { int pm, pn; const char* bB; int e, nvalid, rowbase, par; };
struct Gemm { const char* A; };

typedef int v8i_t __attribute__((ext_vector_type(8)));
typedef int v4i_t __attribute__((ext_vector_type(4)));
__device__ __forceinline__ v8i_t cat8(const bf16x8 lo, const bf16x8 hi) { const v4i_t a = __builtin_bit_cast(v4i_t, lo), b = __builtin_bit_cast(v4i_t, hi); return __builtin_shufflevector(a, b, 0, 1, 2, 3, 4, 5, 6, 7); }
template <int K, int KSTEPA, bool FP8 = false, bool ALIGN = true, class Epi, class Sched>
__device__ __forceinline__ void gemm_phase(PG8_LAS unsigned char* lds, const Gemm g, const Sched& S, const Epi& E) {
    const int tid = opqv(threadIdx.x), wid = __builtin_amdgcn_readfirstlane(tid >> 6), lane = tid & 63, wr = wid >> 2, wc = wid & 3, fr = lane & 15, fq = lane >> 4;
    constexpr int nt = K / BK;
    constexpr int PERMI = (int)Epi::PERM;
    unsigned voffB[2], voffB1[2];
#pragma unroll
    for (int i = 0; i < 2; ++i) { int R, C; stage_rc(tid * 16 + i * 8192, R, C);
        if constexpr (PERMI == 2) { const int w0 = 64 * (R >> 5) + 16 * ((R & 15) >> 2) + 4 * ((R >> 4) & 1) + (R & 3); voffB[i] = (unsigned)(w0 * K + C) * 2u; voffB1[i] = (unsigned)((w0 + 8) * K + C) * 2u; }
        else { const int Rb = PERMI == 1 ? ((R & ~31) + perm32(R & 31)) : R; voffB[i] = (unsigned)(Rb * K + C) * 2u; voffB1[i] = voffB[i]; } }
#define PG8_AOFF2T(U, h, par, o0, o1) do { int R0_, C0_, R1_, C1_; const int t_ = opqv(tid); stage_rc(t_ * 16, R0_, C0_); stage_rc(t_ * 16 + 8192, R1_, C1_); o0 = (unsigned)opqv((int)S.a_off_tab(U, h, R0_, C0_, par, lds)); o1 = (unsigned)opqv((int)S.a_off_tab(U, h, R1_, C1_, par, lds)); } while (0)
#define PG8_AOFF2(U, h, o0, o1) do { int R0_, C0_, R1_, C1_; const int t_ = opqv(tid); stage_rc(t_ * 16, R0_, C0_); stage_rc(t_ * 16 + 8192, R1_, C1_); o0 = (unsigned)opqv((int)S.a_off(U, h, R0_, C0_)); o1 = (unsigned)opqv((int)S.a_off(U, h, R1_, C1_)); } while (0)
#define PG8_AOFFS(U, o00, o01, o10, o11) do { int R0_, C0_, R1_, C1_; const int t_ = opqv(tid); stage_rc(t_ * 16, R0_, C0_); stage_rc(t_ * 16 + 8192, R1_, C1_); \
        o00 = (unsigned)opqv((int)S.a_off(U, 0, R0_, C0_)); o01 = (unsigned)opqv((int)S.a_off(U, 0, R1_, C1_)); o10 = (unsigned)opqv((int)S.a_off(U, 1, R0_, C0_)); o11 = (unsigned)opqv((int)S.a_off(U, 1, R1_, C1_)); } while (0)
    constexpr size_t kstepA = (size_t)KSTEPA;
    const size_t kstep = (size_t)(BK * 2);
    const size_t hstep = (size_t)HALF * K * 2;
    const size_t hstepB = PERMI == 2 ? (size_t)0 : hstep;
    const unsigned ldsw = (unsigned)wid * 1024u;
    const int aoff = lds_byte(wr * 64 + fr, fq * 8), boff = lds_byte(wc * 32 + fr, fq * 8);
#define PG8_SA(b, h) (((b) * 2 + (h)) * HTB)
#define PG8_SB(b, h) ((4 + (b) * 2 + (h)) * HTB)
#define PG8_STAGE(bufoff, gbase, voff) do { _Pragma("unroll") for (int _i = 0; _i < 2; ++_i) \
        __builtin_amdgcn_global_load_lds((const unsigned*)((const char*)(gbase) + (voff)[_i]), (PG8_LAS unsigned*)(lds + (bufoff) + ldsw + _i * 8192), 16, 0, 0); } while (0)
#define PG8_STAGEA(bufoff, o0, o1, kb) do { \
        __builtin_amdgcn_global_load_lds((const unsigned*)(g.A + (kb) + (o0)), (PG8_LAS unsigned*)(lds + (bufoff) + ldsw), 16, 0, 0); \
        __builtin_amdgcn_global_load_lds((const unsigned*)(g.A + (kb) + (o1)), (PG8_LAS unsigned*)(lds + (bufoff) + ldsw + 8192), 16, 0, 0); } while (0)
#define PG8_LDA8(dst, b, h) do { _Pragma("unroll") for (int m = 0; m < 4; ++m) dst[m] = cat8(*(const PG8_LAS bf16x8*)(lds + PG8_SA(b, h) + aoff + m * 2048), *(const PG8_LAS bf16x8*)(lds + PG8_SA(b, h) + aoff + m * 2048 + 1024)); } while (0)
#define PG8_LDB8(dst, b, h) do { _Pragma("unroll") for (int n = 0; n < 2; ++n) dst[n] = cat8(*(const PG8_LAS bf16x8*)(lds + PG8_SB(b, h) + boff + n * 2048), *(const PG8_LAS bf16x8*)(lds + PG8_SB(b, h) + boff + n * 2048 + 1024)); } while (0)
#define PG8_LDA_(dst, dst8, b, h) do { if constexpr (FP8) PG8_LDA8(dst8, b, h); else PG8_LDA(dst, b, h); } while (0)
#define PG8_LDB_(dst, dst8, b, h) do { if constexpr (FP8) PG8_LDB8(dst8, b, h); else PG8_LDB(dst, b, h); } while (0)
#define PG8_LDA(dst, b, h) do { _Pragma("unroll") for (int m = 0; m < 4; ++m) _Pragma("unroll") for (int k = 0; k < 2; ++k) dst[m][k] = *(const PG8_LAS bf16x8*)(lds + PG8_SA(b, h) + aoff + m * 2048 + k * 1024); } while (0)
#define PG8_LDB(dst, b, h) do { _Pragma("unroll") for (int n = 0; n < 2; ++n) _Pragma("unroll") for (int k = 0; k < 2; ++k) dst[n][k] = *(const PG8_LAS bf16x8*)(lds + PG8_SB(b, h) + boff + n * 2048 + k * 1024); } while (0)
#define PG8_MMA(ai, bj, At, Bt) do { __builtin_amdgcn_s_setprio(1); if constexpr (FP8) { _Pragma("unroll") for (int m = 0; m < 4; ++m) _Pragma("unroll") for (int n = 0; n < 2; ++n) \
        acc[ai][bj][m][n] = __builtin_amdgcn_mfma_scale_f32_16x16x128_f8f6f4(Bt##8[n], At##8[m], acc[ai][bj][m][n], 0, 0, 0, 0x7f7f7f7f, 0, 0x7f7f7f7f); } else { \
        _Pragma("unroll") for (int m = 0; m < 4; ++m) _Pragma("unroll") for (int n = 0; n < 2; ++n) _Pragma("unroll") for (int k = 0; k < 2; ++k) \
        acc[ai][bj][m][n] = __builtin_amdgcn_mfma_f32_16x16x32_bf16(Bt[n][k], At[m][k], acc[ai][bj][m][n], 0, 0, 0); } __builtin_amdgcn_s_setprio(0); } while (0)
#define PG8_WAIT_V(n) asm volatile("s_waitcnt vmcnt(" #n ")" ::: "memory")
#define PG8_WAIT_L(n) asm volatile("s_waitcnt lgkmcnt(" #n ")" ::: "memory")
#define PG8_BAR __builtin_amdgcn_s_barrier()
#define PG8_SCHED __builtin_amdgcn_sched_barrier(0)
#define PG8_SCHED8 do { if constexpr (FP8) __builtin_amdgcn_sched_barrier(0); } while (0)
#define PG8_PIN(ai) do { if constexpr (FP8) { _Pragma("unroll") for (int bj_ = 0; bj_ < 2; ++bj_) _Pragma("unroll") for (int m_ = 0; m_ < 4; ++m_) _Pragma("unroll") for (int n_ = 0; n_ < 2; ++n_) asm volatile("" : "+v"(acc[ai][bj_][m_][n_])); } } while (0)
    Unit cur, nxt; int ui = 0;
    if (!S.next(0, cur)) return;
    S.prefetch(cur, 0, lds);
    f32x4 acc[2][2][4][2];
#pragma unroll
    for (int a = 0; a < 2; ++a)
#pragma unroll
        for (int b = 0; b < 2; ++b)
#pragma unroll
            for (int m = 0; m < 4; ++m)
#pragma unroll
                for (int n = 0; n < 2; ++n) acc[a][b][m][n] = (f32x4){0.f, 0.f, 0.f, 0.f};
    bf16x8 At[4][2], B0[2][2], B1[2][2]; v8i_t At8[4], B08[2], B18[2];
    unsigned ca00, ca01, ca10, ca11; PG8_AOFFS(cur, ca00, ca01, ca10, ca11);
    const char* cB = cur.bB;
    PG8_STAGE(PG8_SB(0, 0), cB, voffB); PG8_STAGE(PG8_SB(0, 1), cB + hstepB, voffB1); PG8_STAGEA(PG8_SA(0, 0), ca00, ca01, (size_t)0); PG8_STAGEA(PG8_SA(0, 1), ca10, ca11, (size_t)0);
    if (wr == 1) PG8_BAR;
    PG8_WAIT_V(2); PG8_BAR;
    PG8_STAGE(PG8_SB(1, 0), cB + kstep, voffB); PG8_STAGEA(PG8_SA(1, 0), ca00, ca01, kstepA); PG8_STAGE(PG8_SB(1, 1), cB + hstepB + kstep, voffB1);
    PG8_WAIT_V(6); PG8_BAR;
    for (;;) {
        const bool has_next = S.next(ui + 1, nxt);
        const char* nB = has_next ? nxt.bB : cB;
        const int npar = (ui + 1) & 1;
        if (has_next) S.prefetch(nxt, npar, lds);

#pragma unroll 1
        for (int t = 0; t < nt; t += 2) {
            const bool last = (t == nt - 2);
            const bool fromnext = last && has_next;
            const size_t k1 = (size_t)(t + 1) * kstepA;
            const size_t k2 = last ? (size_t)0 : (size_t)(t + 2) * kstepA;
            const size_t k3 = k2 + kstepA;
            const char* b2 = last ? nB : cB + (size_t)(t + 2) * kstep; const char* b3 = b2 + kstep;
            unsigned y0, y1;
            PG8_LDB_(B0, B08, 0, 0); PG8_LDB_(B1, B18, 0, 1); PG8_SCHED; PG8_LDA_(At, At8, 0, 0); PG8_STAGEA(PG8_SA(1, 1), ca10, ca11, k1);
            PG8_WAIT_V(8); PG8_WAIT_L(0); PG8_BAR; PG8_SCHED8; PG8_MMA(0, 0, At, B0); PG8_MMA(0, 1, At, B1); PG8_PIN(0); PG8_SCHED8; PG8_BAR; PG8_SCHED;
            y0 = ca00; y1 = ca01; if (fromnext) PG8_AOFF2T(nxt, 0, npar, y0, y1);
            PG8_LDA_(At, At8, 0, 1); PG8_STAGE(PG8_SB(0, 0), b2, voffB); PG8_STAGE(PG8_SB(0, 1), b2 + hstepB, voffB1); PG8_STAGEA(PG8_SA(0, 0), y0, y1, k2);
            PG8_WAIT_V(8); PG8_WAIT_L(0); PG8_BAR; PG8_SCHED8; PG8_MMA(1, 0, At, B0); PG8_MMA(1, 1, At, B1); PG8_PIN(1); PG8_SCHED8; PG8_BAR; PG8_SCHED;
            y0 = ca10; y1 = ca11; if (fromnext) PG8_AOFF2T(nxt, 1, npar, y0, y1);
            PG8_LDB_(B0, B08, 1, 0); PG8_LDB_(B1, B18, 1, 1); PG8_SCHED; PG8_LDA_(At, At8, 1, 0); PG8_STAGEA(PG8_SA(0, 1), y0, y1, k2);
            PG8_WAIT_V(8); PG8_WAIT_L(0); PG8_BAR; PG8_SCHED8; PG8_MMA(0, 0, At, B0); PG8_MMA(0, 1, At, B1); PG8_PIN(0); PG8_SCHED8; PG8_BAR; PG8_SCHED;
            y0 = ca00; y1 = ca01; if (fromnext) PG8_AOFF2T(nxt, 0, npar, y0, y1);
            PG8_LDA_(At, At8, 1, 1); PG8_STAGE(PG8_SB(1, 0), b3, voffB); PG8_STAGE(PG8_SB(1, 1), b3 + hstepB, voffB1); PG8_STAGEA(PG8_SA(1, 0), y0, y1, k3);
            PG8_WAIT_V(8); PG8_WAIT_L(0); PG8_BAR; PG8_SCHED8; PG8_MMA(1, 0, At, B0); PG8_MMA(1, 1, At, B1); PG8_PIN(1); PG8_SCHED8; PG8_BAR; PG8_SCHED;
        }
        if (ALIGN && wr == 0) PG8_BAR;
        if constexpr (!Epi::AFTER_DRAIN) { E(acc, cur, wr, wc, fr, fq); }
        if (!has_next) break;
#pragma unroll
        for (int a = 0; a < 2; ++a)
#pragma unroll
            for (int b = 0; b < 2; ++b)
#pragma unroll
                for (int m = 0; m < 4; ++m)
#pragma unroll
                    for (int n = 0; n < 2; ++n) acc[a][b][m][n] = (f32x4){0.f, 0.f, 0.f, 0.f};
        cur = nxt; cB = nB; ++ui; PG8_AOFF2T(cur, 0, npar, ca00, ca01); PG8_AOFF2T(cur, 1, npar, ca10, ca11);
        if (ALIGN && wr == 1) PG8_BAR;
    }
    PG8_WAIT_V(0);
    if (!ALIGN && wr == 0) PG8_BAR;
    PG8_BAR;
    if constexpr (Epi::AFTER_DRAIN) { E.fused(acc, cur, wr, wc, fr, fq, lds, wid, lane); }
#undef PG8_SA
#undef PG8_SB
#undef PG8_STAGE
#undef PG8_STAGEA
#undef PG8_AOFFS
#undef PG8_AOFF2
#undef PG8_AOFF2T
#undef PG8_LDA
#undef PG8_LDA8
#undef PG8_LDB8
#undef PG8_LDA_
#undef PG8_LDB_
#undef PG8_LDB
#undef PG8_MMA
#undef PG8_WAIT_V
#undef PG8_WAIT_L
#undef PG8_BAR
#undef PG8_SCHED
#undef PG8_SCHED8
#undef PG8_PIN
}

struct DenseOrder {
    int nM, nN, nwg, G, c, K; const char* Bt;
    __device__ void init(int M, int N, int K_, const void* Bt_, int G_, int c_) { nM = M / BM; nN = N / BM; nwg = nM * nN; G = G_; c = c_; K = K_; Bt = (const char*)Bt_; }
    __device__ __forceinline__ bool next(int i, Unit& u) const {
        const int L = i * G + c; if (L >= nwg) return false;
        int wgid = L; { const int q = nwg / 8, r = nwg % 8, xcd = wgid % 8, off = wgid / 8; wgid = (xcd < r ? xcd * (q + 1) : r * (q + 1) + (xcd - r) * q) + off; }
        const int nig = 8 * nN, gid = wgid / nig, fm = gid * 8, gsz = (nM - fm) < 8 ? (nM - fm) : 8;
        u.pm = fm + ((wgid % nig) % gsz); u.pn = (wgid % nig) / gsz; u.bB = Bt + (size_t)u.pn * BM * K * 2; u.e = 0; u.nvalid = 256; u.rowbase = 0; u.par = 0; return true;
    }
    __device__ __forceinline__ unsigned a_off(const Unit& u, int h, int R, int C) const { return (unsigned)(((u.pm * BM + h * HALF + R) * K + C) * 2); }
    __device__ __forceinline__ void prefetch(const Unit&, int, PG8_LAS unsigned char*) const {}
    __device__ __forceinline__ unsigned a_off_tab(const Unit& u, int h, int R, int C, int, PG8_LAS unsigned char*) const { return a_off(u, h, R, C); }
};
}
template <class RowMap>
__device__ __forceinline__ void transpose_item(const float* W, int K, int N, bf16_t* dst, const RowMap& rowmap, LAS float* scr, int kb, int nb, int lane) {
    const int k0 = 64 * kb, n0 = 64 * nb;
    const int cc = 4 * (lane & 15), rr = lane >> 4;
    const bool ok = (n0 + cc) < N;
    f32x4 v[16];
#pragma unroll
    for (int i = 0; i < 16; ++i) { v[i] = (f32x4){0.f, 0.f, 0.f, 0.f}; if (ok) v[i] = __builtin_nontemporal_load((const f32x4*)(W + (size_t)(k0 + 4 * i + rr) * N + n0 + cc)); }
#pragma unroll
    for (int i = 0; i < 16; ++i) { LAS float* s = scr + (4 * i + rr) * 65 + cc; s[0] = v[i].x; s[1] = v[i].y; s[2] = v[i].z; s[3] = v[i].w; }
    LDS_WAIT();
    const int c = lane & 7;
#pragma unroll
    for (int j = 0; j < 8; ++j) {
        const int n = (lane >> 3) + 8 * j;
        const LAS float* s = scr + (8 * c) * 65 + n;
        u32x4 o; o.x = pk2(s[0 * 65], s[1 * 65]); o.y = pk2(s[2 * 65], s[3 * 65]); o.z = pk2(s[4 * 65], s[5 * 65]); o.w = pk2(s[6 * 65], s[7 * 65]);
        if (n0 + n < N) *(u32x4*)(dst + (size_t)rowmap(n0 + n) * K + k0 + 8 * c) = o;
    }
    LDS_WAIT();
}
template <class RowMap>
__device__ __forceinline__ void transpose_item_fp8(const float* W, int K, int N, unsigned char* dst, const RowMap& rowmap, float scale, LAS float* scr, int kb, int nb, int lane) {
    const int k0 = 64 * kb, n0 = 64 * nb;
    const int cc = 4 * (lane & 15), rr = lane >> 4;
    const bool ok = (n0 + cc) < N;
    f32x4 v[16];
#pragma unroll
    for (int i = 0; i < 16; ++i) { v[i] = (f32x4){0.f, 0.f, 0.f, 0.f}; if (ok) v[i] = __builtin_nontemporal_load((const f32x4*)(W + (size_t)(k0 + 4 * i + rr) * N + n0 + cc)); }
#pragma unroll
    for (int i = 0; i < 16; ++i) { LAS float* s = scr + (4 * i + rr) * 65 + cc; s[0] = v[i].x; s[1] = v[i].y; s[2] = v[i].z; s[3] = v[i].w; }
    LDS_WAIT();
    const int c = lane & 7;
#pragma unroll
    for (int j = 0; j < 8; ++j) {
        const int n = (lane >> 3) + 8 * j;
        const LAS float* s = scr + (8 * c) * 65 + n;
        u32x2 o; o.x = pk4_fp8(s[0 * 65] * scale, s[1 * 65] * scale, s[2 * 65] * scale, s[3 * 65] * scale); o.y = pk4_fp8(s[4 * 65] * scale, s[5 * 65] * scale, s[6 * 65] * scale, s[7 * 65] * scale);
        if (n0 + n < N) *(u32x2*)(dst + (size_t)rowmap(n0 + n) * K + k0 + 8 * c) = o;
    }
    LDS_WAIT();
}
struct MapId { int off; __device__ __forceinline__ int operator()(int n) const { return off + n; } };
struct MapGU { int off; __device__ __forceinline__ int operator()(int n) const { return (n >> 7) * 256 + off + (n & 127); } };

struct XItem { const float* src; unsigned char* dst; int N, K; };
__device__ __forceinline__ XItem xitem(const Params& p, unsigned char* ws, int id_, int lane) {
    const int id = __builtin_amdgcn_readfirstlane(id_);
    const int t = id & 255, ew = id >> 8, e = ew / 3, which = ew - 3 * e;
    XItem it;
    if (which < 2) {
        const int kb = t >> 3, nb = t & 7;
        it.N = EFF; it.K = DM;
        it.src = (e < NEXP ? INP(23 + which) + (size_t)e * DM * EFF : INP(26 + which)) + (size_t)(64 * kb) * EFF + 64 * nb;
        const int n0 = 64 * nb; const int r0 = (n0 >> 7) * 256 + which * 128 + (n0 & 127);
        it.dst = (unsigned char*)(ws + OFF_WEUPT) + (size_t)e * 1024 * DM + (size_t)r0 * DM + 64 * kb;
    } else {
        const int kb = t >> 5, nb = t & 31;
        it.N = DM; it.K = EFF;
        it.src = (e < NEXP ? INP(25) + (size_t)e * EFF * DM : INP(28)) + (size_t)(64 * kb) * DM + 64 * nb;
        it.dst = (unsigned char*)(ws + OFF_WEDT) + (size_t)e * DM * EFF + (size_t)(64 * nb) * EFF + 64 * kb;
    }
    return it;
}
__device__ __forceinline__ void xload(f32x4 (&v)[16], const XItem& it, int lane) {
    const int cc = 4 * (lane & 15), rr = lane >> 4;
#pragma unroll
    for (int i = 0; i < 16; ++i) v[i] = __builtin_nontemporal_load((const f32x4*)(it.src + (size_t)(4 * i + rr) * it.N + cc));
}
__device__ __forceinline__ void xstore(const f32x4 (&v)[16], const XItem& it, LAS float* scr, int lane) {
    const int cc = 4 * (lane & 15), rr = lane >> 4;
#pragma unroll
    for (int i = 0; i < 16; ++i) { LAS float* s = scr + (4 * i + rr) * 65 + cc; s[0] = v[i].x; s[1] = v[i].y; s[2] = v[i].z; s[3] = v[i].w; }
    LDS_WAIT();
    const int c = lane & 7;
#pragma unroll
    for (int j = 0; j < 8; ++j) {
        const int n = (lane >> 3) + 8 * j;
        const LAS float* s = scr + (8 * c) * 65 + n;
        u32x2 o; o.x = pk4_fp8(s[0 * 65] * W8_SCALE, s[1 * 65] * W8_SCALE, s[2 * 65] * W8_SCALE, s[3 * 65] * W8_SCALE); o.y = pk4_fp8(s[4 * 65] * W8_SCALE, s[5 * 65] * W8_SCALE, s[6 * 65] * W8_SCALE, s[7 * 65] * W8_SCALE);
        *(u32x2*)(it.dst + (size_t)n * it.K + 8 * c) = o;
    }
    LDS_WAIT();
}
__device__ __forceinline__ void expert_convert(const Params& p, LAS unsigned char* lds, int vcu, int G, int first, int count) {
    const int tid = opqv(threadIdx.x), lane = tid & 63, wave = tid >> 6;
    const int gw = vcu * NWAVES + wave, NGW = G * NWAVES;
    unsigned char* ws = opqf(p.ws);
    LAS float* scr = (LAS float*)(lds + wave * 16640);
#ifdef PROBE_PH
    for (int rp = 0; rp < (PROBE_PH == 99 ? 2 : 1); ++rp) {
#endif
    int j = gw;
    if (j >= count) return;
    f32x4 va[16], vb[16];
    XItem ia = xitem(p, ws, first + j, lane), ib = ia;
    xload(va, ia, lane);
    for (;;) {
        const int j1 = j + NGW; const bool m1 = j1 < count;
        if (m1) { ib = xitem(p, ws, first + j1, lane); xload(vb, ib, lane); }
        xstore(va, ia, scr, lane);
        if (!m1) break;
        const int j2 = j1 + NGW; const bool m2 = j2 < count;
        if (m2) { ia = xitem(p, ws, first + j2, lane); xload(va, ia, lane); }
        xstore(vb, ib, scr, lane);
        if (!m2) break;
        j = j2;
    }
#ifdef PROBE_PH
    }
#endif
}
__device__ __forceinline__ void p0_prep(const Params& p, LAS unsigned char* lds, int vcu, int G) {
    const int tid = opqv(threadIdx.x), lane = tid & 63, wave = tid >> 6;
    const int gw = vcu * NWAVES + wave, NGW = G * NWAVES;
    const int gt = vcu * NTHREADS + tid, NGT = G * NTHREADS;
    unsigned char* ws = opqf(p.ws);
    if (vcu == 0 && tid < 64) ((unsigned*)(ws + OFF_CTL))[tid] = 0u;
    {
        const f32x4* x4 = (const f32x4*)INP(0); u32x4* xb = (u32x4*)(ws + OFF_XB);
        const int n8 = T_TOK * DM / 8;
        for (int i0 = gt; i0 < n8; i0 += 4 * NGT) {
            f32x4 a[4], b[4];
#pragma unroll
            for (int k = 0; k < 4; ++k) { const int i = i0 + k * NGT; if (i < n8) { a[k] = x4[2 * i]; b[k] = x4[2 * i + 1]; } }
#pragma unroll
            for (int k = 0; k < 4; ++k) { const int i = i0 + k * NGT; if (i < n8) { u32x4 o; o.x = pk2(a[k].x, a[k].y); o.y = pk2(a[k].z, a[k].w); o.z = pk2(b[k].x, b[k].y); o.w = pk2(b[k].z, b[k].w); xb[i] = o;
                ((u32x2*)(ws + OFF_X8))[i] = (u32x2){pk4_fp8(a[k].x, a[k].y, a[k].z, a[k].w), pk4_fp8(b[k].x, b[k].y, b[k].z, b[k].w)}; } }
        }
    }
    {
        u32x4* z1 = (u32x4*)(ws + OFF_WINT + (size_t)IN_COLS * DM); const int n1 = (PROJ_LD - IN_COLS) * DM / 16;
        for (int i = gt; i < n1; i += NGT) z1[i] = (u32x4){0u, 0u, 0u, 0u};

    }
    for (int i = gt; i < NGRP * NSTATE; i += NGT) {
        const int g = i >> 6, pp = i & 63;
        const float lr = INP(3)[i], li = INP(4)[i], dt = expf(INP(5)[g]);
        const float mag = expf(lr * dt); float sn, cs; sincosf(li * dt, &sn, &cs);
        const float ar = mag * cs, ai = mag * sn;
        const float zr = ar - 1.f, zi = ai, den = lr * lr + li * li;
        const float fr = (zr * lr + zi * li) / den, fi = (zi * lr - zr * li) / den;
        ((f32x2*)(ws + OFF_S5A))[i] = (f32x2){ar, ai};
        float pr = ar, pi = ai;
#pragma unroll
        for (int k = 0; k < 8; ++k) { const float nr = pr * pr - pi * pi, ni = 2.f * pr * pi; pr = nr; pi = ni; }
        ((f32x2*)(ws + OFF_S5AC))[i] = (f32x2){pr, pi};
        (void)fr; (void)fi;
    }
    for (int i = gt; i < NGRP * 4 * 64; i += NGT) {
        const int g = i >> 8, v = (i >> 6) & 3, l = i & 63, pp = 32 * (v >> 1) + (l & 31), h0 = 8 * (l >> 5), gp = g * 64 + pp;
        const float lr = INP(3)[gp], li = INP(4)[gp], dt = expf(INP(5)[g]);
        const float mag = expf(lr * dt); float sn, cs; sincosf(li * dt, &sn, &cs);
        const float ar = mag * cs, ai = mag * sn, zr = ar - 1.f, zi = ai, den = lr * lr + li * li;
        const float fr = (zr * lr + zi * li) / den, fi = (zi * lr - zr * li) / den;
        const float* br = INP(6) + (size_t)gp * 16 + h0; const float* bi = INP(7) + (size_t)gp * 16 + h0;
        unsigned w[4];
#pragma unroll
        for (int jj = 0; jj < 4; ++jj) {
            const float r0 = fr * br[2 * jj] - fi * bi[2 * jj], i0 = fr * bi[2 * jj] + fi * br[2 * jj], r1 = fr * br[2 * jj + 1] - fi * bi[2 * jj + 1], i1 = fr * bi[2 * jj + 1] + fi * br[2 * jj + 1];
            w[jj] = (v & 1) ? pk2(i0, i1) : pk2(r0, r1);
        }
        ((u32x4*)(ws + OFF_S5BB))[i] = (u32x4){w[0], w[1], w[2], w[3]};
    }
    for (int i = gt; i < NGRP * 4 * 64; i += NGT) {
        const int g = i >> 8, ks = (i >> 6) & 3, l = i & 63, h = l & 15, q = l >> 4;
        const float* cre = INP(8) + ((size_t)g * 16 + h) * 64; const float* cim = INP(9) + ((size_t)g * 16 + h) * 64;
        unsigned w[4];
#pragma unroll
        for (int jj = 0; jj < 4; ++jj) { const int k = 32 * ks + 8 * q + 2 * jj, pp = k >> 1; w[jj] = pk2(cre[pp], -cim[pp]); }
        ((u32x4*)(ws + OFF_S5CF))[i] = (u32x4){w[0], w[1], w[2], w[3]};
    }
    if (vcu < 32) {
        const int which = vcu >> 4, pt = vcu & 15;
        const float* pe = INP(12 + which); const float* w1 = INP(which == 0 ? 14 : 16);
        LAS float* red = (LAS float*)lds;
        const int j = tid & 127, sub = tid >> 7; float s = 0.f;
        const int kb0 = pt * 128 + sub * 32;
        float wv[32];
#pragma unroll
        for (int k = 0; k < 32; ++k) wv[k] = w1[(size_t)(kb0 + k) * 128 + j];
#pragma unroll
        for (int k = 0; k < 32; ++k) s += pe[kb0 + k] * wv[k];
        red[tid] = s; __syncthreads();
        if (tid < 128) ((float*)(ws + OFF_CBIAS))[(which * 16 + pt) * 128 + tid] = red[tid] + red[tid + 128] + red[tid + 256] + red[tid + 384];
        __syncthreads();
    }
    LAS float* scr = (LAS float*)(lds + wave * 16640);
    auto run = [&](const float* W, int K, int N, bf16_t* dst, auto map, int& base) {
        const int nkb = K / 64, nnb = (N + 63) / 64, items = nkb * nnb;
        int j0 = (gw - (base % NGW) + NGW) % NGW;
        for (int j = j0; j < items; j += NGW) transpose_item(W, K, N, dst, map, scr, j / nnb, j % nnb, lane);
        base += items;
    };
    auto run8 = [&](const float* W, int K, int N, unsigned char* dst, auto map, int& base) {
        const int nnb = (N + 63) / 64, items = (K / 64) * nnb;
        int j0 = (gw - (base % NGW) + NGW) % NGW;
        for (int j = j0; j < items; j += NGW) transpose_item_fp8(W, K, N, dst, map, W8_SCALE, scr, j / nnb, j % nnb, lane);
        base += items;
    };
    int base = 0;
    run8(INP(2), DM, IN_COLS, (unsigned char*)(ws + OFF_WINT), MapId{0}, base);
    run(INP(11), 1024, 1024, (bf16_t*)(ws + OFF_WGLUT), MapId{0}, base);
    run8(INP(18), DM, DM, (unsigned char*)(ws + OFF_WOUTT), MapId{0}, base);
    run(INP(14), DM, 128, (bf16_t*)(ws + OFF_WC1T), MapId{0}, base);
    run(INP(16), DM, 128, (bf16_t*)(ws + OFF_WC1T), MapId{128}, base);
    run(INP(21), DM, NEXP, (bf16_t*)(ws + OFF_WRT), MapId{0}, base);
    (void)run8;
}
using pg8::Unit;
struct EpiStoreBf16 {
    static constexpr int PERM = 1; static constexpr bool AFTER_DRAIN = false;
    bf16_t* O; int ldc; float sc;
    __device__ __forceinline__ void operator()(const f32x4 (&acc)[2][2][4][2], const Unit& u, int wr, int wc, int fr, int fq) const {
        const int row0 = u.pm * 256 + wr * 64 + fr, col0 = u.pn * 256 + wc * 32 + 8 * fq;
#pragma unroll
        for (int ai = 0; ai < 2; ++ai)
#pragma unroll
            for (int m = 0; m < 4; ++m) { bf16_t* rowp = O + (size_t)(row0 + ai * 128 + m * 16) * ldc + col0;
#pragma unroll
                for (int bj = 0; bj < 2; ++bj) { const f32x4 v0 = acc[ai][bj][m][0] * sc, v1 = acc[ai][bj][m][1] * sc;
                    u32x4 w; w.x = cvt_pk_bf16(v0[0], v0[1]); w.y = cvt_pk_bf16(v0[2], v0[3]); w.z = cvt_pk_bf16(v1[0], v1[1]); w.w = cvt_pk_bf16(v1[2], v1[3]);
                    *(u32x4*)(rowp + bj * 128) = w; } }
    }
};
struct EpiGlu {
    static constexpr int PERM = 1; static constexpr bool AFTER_DRAIN = false;
    const bf16_t* Y; unsigned char* O;
    __device__ __forceinline__ void operator()(const f32x4 (&acc)[2][2][4][2], const Unit& u, int wr, int wc, int fr, int fq) const {
        const int row0 = u.pm * 256 + wr * 64 + fr, col0 = u.pn * 256 + wc * 32 + 8 * fq;
#pragma unroll
        for (int ai = 0; ai < 2; ++ai) {
            u32x4 yv[4][2];
#pragma unroll
            for (int m = 0; m < 4; ++m)
#pragma unroll
                for (int bj = 0; bj < 2; ++bj) yv[m][bj] = *(const u32x4*)(Y + (size_t)(row0 + ai * 128 + m * 16) * 1024 + col0 + bj * 128);
#pragma unroll
            for (int m = 0; m < 4; ++m) { const size_t r = (size_t)(row0 + ai * 128 + m * 16);
#pragma unroll
                for (int bj = 0; bj < 2; ++bj) { const f32x4 v0 = acc[ai][bj][m][0], v1 = acc[ai][bj][m][1];
                    const u32x4 y = yv[m][bj];
                    u32x2 w;
                    w.x = pk4_fp8(bflo(y.x) * sigmoidf_(v0[0]) * MIX8_SCALE, bfhi(y.x) * sigmoidf_(v0[1]) * MIX8_SCALE, bflo(y.y) * sigmoidf_(v0[2]) * MIX8_SCALE, bfhi(y.y) * sigmoidf_(v0[3]) * MIX8_SCALE);
                    w.y = pk4_fp8(bflo(y.z) * sigmoidf_(v1[0]) * MIX8_SCALE, bfhi(y.z) * sigmoidf_(v1[1]) * MIX8_SCALE, bflo(y.w) * sigmoidf_(v1[2]) * MIX8_SCALE, bfhi(y.w) * sigmoidf_(v1[3]) * MIX8_SCALE);
                    *(u32x2*)(O + r * 2048 + col0 + bj * 128) = w; } }
        }
    }
};
struct EpiResF32 {
    static constexpr int PERM = 0; static constexpr bool AFTER_DRAIN = false;
    const float* X; float* O;
    __device__ __forceinline__ void operator()(const f32x4 (&acc)[2][2][4][2], const Unit& u, int wr, int wc, int fr, int fq) const {
        const int row0 = u.pm * 256 + wr * 64 + fr, col0 = u.pn * 256 + wc * 32 + 4 * fq;
#pragma unroll
        for (int ai = 0; ai < 2; ++ai)
#pragma unroll
            for (int m = 0; m < 4; ++m) { const size_t off = (size_t)(row0 + ai * 128 + m * 16) * DM + col0;
#pragma unroll
                for (int bj = 0; bj < 2; ++bj)
#pragma unroll
                    for (int n = 0; n < 2; ++n) { const f32x4 xv = *(const f32x4*)(X + off + bj * 128 + n * 16); *(f32x4*)(O + off + bj * 128 + n * 16) = xv * ALPHA + acc[ai][bj][m][n]; } }
    }
};

struct EpiResBf16 {
    static constexpr int PERM = 1; static constexpr bool AFTER_DRAIN = false;
    const bf16_t* X; bf16_t* O;
    __device__ __forceinline__ void operator()(const f32x4 (&acc)[2][2][4][2], const Unit& u, int wr, int wc, int fr, int fq) const {
        const int row0 = u.pm * 256 + wr * 64 + fr, col0 = u.pn * 256 + wc * 32 + 8 * fq;
#pragma unroll
        for (int ai = 0; ai < 2; ++ai) {
            u32x4 xv[4][2];
#pragma unroll
            for (int m = 0; m < 4; ++m)
#pragma unroll
                for (int bj = 0; bj < 2; ++bj) xv[m][bj] = *(const u32x4*)(X + (size_t)(row0 + ai * 128 + m * 16) * DM + col0 + bj * 128);
#pragma unroll
            for (int m = 0; m < 4; ++m) { const size_t off = (size_t)(row0 + ai * 128 + m * 16) * DM + col0;
#pragma unroll
                for (int bj = 0; bj < 2; ++bj) { const f32x4 v0 = acc[ai][bj][m][0] * (1.f / (W8_SCALE * MIX8_SCALE)), v1 = acc[ai][bj][m][1] * (1.f / (W8_SCALE * MIX8_SCALE));
                    const u32x4 x = xv[m][bj];
                    u32x4 w; w.x = cvt_pk_bf16(bflo(x.x) * ALPHA + v0[0], bfhi(x.x) * ALPHA + v0[1]); w.y = cvt_pk_bf16(bflo(x.y) * ALPHA + v0[2], bfhi(x.y) * ALPHA + v0[3]);
                    w.z = cvt_pk_bf16(bflo(x.z) * ALPHA + v1[0], bfhi(x.z) * ALPHA + v1[1]); w.w = cvt_pk_bf16(bflo(x.w) * ALPHA + v1[2], bfhi(x.w) * ALPHA + v1[3]);
                    *(u32x4*)(O + off + bj * 128) = w; } }
        }
    }
};

template <int NSL>
__device__ __forceinline__ void ln_row(const bf16_t* inrow, float inscale, const unsigned char* slots  , const f32x4 (&gv)[8], const f32x4 (&bv)[8]  , float* outrow, bf16_t* outb, unsigned char* outq, int lane) {
    const u32x2* xr = (const u32x2*)inrow + lane;
    f32x4 v[8]; float s = 0.f;
#pragma unroll
    for (int j = 0; j < 8; ++j) { const u32x2 w = xr[64 * j]; v[j] = (f32x4){bflo(w.x), bfhi(w.x), bflo(w.y), bfhi(w.y)} * inscale; }
    if (NSL > 0) {
#pragma unroll
        for (int k = 0; k < NSL; ++k) { const unsigned* sr = (const unsigned*)(slots + (size_t)k * DM) + lane;
#pragma unroll
            for (int j = 0; j < 8; ++j) { const unsigned w = sr[64 * j]; const f32x2 lo = __builtin_amdgcn_cvt_pk_f32_fp8(w, false), hi = __builtin_amdgcn_cvt_pk_f32_fp8(w, true);
                v[j].x += lo.x * (1.f / SLOT_SCALE); v[j].y += lo.y * (1.f / SLOT_SCALE); v[j].z += hi.x * (1.f / SLOT_SCALE); v[j].w += hi.y * (1.f / SLOT_SCALE); } }
    }
#pragma unroll
    for (int j = 0; j < 8; ++j) s += (v[j].x + v[j].y) + (v[j].z + v[j].w);
    const float mean = wave_sum(s) * (1.f / DM); float s2 = 0.f;
#pragma unroll
    for (int j = 0; j < 8; ++j) { v[j] = v[j] - mean; s2 += (v[j].x * v[j].x + v[j].y * v[j].y) + (v[j].z * v[j].z + v[j].w * v[j].w); }
    const float rstd = 1.f / sqrtf(wave_sum(s2) * (1.f / DM) + LN_EPS);
    f32x4* o = (f32x4*)outrow + lane;
    u32x2* ob = (u32x2*)outb + lane; unsigned* oq = (unsigned*)outq + lane;
#pragma unroll
    for (int j = 0; j < 8; ++j) { const f32x4 r = v[j] * rstd * gv[j] + bv[j]; __builtin_nontemporal_store(r, &o[64 * j]); if (outb) ob[64 * j] = (u32x2){pk2(r.x, r.y), pk2(r.z, r.w)}; if (outq) oq[64 * j] = pk4_fp8(r.x, r.y, r.z, r.w); }
}
typedef float f32x16 __attribute__((ext_vector_type(16)));
constexpr int S5_WAVE_LDS = 2 * 16 * 272;
template <bool PASS2>
__device__ __forceinline__ void s5_pass(const Params& p, LAS unsigned char* lds, int vcu, int G) {
    const int tid = opqv(threadIdx.x), lane = tid & 63, wave = __builtin_amdgcn_readfirstlane(tid >> 6);
    const int gw = vcu * NWAVES + wave, NGW = G * NWAVES;
    unsigned char* ws = opqf(p.ws);
    const bf16_t* proj = (const bf16_t*)(ws + OFF_PROJ);
    LAS unsigned char* sl = lds + wave * S5_WAVE_LDS;
    f32x2* Ebuf = (f32x2*)(ws + OFF_E);
    const int c = lane & 31, hh = lane >> 5;
    const int arow = lane & 31, ab = (arow >> 2) & 1, atok = (arow & 3) + 4 * (arow >> 3), ak = 8 * (lane >> 5);
    const int h = lane & 15, q = lane >> 4;
    for (int task = gw; task < NGRP * S5_NSEG; task += NGW) {
        const int g = task % NGRP, sg = task / NGRP;
        bf16x8 bf[4];
#pragma unroll
        for (int v = 0; v < 4; ++v) bf[v] = ((const bf16x8*)(ws + OFF_S5BB))[(g * 4 + v) * 64 + lane];
        const f32x2 a0 = ((const f32x2*)(ws + OFF_S5A))[g * 64 + c], a1 = ((const f32x2*)(ws + OFF_S5A))[g * 64 + 32 + c];
        float s0r = 0.f, s0i = 0.f, s1r = 0.f, s1i = 0.f;
        bf16x8 cf[4]; float dsk = 0.f;
        if (PASS2) {
            const f32x2 c0 = ((const f32x2*)(ws + OFF_S5AC))[g * 64 + c], c1 = ((const f32x2*)(ws + OFF_S5AC))[g * 64 + 32 + c];
            const f32x2* Ep = Ebuf + ((size_t)(hh * NGRP + g) * S5_NSEG) * 64 + c;
#pragma unroll 1
            for (int cc = 0; cc < sg; cc += 4) {
                f32x2 e0[4], e1[4];
#pragma unroll
                for (int k = 0; k < 4; ++k) { e0[k] = (f32x2){0.f, 0.f}; e1[k] = e0[k]; if (cc + k < sg) { e0[k] = Ep[(size_t)(cc + k) * 64]; e1[k] = Ep[(size_t)(cc + k) * 64 + 32]; } }
#pragma unroll
                for (int k = 0; k < 4; ++k) if (cc + k < sg) {
                    const float n0r = c0.x * s0r - c0.y * s0i + e0[k].x, n0i = c0.x * s0i + c0.y * s0r + e0[k].y; s0r = n0r; s0i = n0i;
                    const float n1r = c1.x * s1r - c1.y * s1i + e1[k].x, n1i = c1.x * s1i + c1.y * s1r + e1[k].y; s1r = n1r; s1i = n1i;
                }
            }
#pragma unroll
            for (int ks = 0; ks < 4; ++ks) cf[ks] = ((const bf16x8*)(ws + OFF_S5CF))[(g * 4 + ks) * 64 + lane];
            dsk = INP(10)[g * 16 + h];
        }
        const bf16_t* ubase = proj + (size_t)(ab * SEQ + sg * S5_SEG + atok) * PROJ_LD + g * 16 + ak;
        bf16x8 ua = *(const bf16x8*)ubase;
#pragma unroll 1
        for (int st = 0; st < S5_SEG / 16; ++st) {
            const bf16x8 ucur = ua;
            if (st + 1 < S5_SEG / 16) ua = *(const bf16x8*)(ubase + (size_t)(st + 1) * 16 * PROJ_LD);
            unsigned short uraw[2][4];
            if (PASS2) {
#pragma unroll
                for (int bb = 0; bb < 2; ++bb)
#pragma unroll
                    for (int r = 0; r < 4; ++r) uraw[bb][r] = proj[(size_t)(bb * SEQ + sg * S5_SEG + st * 16 + 4 * q + r) * PROJ_LD + g * 16 + h];
            }
            f32x16 x0r = {0.f, 0.f, 0.f, 0.f, 0.f, 0.f, 0.f, 0.f, 0.f, 0.f, 0.f, 0.f, 0.f, 0.f, 0.f, 0.f}, x0i = x0r, x1r = x0r, x1i = x0r;
            asm volatile("" : "+v"(x0r), "+v"(x0i), "+v"(x1r), "+v"(x1i));
            x0r = __builtin_amdgcn_mfma_f32_32x32x16_bf16(ucur, bf[0], x0r, 0, 0, 0); x0i = __builtin_amdgcn_mfma_f32_32x32x16_bf16(ucur, bf[1], x0i, 0, 0, 0);
            x1r = __builtin_amdgcn_mfma_f32_32x32x16_bf16(ucur, bf[2], x1r, 0, 0, 0); x1i = __builtin_amdgcn_mfma_f32_32x32x16_bf16(ucur, bf[3], x1i, 0, 0, 0);
#pragma unroll
            for (int t = 0; t < 16; ++t) {
                const float n0r = a0.x * s0r - a0.y * s0i + x0r[t], n0i = a0.x * s0i + a0.y * s0r + x0i[t]; s0r = n0r; s0i = n0i;
                const float n1r = a1.x * s1r - a1.y * s1i + x1r[t], n1i = a1.x * s1i + a1.y * s1r + x1i[t]; s1r = n1r; s1i = n1i;
                if (PASS2) { *(LAS unsigned*)(sl + (hh * 16 + t) * 272 + c * 4) = cvt_pk_bf16(s0r, s0i); *(LAS unsigned*)(sl + (hh * 16 + t) * 272 + 128 + c * 4) = cvt_pk_bf16(s1r, s1i); }
            }
            if (PASS2) {
                LDS_WAIT();
#pragma unroll
                for (int bb = 0; bb < 2; ++bb) {
                    f32x4 acc = (f32x4){0.f, 0.f, 0.f, 0.f};
#pragma unroll
                    for (int ks = 0; ks < 4; ++ks) { const bf16x8 av = *(const LAS bf16x8*)(sl + (bb * 16 + h) * 272 + ks * 64 + q * 16); acc = __builtin_amdgcn_mfma_f32_16x16x32_bf16(av, cf[ks], acc, 0, 0, 0); }
                    const size_t trow = (size_t)(bb * SEQ + sg * S5_SEG + st * 16 + 4 * q);
                    bf16_t* yo = (bf16_t*)(ws + OFF_YGELU) + trow * SSM_W + g * 16 + h;
#pragma unroll
                    for (int r = 0; r < 4; ++r) { const float uu = bf2f(uraw[bb][r]); const float y = gelu_tanh(acc[r] + dsk * uu); yo[(size_t)r * SSM_W] = (bf16_t)f2bf(y); }
                }
                LDS_WAIT();
            }
        }
        if (!PASS2) { f32x2* Eo = Ebuf + ((size_t)(hh * NGRP + g) * S5_NSEG + sg) * 64 + c; Eo[0] = (f32x2){s0r, s0i}; Eo[32] = (f32x2){s1r, s1i}; }
    }
}
__device__ __forceinline__ int vperm32(int k) { return 8 * ((k >> 2) & 3) + 4 * (k >> 4) + (k & 3); }

__device__ __forceinline__ void rope8(const u32x4 a, const u32x4 b, const float* cs, const float* sn, float (&o1)[8], float (&o2)[8]) {
    const unsigned aw[4] = {a.x, a.y, a.z, a.w}, bw[4] = {b.x, b.y, b.z, b.w};
#pragma unroll
    for (int k = 0; k < 4; ++k) {
        const float x1l = bflo(aw[k]), x1h = bfhi(aw[k]), x2l = bflo(bw[k]), x2h = bfhi(bw[k]);
        o1[2 * k] = x1l * cs[2 * k] - x2l * sn[2 * k]; o2[2 * k] = x2l * cs[2 * k] + x1l * sn[2 * k];
        o1[2 * k + 1] = x1h * cs[2 * k + 1] - x2h * sn[2 * k + 1]; o2[2 * k + 1] = x2h * cs[2 * k + 1] + x1h * sn[2 * k + 1];
    }
}
__device__ __forceinline__ void nsa_rope_layout(const Params& p, LAS unsigned char* lds, int vcu, int G) {
    const int tid = opqv(threadIdx.x), lane = tid & 63, wave = __builtin_amdgcn_readfirstlane(tid >> 6);
    const int gw = vcu * NWAVES + wave, NGW = G * NWAVES;
    unsigned char* ws = opqp(p.ws);
    const bf16_t* proj = (const bf16_t*)(ws + OFF_PROJ);
    bf16_t* Qr = (bf16_t*)(ws + OFF_QR);
    unsigned char* Q8 = (unsigned char*)(ws + OFF_Q8);
    const int* positions = (const int*)INP(1);
    LAS float* tab = (LAS float*)(lds + wave * 256);
    const float inv = powf(10000.f, -(float)(lane & 31) * (1.f / 32.f));
    const int hd = lane >> 2, qq = lane & 3;
    const int kidx = (lane >> 2) & 3, ktype = kidx >> 1, kkvh = kidx & 1, kcol = (ktype == 0 ? COL_KS : COL_KW) + kkvh * 64;
    u32x4 qa, qb, ka, kb; unsigned short gr = 0;
    auto fetch = [&](int t, u32x4& qa_, u32x4& qb_, u32x4& ka_, u32x4& kb_, unsigned short& g_) {
        const bf16_t* prow = proj + (size_t)t * PROJ_LD;
        qa_ = *(const u32x4*)(prow + COL_Q + hd * 64 + 8 * qq); qb_ = *(const u32x4*)(prow + COL_Q + hd * 64 + 32 + 8 * qq);
        ka_ = (u32x4){0u, 0u, 0u, 0u}; kb_ = ka_;
        if (lane < 16) { ka_ = *(const u32x4*)(prow + kcol + 8 * qq); kb_ = *(const u32x4*)(prow + kcol + 32 + 8 * qq); }
        g_ = lane < 48 ? prow[COL_G + lane] : (unsigned short)0;
    };
    if (gw < T_TOK) fetch(gw, qa, qb, ka, kb, gr);
    for (int t = gw; t < T_TOK; t += NGW) {
        const int b = t / SEQ, tl = t % SEQ;
        const float pos = (float)positions[t];
        u32x4 nqa = qa, nqb = qb, nka = ka, nkb = kb; unsigned short ngr = gr;
        if (t + NGW < T_TOK) fetch(t + NGW, nqa, nqb, nka, nkb, ngr);
        if (lane < 32) { float sn, cs; sincosf(pos * inv, &sn, &cs); tab[lane] = cs; tab[32 + lane] = sn; }
        LDS_WAIT();
        float cs[8], sn[8];
        { const f32x4 c0 = *(const LAS f32x4*)(tab + 8 * qq), c1 = *(const LAS f32x4*)(tab + 8 * qq + 4), s0 = *(const LAS f32x4*)(tab + 32 + 8 * qq), s1 = *(const LAS f32x4*)(tab + 32 + 8 * qq + 4);
#pragma unroll
          for (int k = 0; k < 4; ++k) { cs[k] = c0[k]; cs[4 + k] = c1[k]; sn[k] = s0[k]; sn[4 + k] = s1[k]; } }
        {
            float o1[8], o2[8]; rope8(qa, qb, cs, sn, o1, o2);
            bf16_t* qd = Qr + (size_t)t * 1024 + hd * 64 + 8 * qq;
            *(u32x4*)qd = (u32x4){pk2(o1[0] * 0.125f, o1[1] * 0.125f), pk2(o1[2] * 0.125f, o1[3] * 0.125f), pk2(o1[4] * 0.125f, o1[5] * 0.125f), pk2(o1[6] * 0.125f, o1[7] * 0.125f)};
            *(u32x4*)(qd + 32) = (u32x4){pk2(o2[0] * 0.125f, o2[1] * 0.125f), pk2(o2[2] * 0.125f, o2[3] * 0.125f), pk2(o2[4] * 0.125f, o2[5] * 0.125f), pk2(o2[6] * 0.125f, o2[7] * 0.125f)};
            unsigned char* q8 = Q8 + (size_t)t * 1024 + hd * 64 + 8 * qq;
            *(u32x2*)q8 = (u32x2){pk4_fp8(o1[0], o1[1], o1[2], o1[3]), pk4_fp8(o1[4], o1[5], o1[6], o1[7])};
            *(u32x2*)(q8 + 32) = (u32x2){pk4_fp8(o2[0], o2[1], o2[2], o2[3]), pk4_fp8(o2[4], o2[5], o2[6], o2[7])};
        }
        if (lane < 16) {
            float o1[8], o2[8]; rope8(ka, kb, cs, sn, o1, o2);
            if (ktype == 0) {
                unsigned char* dst = (unsigned char*)(ws + OFF_KSEL) + ((size_t)(b * 2 + kkvh) * SEQ + (tl & ~63)) * 64 + ((tl & 63) >> 4) * 1024 + (qq * 16 + (tl & 15)) * 16;
                *(u32x4*)dst = (u32x4){pk4_fp8(o1[0], o1[1], o1[2], o1[3]), pk4_fp8(o1[4], o1[5], o1[6], o1[7]), pk4_fp8(o2[0], o2[1], o2[2], o2[3]), pk4_fp8(o2[4], o2[5], o2[6], o2[7])};
            } else {
                bf16_t* dst = (bf16_t*)(ws + OFF_KWIN) + ((size_t)(b * 2 + kkvh) * SEQ + tl) * 64 + 8 * qq;
                *(u32x4*)dst = (u32x4){pk2(o1[0], o1[1]), pk2(o1[2], o1[3]), pk2(o1[4], o1[5]), pk2(o1[6], o1[7])};
                *(u32x4*)(dst + 32) = (u32x4){pk2(o2[0], o2[1]), pk2(o2[2], o2[3]), pk2(o2[4], o2[5]), pk2(o2[6], o2[7])};
            }
        }
        if (lane < 48) ((float*)(ws + OFF_GATES))[(size_t)t * 48 + lane] = sigmoidf_(bf2f(gr));
        LDS_WAIT();
        qa = nqa; qb = nqb; ka = nka; kb = nkb; gr = ngr;
    }
}

__device__ __forceinline__ void nsa_vtranspose(const Params& p, LAS unsigned char* lds, int vcu, int G) {
    const int tid = opqv(threadIdx.x), lane = tid & 63, wave = __builtin_amdgcn_readfirstlane(tid >> 6);
    const int gw = vcu * NWAVES + wave, NGW = G * NWAVES;
    unsigned char* ws = opqp(p.ws);
    const bf16_t* proj = (const bf16_t*)(ws + OFF_PROJ);
    LAS unsigned char* sl = lds + wave * 9216;
    for (int task = gw; task < 2 * 4 * 128; task += NGW) {
        const int blk = task & 127, bk = (task >> 7) & 3, type = task >> 9, b = bk >> 1, kvh = bk & 1;
        const bf16_t* src = proj + (size_t)(b * SEQ + blk * 64 + lane) * PROJ_LD + (type == 0 ? COL_VS : COL_VW) + kvh * 64;
#pragma unroll
        for (int i = 0; i < 8; ++i) *(LAS u32x4*)(sl + lane * 144 + 16 * i) = *(const u32x4*)(src + 8 * i);
        LDS_WAIT();
        if (type == 0) {
            unsigned char* dst8 = (unsigned char*)(ws + OFF_VSELT) + (size_t)(bk * 128 + blk) * 4096 + (lane >> 4) * 1024 + (lane & 15) * 16;
#pragma unroll
            for (int qv = 0; qv < 4; ++qv) {
                unsigned w[4];
#pragma unroll
                for (int jj = 0; jj < 4; ++jj) {
                    float f[4];
#pragma unroll
                    for (int e = 0; e < 4; ++e) { const int p0 = 32 * (jj >> 1) + 8 * qv + 4 * (jj & 1) + e; const int k0 = 32 * (p0 >> 5) + ((p0 & 7) >> 2) * 16 + 4 * ((p0 >> 3) & 3) + (p0 & 3); f[e] = bf2f(*(const LAS bf16_t*)(sl + k0 * 144 + lane * 2)); }
                    w[jj] = pk4_fp8(f[0], f[1], f[2], f[3]);
                }
                *(u32x4*)(dst8 + 256 * qv) = (u32x4){w[0], w[1], w[2], w[3]};
            }
            LDS_WAIT();
            continue;
        }
        bf16_t* dst = (bf16_t*)(ws + OFF_VWINT) + ((size_t)(bk * 128 + blk) * 64 + lane) * 64;
#pragma unroll
        for (int c8 = 0; c8 < 8; ++c8) {
            unsigned w[4];
#pragma unroll
            for (int jj = 0; jj < 4; ++jj) {
                const int p0 = c8 * 8 + 2 * jj, p1 = p0 + 1;
                const int k0 = 32 * (p0 >> 5) + ((p0 & 7) >> 2) * 16 + 4 * ((p0 >> 3) & 3) + (p0 & 3), k1 = 32 * (p1 >> 5) + ((p1 & 7) >> 2) * 16 + 4 * ((p1 >> 3) & 3) + (p1 & 3);
                const unsigned lo = *(const LAS bf16_t*)(sl + k0 * 144 + lane * 2), hi = *(const LAS bf16_t*)(sl + k1 * 144 + lane * 2);
                w[jj] = lo | (hi << 16);
            }
            *(u32x4*)(dst + 8 * c8) = (u32x4){w[0], w[1], w[2], w[3]};
        }
        LDS_WAIT();
    }
}

__device__ __forceinline__ void nsa_compress(const Params& p, LAS unsigned char* lds, int vcu, int G) {
    const int tid = opqv(threadIdx.x), lane = tid & 63, wave = __builtin_amdgcn_readfirstlane(tid >> 6), fr = lane & 15, fq = lane >> 4;
    unsigned char* ws = opqp(p.ws);
    const bf16_t* proj = (const bf16_t*)(ws + OFF_PROJ);
    LAS float* hid = (LAS float*)lds;
    LAS float* w2s = (LAS float*)(lds + 16384);
    for (int rt = vcu; rt < 256; rt += G) {
        const int rr0 = rt * 16, which = rr0 >> 11, bk = (rr0 >> 9) & 3, b = bk >> 1, kvh = bk & 1, n0 = rr0 & 511;
        const int na = (n0 + fr) > (NCMP - 1) ? (NCMP - 1) : (n0 + fr);
        const bf16_t* arow = proj + (size_t)(b * SEQ + 16 * na) * PROJ_LD + COL_KC + which * 128 + kvh * 64 + 8 * fq;
        const bf16_t* brow = (const bf16_t*)(ws + OFF_WC1T) + (size_t)(which * 128 + wave * 16 + fr) * DM + 8 * fq;
        {
            const float* w2 = INP(which ? 17 : 15);
            f32x4 wv[4];
#pragma unroll
            for (int i = 0; i < 4; ++i) wv[i] = *(const f32x4*)(w2 + 4 * (tid + i * NTHREADS));
#pragma unroll
            for (int i = 0; i < 4; ++i) *(LAS f32x4*)(w2s + 4 * (tid + i * NTHREADS)) = wv[i];
        }
        f32x4 acc = (f32x4){0.f, 0.f, 0.f, 0.f};
#pragma unroll 8
        for (int ks = 0; ks < 64; ++ks) {
            const bf16x8 a = *(const bf16x8*)(arow + (size_t)(ks >> 1) * PROJ_LD + (ks & 1) * 32);
            const bf16x8 bv = *(const bf16x8*)(brow + ks * 32);
            acc = __builtin_amdgcn_mfma_f32_16x16x32_bf16(a, bv, acc, 0, 0, 0);
        }
        float bias = 0.f;
#pragma unroll
        for (int pt = 0; pt < 16; ++pt) bias += ((const float*)(ws + OFF_CBIAS))[(which * 16 + pt) * 128 + wave * 16 + fr];
#pragma unroll
        for (int r = 0; r < 4; ++r) hid[(4 * fq + r) * 132 + wave * 16 + fr] = gelu_tanh(acc[r] + bias);
        __syncthreads();
        {
            const int row = tid >> 5, d = tid & 31;
            float o1 = 0.f, o2 = 0.f;
#pragma unroll 8
            for (int c = 0; c < 128; ++c) { const float hv = hid[row * 132 + c]; o1 += hv * w2s[c * 64 + d]; o2 += hv * w2s[c * 64 + 32 + d]; }
            const int n = n0 + row; const bool valid = n < NCMP;
            if (which == 0) {
                const int* positions = (const int*)INP(1);
                const int nn = valid ? n : NCMP - 1;
                float ps = 0.f;
#pragma unroll
                for (int t = 0; t < 32; ++t) ps += (float)positions[b * SEQ + 16 * nn + t];
                const float posm = ps * (1.f / 32.f);
                const float inv = powf(10000.f, -(float)d * (1.f / 32.f));
                float sn, cs; sincosf(posm * inv, &sn, &cs);
                bf16_t* dst = (bf16_t*)(ws + OFF_KC) + ((size_t)bk * 512 + n) * 64;
                dst[d] = valid ? (bf16_t)f2bf(o1 * cs - o2 * sn) : (bf16_t)0;
                dst[32 + d] = valid ? (bf16_t)f2bf(o2 * cs + o1 * sn) : (bf16_t)0;
            } else {
                const int pos = 32 * (n >> 5) + vperm32(n & 31);
                bf16_t* dst = (bf16_t*)(ws + OFF_VCT) + (size_t)bk * 64 * 512 + pos;
                dst[(size_t)d * 512] = valid ? (bf16_t)f2bf(o1) : (bf16_t)0;
                dst[(size_t)(d + 32) * 512] = valid ? (bf16_t)f2bf(o2) : (bf16_t)0;
            }
        }
        __syncthreads();
    }
}
__device__ __forceinline__ bf16x8 pack_p(const f32x4 a, const f32x4 b) {
    u32x4 w; w.x = cvt_pk_bf16(a[0], a[1]); w.y = cvt_pk_bf16(a[2], a[3]); w.z = cvt_pk_bf16(b[0], b[1]); w.w = cvt_pk_bf16(b[2], b[3]);
    return __builtin_bit_cast(bf16x8, w);
}
__device__ __forceinline__ f32x4 mfma16(const bf16x8 a, const bf16x8 b, const f32x4 c) { return __builtin_amdgcn_mfma_f32_16x16x32_bf16(a, b, c, 0, 0, 0); }
#define ZERO4 ((f32x4){0.f, 0.f, 0.f, 0.f})
__device__ __forceinline__ float xq_max(float x) {
    float a = x, b = x; swap16(a, b); float y = fmaxf(a, b);
    a = y; b = y; swap32(a, b); return fmaxf(a, b);
}
__device__ __forceinline__ float xq_sum(float x) {
    float a = x, b = x; swap16(a, b); float y = a + b;
    a = y; b = y; swap32(a, b); return a + b;
}
__device__ __forceinline__ float oct_sum(float x) {
    x += __builtin_bit_cast(float, __builtin_amdgcn_update_dpp(0, __builtin_bit_cast(int, x), 0xB1, 0xf, 0xf, false));
    x += __builtin_bit_cast(float, __builtin_amdgcn_update_dpp(0, __builtin_bit_cast(int, x), 0x4E, 0xf, 0xf, false));
    x += __builtin_bit_cast(float, __builtin_amdgcn_update_dpp(0, __builtin_bit_cast(int, x), 0x141, 0xf, 0xf, false));
    return x;
}
__device__ __forceinline__ unsigned wave_umax(unsigned x) {
    unsigned t;
    t = (unsigned)__builtin_amdgcn_update_dpp(0, (int)x, 0xB1, 0xf, 0xf, false); x = t > x ? t : x;
    t = (unsigned)__builtin_amdgcn_update_dpp(0, (int)x, 0x4E, 0xf, 0xf, false); x = t > x ? t : x;
    t = (unsigned)__builtin_amdgcn_update_dpp(0, (int)x, 0x141, 0xf, 0xf, false); x = t > x ? t : x;
    t = (unsigned)__builtin_amdgcn_update_dpp(0, (int)x, 0x140, 0xf, 0xf, false); x = t > x ? t : x;
    const unsigned a = __builtin_amdgcn_readlane(x, 0), b = __builtin_amdgcn_readlane(x, 16), c = __builtin_amdgcn_readlane(x, 32), d = __builtin_amdgcn_readlane(x, 48);
    const unsigned ab = a > b ? a : b, cd = c > d ? c : d; return ab > cd ? ab : cd;
}
__device__ __forceinline__ int swz128(int row, int ch) { return row * 128 + ((ch ^ ((row >> 1) & 7)) << 4); }
__device__ __forceinline__ int swz1024(int row, int ch) { return row * 1024 + ((ch ^ (row & 15)) << 4); }

constexpr int CMP_LDS_K = 0, CMP_LDS_V = 65536, CMP_LDS_IMP = 131072, CMP_LDS_SC = 131072 + 8192;
__device__ __forceinline__ void nsa_cmp_stage(const Params& p, LAS unsigned char* lds, int bk) {
    const int tid = opqv(threadIdx.x);
    const u32x4* kc = (const u32x4*)(opqp(p.ws) + OFF_KC) + (size_t)bk * 4096;
    const u32x4* vc = (const u32x4*)(opqp(p.ws) + OFF_VCT) + (size_t)bk * 4096;
    for (int i = tid; i < 4096; i += NTHREADS) {
        *(LAS u32x4*)(lds + CMP_LDS_K + swz128(i >> 3, i & 7)) = kc[i];
        *(LAS u32x4*)(lds + CMP_LDS_V + swz1024(i >> 6, i & 63)) = vc[i];
    }
}
__device__ __forceinline__ void nsa_cmp_unit(const Params& p, LAS unsigned char* lds, int bk, int qt) {
    const int tid = opqv(threadIdx.x), lane = tid & 63, wave = __builtin_amdgcn_readfirstlane(tid >> 6);
    const int qrow = lane & 15, q = lane >> 4, b = bk >> 1, kvh = bk & 1;
    unsigned char* ws = opqp(p.ws);
    const int t0 = qt * 16 + wave * 2, tok = t0 + (qrow >> 3), head = kvh * 8 + (qrow & 7);
    const bf16_t* qp = (const bf16_t*)(ws + OFF_QR) + (size_t)(b * SEQ + tok) * 1024 + head * 64 + 8 * q;
    const bf16x8 qf0 = *(const bf16x8*)qp, qf1 = *(const bf16x8*)(qp + 32);
    const int nv = tok >= 31 ? ((tok - 31) >> 4) + 1 : 0;
    const int nvmax = (t0 + 1) >= 31 ? ((t0 + 1 - 31) >> 4) + 1 : 0;
    const int NBk = (nvmax + 15) >> 4;
    f32x4 S[32];
#pragma unroll
    for (int jb = 0; jb < 32; ++jb) {
        S[jb] = ZERO4;
        if (jb < NBk) {
            const bf16x8 a0 = *(const LAS bf16x8*)(lds + CMP_LDS_K + swz128(16 * jb + qrow, q)), a1 = *(const LAS bf16x8*)(lds + CMP_LDS_K + swz128(16 * jb + qrow, 4 + q));
            S[jb] = mfma16(a1, qf1, mfma16(a0, qf0, ZERO4));
        }
        if ((jb & 3) == 3) __builtin_amdgcn_sched_barrier(0);
    }
    float m = -1e30f;
    int c0 = opqv(4 * q), c1 = opqv(4 * q + 1), c2 = opqv(4 * q + 2), c3 = opqv(4 * q + 3);
    const int cr[4] = {c0, c1, c2, c3};
    const int nv0 = t0 >= 31 ? ((t0 - 31) >> 4) + 1 : 0;
#pragma unroll
    for (int jb = 0; jb < 32; ++jb) if (jb < NBk) {
        if (16 * jb + 16 > nv0) {
            const int rem = nv - 16 * jb;
#pragma unroll
            for (int r = 0; r < 4; ++r) S[jb][r] = (cr[r] < rem) ? S[jb][r] : -1e30f;
        }
        m = fmaxf(m, fmaxf(fmaxf(S[jb][0], S[jb][1]), fmaxf(S[jb][2], S[jb][3])));
        if ((jb & 7) == 7) __builtin_amdgcn_sched_barrier(0);
    }
    m = xq_max(m);
    float l = 0.f;
    constexpr float L2E = 1.4426950408889634f;
#pragma unroll
    for (int jb = 0; jb < 32; ++jb) if (jb < NBk) {
#pragma unroll
        for (int r = 0; r < 4; ++r) { const float e = __builtin_amdgcn_exp2f((S[jb][r] - m) * L2E); S[jb][r] = e; l += e; }
        if ((jb & 3) == 3) __builtin_amdgcn_sched_barrier(0);
    }
    l = xq_sum(l);
    const float linv = (l > 0.f && nv > 0) ? 1.f / l : 0.f;
#pragma unroll
    for (int jb = 0; jb < 32; ++jb) if (jb < NBk) S[jb] = S[jb] * linv;
    LAS float* impL = (LAS float*)(lds + CMP_LDS_IMP + wave * 1024);
#pragma unroll
    for (int jb = 0; jb < 32; ++jb) {
        const float rs = (S[jb][0] + S[jb][1]) + (S[jb][2] + S[jb][3]);
        const float prev3 = jb > 0 ? S[jb > 0 ? jb - 1 : 0][3] : 0.f;
        const float prov = (q == 3) ? prev3 : S[jb][3];
        const float nbv = __shfl(prov, (lane - 16) & 63);
        float im = rs + nbv;
        im = oct_sum(im);
        if ((lane & 7) == 0) impL[(qrow >> 3) * 128 + 4 * jb + q] = im;
        if ((jb & 3) == 3) __builtin_amdgcn_sched_barrier(0);
    }
    LDS_WAIT();
    int* selo = (int*)(ws + OFF_SEL);
#pragma unroll 1
    for (int tk = 0; tk < 2; ++tk) {
        const int tokn = t0 + tk, cur = tokn >> 6;
        const int sa = lane, sb = lane + 64;
        const bool fa = (sa == 0) | (sa == cur) | (sa == cur - 1), fb = (sb == cur) | (sb == cur - 1);
        const float ia = impL[tk * 128 + sa], ib = impL[tk * 128 + sb];
        unsigned ka = (!fa && sa <= cur) ? (0x80000000u | ((__builtin_bit_cast(unsigned, ia) >> 8) << 7) | (unsigned)(127 - sa)) : 0u;
        unsigned kb = (!fb && sb <= cur) ? (0x80000000u | ((__builtin_bit_cast(unsigned, ib) >> 8) << 7) | (unsigned)(127 - sb)) : 0u;
        int* so = selo + ((size_t)bk * SEQ + tokn) * 16;
        int nf = 1;
        if (lane == 0) { so[0] = 0; if (cur >= 2) { so[1] = cur - 1; so[2] = cur; } else if (cur == 1) so[1] = 1; }
        nf = cur >= 2 ? 3 : (cur == 1 ? 2 : 1);
#pragma unroll 1
        for (int r = nf; r < 16; ++r) {
            const unsigned k = wave_umax(ka > kb ? ka : kb);
            if (k == 0u) { if (lane == 0) so[r] = 127; continue; }
            if (ka == k) ka = 0u;
            if (kb == k) kb = 0u;
            if (lane == 0) so[r] = 127 - (int)(k & 127u);
        }
    }
    f32x4 O[4] = {ZERO4, ZERO4, ZERO4, ZERO4};
#pragma unroll
    for (int s32 = 0; s32 < 16; ++s32) if (2 * s32 < NBk) {
        const bf16x8 pb = pack_p(S[2 * s32], S[2 * s32 + 1]);
#pragma unroll
        for (int dg = 0; dg < 4; ++dg) { const bf16x8 va = *(const LAS bf16x8*)(lds + CMP_LDS_V + swz1024(16 * dg + qrow, 4 * s32 + q)); O[dg] = mfma16(va, pb, O[dg]); }
    }
    const float gate = ((const float*)(ws + OFF_GATES))[(size_t)(b * SEQ + tok) * 48 + head * 3 + 0];
    bf16_t* yo = (bf16_t*)(ws + OFF_SLOT64) + (size_t)(b * SEQ + tok) * 1024 + head * 64 + 4 * q;
#pragma unroll
    for (int dg = 0; dg < 4; ++dg) *(u32x2*)(yo + 16 * dg) = (u32x2){pk2(O[dg][0] * gate, O[dg][1] * gate), pk2(O[dg][2] * gate, O[dg][3] * gate)};
}

__device__ __forceinline__ void nsa_win_unit(const Params& p, LAS unsigned char* lds, int bk, int kb64) {
    const int tid = opqv(threadIdx.x), lane = tid & 63, wave = __builtin_amdgcn_readfirstlane(tid >> 6);
    const int qrow = lane & 15, q = lane >> 4, b = bk >> 1, kvh = bk & 1;
    unsigned char* ws = opqp(p.ws);
    const int t0 = kb64 * 64, kt_lo = kb64 > 8 ? kb64 - 8 : 0, ntile = kb64 - kt_lo + 1;
    const u32x4* Kg = (const u32x4*)(ws + OFF_KWIN) + (size_t)bk * SEQ * 8 + (size_t)kt_lo * 512;
    const u32x4* Vg = (const u32x4*)(ws + OFF_VWINT) + (size_t)bk * 128 * 512 + (size_t)kt_lo * 512;
    __syncthreads();
    for (int i = 0; i < ntile; ++i) {
        *(LAS u32x4*)(lds + i * 16384 + swz128(tid >> 3, tid & 7)) = Kg[(size_t)i * 512 + tid];
        *(LAS u32x4*)(lds + i * 16384 + 8192 + swz128(tid >> 3, tid & 7)) = Vg[(size_t)i * 512 + tid];
    }
    __syncthreads();
#pragma unroll 1
    for (int ss = 0; ss < 4; ++ss) {
        const int tok = t0 + 16 * ss + wave * 2 + (qrow >> 3), head = kvh * 8 + (qrow & 7);
        const bf16_t* qp = (const bf16_t*)(ws + OFF_QR) + (size_t)(b * SEQ + tok) * 1024 + head * 64 + 8 * q;
        const bf16x8 qf0 = *(const bf16x8*)qp, qf1 = *(const bf16x8*)(qp + 32);
        float m_run = -1e30f, l_run = 0.f;
        f32x4 O[4] = {ZERO4, ZERO4, ZERO4, ZERO4};
#pragma unroll 1
        for (int i = 0; i < ntile; ++i) {
            const int kt = kt_lo + i;
            LAS unsigned char* kl = lds + i * 16384; LAS unsigned char* vl = kl + 8192;
            f32x4 S[4]; float mt = -1e30f;
#pragma unroll
            for (int kb = 0; kb < 4; ++kb) {
                const bf16x8 a0 = *(const LAS bf16x8*)(kl + swz128(16 * kb + qrow, q)), a1 = *(const LAS bf16x8*)(kl + swz128(16 * kb + qrow, 4 + q));
                S[kb] = mfma16(a1, qf1, mfma16(a0, qf0, ZERO4));
            }
            if (kt == kb64 || kt + 8 <= kb64) {
#pragma unroll
                for (int kb = 0; kb < 4; ++kb)
#pragma unroll
                    for (int r = 0; r < 4; ++r) { const int kp = kt * 64 + 16 * kb + 4 * q + r; const bool ok = (kp <= tok) & (kp > tok - WINDOW); S[kb][r] = ok ? S[kb][r] : -1e30f; }
            }
#pragma unroll
            for (int kb = 0; kb < 4; ++kb) mt = fmaxf(mt, fmaxf(fmaxf(S[kb][0], S[kb][1]), fmaxf(S[kb][2], S[kb][3])));
            mt = xq_max(mt);
            constexpr float L2E = 1.4426950408889634f;
            const float m_new = fmaxf(m_run, mt), alpha = __builtin_amdgcn_exp2f((m_run - m_new) * L2E);
            float ls = 0.f;
            if (m_new > -1e29f) {
#pragma unroll
                for (int kb = 0; kb < 4; ++kb)
#pragma unroll
                    for (int r = 0; r < 4; ++r) { const float e = __builtin_amdgcn_exp2f((S[kb][r] - m_new) * L2E); S[kb][r] = e; ls += e; }
            } else {
#pragma unroll
                for (int kb = 0; kb < 4; ++kb) S[kb] = ZERO4;
            }
            l_run = l_run * alpha + ls; m_run = m_new;
#pragma unroll
            for (int dg = 0; dg < 4; ++dg) O[dg] = O[dg] * alpha;
#pragma unroll
            for (int s32 = 0; s32 < 2; ++s32) {
                const bf16x8 pb = pack_p(S[2 * s32], S[2 * s32 + 1]);
#pragma unroll
                for (int dg = 0; dg < 4; ++dg) { const bf16x8 va = *(const LAS bf16x8*)(vl + swz128(16 * dg + qrow, 4 * s32 + q)); O[dg] = mfma16(va, pb, O[dg]); }
            }
        }
        l_run = xq_sum(l_run);
        const float gate = ((const float*)(ws + OFF_GATES))[(size_t)(b * SEQ + tok) * 48 + head * 3 + 2];
        const float sc = l_run > 0.f ? gate / l_run : 0.f;
        bf16_t* yo = (bf16_t*)(ws + OFF_SLOT64) + (size_t)T_TOK * 1024 + (size_t)(b * SEQ + tok) * 1024 + head * 64 + 4 * q;
#pragma unroll
        for (int dg = 0; dg < 4; ++dg) *(u32x2*)(yo + 16 * dg) = (u32x2){pk2(O[dg][0] * sc, O[dg][1] * sc), pk2(O[dg][2] * sc, O[dg][3] * sc)};
    }
}

typedef long l2 __attribute__((ext_vector_type(2)));
__device__ __forceinline__ f32x4 mfma8(long a, long b, const f32x4 c) { return __builtin_amdgcn_mfma_f32_16x16x32_fp8_fp8(a, b, c, 0, 0, 0); }
__device__ __forceinline__ long pack_p8(const f32x4 a, const f32x4 b) { const unsigned lo = pk4_fp8(a[0], a[1], a[2], a[3]), hi = pk4_fp8(b[0], b[1], b[2], b[3]); return (long)(((unsigned long long)hi << 32) | lo); }
__device__ __forceinline__ void sel_ld(l2 (&d)[4], const char* gblk, int lane) {
    const GAS l2* src = (const GAS l2*)(unsigned long long)gblk + lane;
#pragma unroll
    for (int i = 0; i < 4; ++i) d[i] = src[64 * i];
}
__device__ __forceinline__ void sel_iter(l2 (&kA)[4], l2 (&kB)[4], l2 (&vA)[4], l2 (&vB)[4], const long (&qA)[2], const long (&qB)[2], f32x4 (&O)[4], float& m_run, float& l_run,
                                         int s0, int s1, int sn0, int sn1, const char* Kg, const char* Vg, int cur, int tokm, bool lo, int q, int lane) {
    constexpr float SC = 0.125f * 1.4426950408889634f;
    f32x4 S[4];
#pragma unroll
    for (int kb = 0; kb < 4; ++kb) S[kb] = mfma8(kA[kb][0], qA[0], ZERO4);
#pragma unroll
    for (int kb = 0; kb < 4; ++kb) S[kb] = mfma8(kA[kb][1], qA[1], S[kb]);
#pragma unroll
    for (int kb = 0; kb < 4; ++kb) S[kb] = mfma8(kB[kb][0], qB[0], S[kb]);
#pragma unroll
    for (int kb = 0; kb < 4; ++kb) S[kb] = mfma8(kB[kb][1], qB[1], S[kb]);
    __builtin_amdgcn_sched_barrier(0);
    sel_ld(kA, Kg + (size_t)sn0 * 4096, lane); sel_ld(kB, Kg + (size_t)sn1 * 4096, lane);
    __builtin_amdgcn_sched_barrier(0);
    if (s0 == cur || s1 == cur) {
        const int lim = tokm - (lo ? s0 : s1) * 64 - 4 * q;
#pragma unroll
        for (int kb = 0; kb < 4; ++kb)
#pragma unroll
            for (int r = 0; r < 4; ++r) S[kb][r] = (16 * kb + r <= lim) ? S[kb][r] : -1e30f;
    }
    float mt = -1e30f;
#pragma unroll
    for (int kb = 0; kb < 4; ++kb) mt = fmaxf(mt, fmaxf(fmaxf(S[kb][0], S[kb][1]), fmaxf(S[kb][2], S[kb][3])));
    mt = xq_max(mt);
    const float m_new = fmaxf(m_run, mt), alpha = __builtin_amdgcn_exp2f((m_run - m_new) * SC);
    const float mb = m_new * SC;
    float ls = 0.f;
#pragma unroll
    for (int kb = 0; kb < 4; ++kb)
#pragma unroll
        for (int r = 0; r < 4; ++r) { const float e = __builtin_amdgcn_exp2f(S[kb][r] * SC - mb); S[kb][r] = e; ls += e; }
    l_run = l_run * alpha + ls; m_run = m_new;
#pragma unroll
    for (int dg = 0; dg < 4; ++dg) O[dg] = O[dg] * alpha;
    const long pb0 = pack_p8(S[0], S[1]), pb1 = pack_p8(S[2], S[3]);
    const long pA0 = lo ? pb0 : 0l, pA1 = lo ? pb1 : 0l, pB0 = lo ? 0l : pb0, pB1 = lo ? 0l : pb1;
#pragma unroll
    for (int dg = 0; dg < 4; ++dg) O[dg] = mfma8(vA[dg][0], pA0, O[dg]);
#pragma unroll
    for (int dg = 0; dg < 4; ++dg) O[dg] = mfma8(vA[dg][1], pA1, O[dg]);
#pragma unroll
    for (int dg = 0; dg < 4; ++dg) O[dg] = mfma8(vB[dg][0], pB0, O[dg]);
#pragma unroll
    for (int dg = 0; dg < 4; ++dg) O[dg] = mfma8(vB[dg][1], pB1, O[dg]);
    __builtin_amdgcn_sched_barrier(0);
    sel_ld(vA, Vg + (size_t)sn0 * 4096, lane); sel_ld(vB, Vg + (size_t)sn1 * 4096, lane);
    __builtin_amdgcn_sched_barrier(0);
}
struct SelTask { int bk, tok0, b, kvh, cur, nval; const char* Kg; const char* Vg; };
__device__ __forceinline__ SelTask sel_task(unsigned char* ws, int task) {
    SelTask t; t.bk = task / (SEQ / 2); t.tok0 = (task % (SEQ / 2)) * 2; t.b = t.bk >> 1; t.kvh = t.bk & 1; t.cur = t.tok0 >> 6; t.nval = t.cur + 1 < 16 ? t.cur + 1 : 16;
    t.Kg = (const char*)(ws + OFF_KSEL) + (size_t)t.bk * SEQ * 64; t.Vg = (const char*)(ws + OFF_VSELT) + (size_t)t.bk * 128 * 4096;
    return t;
}
struct SelOps { long q0, q1; int l0, l1; };
__device__ __forceinline__ SelOps sel_ops(unsigned char* ws, const SelTask& t, int lane) {
    const int qrow = lane & 15, q = lane >> 4;
    const GAS int* selg = (const GAS int*)(unsigned long long)(ws + OFF_SEL);
    const GAS unsigned char* qp = (const GAS unsigned char*)(unsigned long long)(ws + OFF_Q8) + (size_t)(t.b * SEQ + t.tok0 + (qrow >> 3)) * 1024 + (t.kvh * 8 + (qrow & 7)) * 64 + 8 * q;
    SelOps o; o.q0 = *(const GAS long*)qp; o.q1 = *(const GAS long*)(qp + 32);
    o.l0 = selg[((size_t)t.bk * SEQ + t.tok0) * 16 + qrow]; o.l1 = selg[((size_t)t.bk * SEQ + t.tok0 + 1) * 16 + qrow];
    return o;
}
__device__ __forceinline__ void nsa_sel_phase(const Params& p, LAS unsigned char* lds, int vcu, int G) {
    const int tid = opqv(threadIdx.x), lane = tid & 63, wave = __builtin_amdgcn_readfirstlane(tid >> 6);
    const int gw = vcu * NWAVES + wave, NGW = G * NWAVES;
    const int qrow = lane & 15, q = lane >> 4;
    const bool lo = qrow < 8;
    unsigned char* ws = opqp(p.ws);
    l2 kA0[4], kB0[4], vA0[4], vB0[4], kA1[4], kB1[4], vA1[4], vB1[4];
    SelOps oc = {0l, 0l, 0, 0}, on = {0l, 0l, 0, 0};
    if (gw < 2 * SEQ) oc = sel_ops(ws, sel_task(ws, gw), lane);
    if (gw + NGW < 2 * SEQ) on = sel_ops(ws, sel_task(ws, gw + NGW), lane);
    asm volatile("" : "+v"(oc.q0), "+v"(oc.q1), "+v"(oc.l0), "+v"(oc.l1), "+v"(on.q0), "+v"(on.q1), "+v"(on.l0), "+v"(on.l1));
    bool have = false;
    for (int task = gw; task < 2 * SEQ; task += NGW) {
        const SelTask t = sel_task(ws, task);
        const int tok0 = t.tok0, b = t.b, head = t.kvh * 8 + (qrow & 7), cur = t.cur, nval = t.nval;
        const int tokm = tok0 + (qrow >> 3);
        const char* Kg = t.Kg; const char* Vg = t.Vg;
        long qA[2], qB[2];
        qA[0] = lo ? oc.q0 : 0l; qA[1] = lo ? oc.q1 : 0l; qB[0] = lo ? 0l : oc.q0; qB[1] = lo ? 0l : oc.q1;
        const int taskN = task + NGW; const bool hasN = taskN < 2 * SEQ;
        const SelTask tn = sel_task(ws, hasN ? taskN : task);
        const bool chain = hasN && nval == 16 && tn.nval == 16;
        const int selv0 = (lane & 16) ? on.l0 : oc.l0, selv1 = (lane & 16) ? on.l1 : oc.l1;
        if (!have) {
            const int a0 = __builtin_amdgcn_readlane(selv0, 0), a1 = __builtin_amdgcn_readlane(selv1, 0);
            const int j1 = nval > 1 ? 1 : 0;
            const int c0 = __builtin_amdgcn_readlane(selv0, j1), c1 = __builtin_amdgcn_readlane(selv1, j1);
            __builtin_amdgcn_sched_barrier(0);
            sel_ld(kA0, Kg + (size_t)a0 * 4096, lane); sel_ld(kB0, Kg + (size_t)a1 * 4096, lane);
            __builtin_amdgcn_sched_barrier(0);
            sel_ld(vA0, Vg + (size_t)a0 * 4096, lane); sel_ld(vB0, Vg + (size_t)a1 * 4096, lane);
            __builtin_amdgcn_sched_barrier(0);
            sel_ld(kA1, Kg + (size_t)c0 * 4096, lane); sel_ld(kB1, Kg + (size_t)c1 * 4096, lane);
            __builtin_amdgcn_sched_barrier(0);
            sel_ld(vA1, Vg + (size_t)c0 * 4096, lane); sel_ld(vB1, Vg + (size_t)c1 * 4096, lane);
            __builtin_amdgcn_sched_barrier(0);
        }
        float m_run = -1e30f, l_run = 0.f;
        f32x4 O[4] = {ZERO4, ZERO4, ZERO4, ZERO4};
        int j = 0;
#pragma unroll 1
        for (; j + 1 < nval; j += 2) {
            const bool in0 = j + 2 < nval, in1 = j + 3 < nval;
            const bool nx0 = !in0 && chain, nx1 = !in1 && chain;
            const int jn0 = in0 ? j + 2 : (chain ? 16 + j + 2 - nval : nval - 1), jn1 = in1 ? j + 3 : (chain ? 16 + j + 3 - nval : nval - 1);
            sel_iter(kA0, kB0, vA0, vB0, qA, qB, O, m_run, l_run, __builtin_amdgcn_readlane(selv0, j), __builtin_amdgcn_readlane(selv1, j),
                     __builtin_amdgcn_readlane(selv0, jn0), __builtin_amdgcn_readlane(selv1, jn0), nx0 ? tn.Kg : Kg, nx0 ? tn.Vg : Vg, cur, tokm, lo, q, lane);
            sel_iter(kA1, kB1, vA1, vB1, qA, qB, O, m_run, l_run, __builtin_amdgcn_readlane(selv0, j + 1), __builtin_amdgcn_readlane(selv1, j + 1),
                     __builtin_amdgcn_readlane(selv0, jn1), __builtin_amdgcn_readlane(selv1, jn1), nx1 ? tn.Kg : Kg, nx1 ? tn.Vg : Vg, cur, tokm, lo, q, lane);
        }
        if (j < nval) {
            const int sl0 = __builtin_amdgcn_readlane(selv0, j), sl1 = __builtin_amdgcn_readlane(selv1, j);
            sel_iter(kA0, kB0, vA0, vB0, qA, qB, O, m_run, l_run, sl0, sl1, sl0, sl1, Kg, Vg, cur, tokm, lo, q, lane);
        }
        SelOps onn = {0l, 0l, 0, 0};
        if (taskN + NGW < 2 * SEQ) onn = sel_ops(ws, sel_task(ws, taskN + NGW), lane);
        {
            const float lr = xq_sum(l_run);
            const float gate = ((const GAS float*)(unsigned long long)(ws + OFF_GATES))[(size_t)(b * SEQ + tokm) * 48 + head * 3 + 1];
            const float sc = lr > 0.f ? gate / lr : 0.f;
            const size_t ro = (size_t)(b * SEQ + tokm) * 1024 + head * 64 + 4 * q;
            const GAS bf16_t* yc = (const GAS bf16_t*)(unsigned long long)(ws + OFF_SLOT64) + ro; const GAS bf16_t* yw = yc + (size_t)T_TOK * 1024;
            GAS unsigned char* mo = (GAS unsigned char*)(unsigned long long)(ws + OFF_MIXIN) + (size_t)(b * SEQ + tokm) * 2048 + 1024 + head * 64 + 4 * q;
            u32x2 cv[4], wv[4];
#pragma unroll
            for (int dg = 0; dg < 4; ++dg) { cv[dg] = *(const GAS u32x2*)(yc + 16 * dg); wv[dg] = *(const GAS u32x2*)(yw + 16 * dg); }
#pragma unroll
            for (int dg = 0; dg < 4; ++dg) {
                const u32x2 c = cv[dg], w = wv[dg];
                const float o0 = O[dg][0] * sc + bflo(c.x) + bflo(w.x), o1 = O[dg][1] * sc + bfhi(c.x) + bfhi(w.x), o2 = O[dg][2] * sc + bflo(c.y) + bflo(w.y), o3 = O[dg][3] * sc + bfhi(c.y) + bfhi(w.y);
                *(GAS unsigned*)(mo + 16 * dg) = pk4_fp8(o0 * MIX8_SCALE, o1 * MIX8_SCALE, o2 * MIX8_SCALE, o3 * MIX8_SCALE);
            }
        }
        asm volatile("" : "+v"(onn.q0), "+v"(onn.q1), "+v"(onn.l0), "+v"(onn.l1));
        have = chain; oc = on; on = onn;
    }
}
__device__ __forceinline__ float rl(float v, int l) { return __builtin_bit_cast(float, __builtin_amdgcn_readlane(__builtin_bit_cast(int, v), l)); }

__device__ __forceinline__ void route_token(const Params& p, unsigned char* ws, int t, float logit, float rb, int lane) {
    unsigned* cnt = (unsigned*)(ws + OFF_CTL);
    int* ltok = (int*)(ws + OFF_LTOK); float* lw = (float*)(ws + OFF_LW); int* lslot = (int*)(ws + OFF_LSLOT);
    const float affin = sigmoidf_(logit);
    const float biased = affin + rb;
    float m1 = biased; m1 = fmaxf(m1, __shfl_xor(m1, 1)); m1 = fmaxf(m1, __shfl_xor(m1, 2)); m1 = fmaxf(m1, __shfl_xor(m1, 4));
    const unsigned long long bal = __ballot(biased == m1);
    const unsigned grpbits = (unsigned)((bal >> (lane & ~7)) & 0xffull);
    const int first = (lane & ~7) + __builtin_ctz(grpbits);
    float m2 = (lane == first) ? -3e38f : biased; m2 = fmaxf(m2, __shfl_xor(m2, 1)); m2 = fmaxf(m2, __shfl_xor(m2, 2)); m2 = fmaxf(m2, __shfl_xor(m2, 4));
    const float gs = m1 + m2; const int myg = lane >> 3;
    int grank = 0;
#pragma unroll
    for (int gg = 0; gg < 8; ++gg) { const float og = rl(gs, 8 * gg); grank += (og > gs) | ((og == gs) & (gg < myg)); }
    const float mv = grank < 4 ? biased : -1e30f;
    int er = 0;
#pragma unroll
    for (int e2 = 0; e2 < 64; ++e2) { const float o = rl(mv, e2); er += (o > mv) | ((o == mv) & (e2 < lane)); }
    const bool sel = er < TOPK_E;
    const float wsum = wave_sum(sel ? affin : 0.f);
    if (sel) {
        const unsigned pos = atomicAdd(&cnt[lane], 1u);
        const size_t li = (size_t)lane * LISTCAP + pos;
        ltok[li] = t; lw[li] = affin / wsum * 2.5f; lslot[li] = t * NSLOT + er;
    }
    if (lane == 0) { const size_t li = (size_t)NEXP * LISTCAP + t; ltok[li] = t; lw[li] = 1.f; lslot[li] = t * NSLOT + TOPK_E; }
}

constexpr int RT_ROWB = 4096 + 16, RT_PART = 16 * RT_ROWB;
template <bool ROUTE>
__device__ __forceinline__ void ln1_route_phase(const Params& p, LAS unsigned char* lds, int vcu, int G) {
    const int tid = opqv(threadIdx.x), lane = tid & 63, wave = __builtin_amdgcn_readfirstlane(tid >> 6);
    unsigned char* ws = opqp(p.ws);
    const bf16_t* x1 = (const bf16_t*)(ws + OFF_X1);
    const float* g1 = INP(19); const float* b1 = INP(20);
    const float rb = INP(22)[lane];
    const bf16_t* WrT = (const bf16_t*)(ws + OFF_WRT);
    LAS float* part = (LAS float*)(lds + RT_PART);
    bf16x8 wfr[8][4];
    {
        const int fr = lane & 15, q = lane >> 4;
#pragma unroll
        for (int k8 = 0; k8 < 8; ++k8)
#pragma unroll
            for (int nb = 0; nb < 4; ++nb) wfr[k8][nb] = *(const bf16x8*)(WrT + (size_t)(16 * nb + fr) * DM + 256 * wave + 32 * k8 + 8 * q);
    }
    for (int tile = vcu; tile < T_TOK / 16; tile += G) {
        const int r0 = tile * 16;
#pragma unroll
        for (int rr = 0; rr < 2; ++rr) {
            const int rl_ = 2 * wave + rr; const size_t row = (size_t)(r0 + rl_);
            const u32x2* xr = (const u32x2*)(x1 + row * DM) + lane;
            f32x4 v[8]; float s = 0.f;
#pragma unroll
            for (int j = 0; j < 8; ++j) { const u32x2 w = xr[64 * j]; v[j] = (f32x4){bflo(w.x), bfhi(w.x), bflo(w.y), bfhi(w.y)}; s += (v[j].x + v[j].y) + (v[j].z + v[j].w); }
            const float mean = wave_sum(s) * (1.f / DM); float s2 = 0.f;
#pragma unroll
            for (int j = 0; j < 8; ++j) { v[j] = v[j] - mean; s2 += (v[j].x * v[j].x + v[j].y * v[j].y) + (v[j].z * v[j].z + v[j].w * v[j].w); }
            const float rstd = 1.f / sqrtf(wave_sum(s2) * (1.f / DM) + LN_EPS);
            const f32x4* gr = (const f32x4*)g1 + lane; const f32x4* br = (const f32x4*)b1 + lane;
            u32x2* o = (u32x2*)((bf16_t*)(ws + OFF_X1B) + row * DM) + lane; unsigned* oq = (unsigned*)(ws + OFF_X1Q + row * DM) + lane;
#pragma unroll
            for (int j = 0; j < 8; ++j) {
                const f32x4 r = v[j] * rstd * gr[64 * j] + br[64 * j]; const u32x2 rb2 = (u32x2){pk2(r.x, r.y), pk2(r.z, r.w)};
                o[64 * j] = rb2; oq[64 * j] = pk4_fp8(r.x, r.y, r.z, r.w);
                *(LAS u32x2*)(lds + rl_ * RT_ROWB + (64 * j + lane) * 8) = rb2;
            }
        }
        __syncthreads();
        {
            const int fr = lane & 15, q = lane >> 4;
            f32x4 acc[4] = {(f32x4){0.f, 0.f, 0.f, 0.f}, (f32x4){0.f, 0.f, 0.f, 0.f}, (f32x4){0.f, 0.f, 0.f, 0.f}, (f32x4){0.f, 0.f, 0.f, 0.f}};
#pragma unroll
            for (int k8 = 0; k8 < 8; ++k8) {
                const int k0 = 256 * wave + 32 * k8 + 8 * q;
                const bf16x8 a = *(const LAS bf16x8*)(lds + fr * RT_ROWB + k0 * 2);
#pragma unroll
                for (int nb = 0; nb < 4; ++nb) acc[nb] = __builtin_amdgcn_mfma_f32_16x16x32_bf16(a, wfr[k8][nb], acc[nb], 0, 0, 0);
            }
#pragma unroll
            for (int nb = 0; nb < 4; ++nb)
#pragma unroll
                for (int r = 0; r < 4; ++r) part[(wave * 16 + 4 * q + r) * 64 + 16 * nb + fr] = acc[nb][r];
        }
        __syncthreads();
#pragma unroll 1
        for (int rr = 0; rr < 2; ++rr) {
            const int rl_ = 2 * wave + rr;
            float lg = 0.f;
#pragma unroll
            for (int w = 0; w < 8; ++w) lg += part[(w * 16 + rl_) * 64 + lane];
            if (ROUTE) route_token(p, ws, r0 + rl_, lg, rb, lane); else asm volatile("" :: "v"(lg));
        }
        __syncthreads();
    }
}

constexpr int MOE_LDS = 131072;
__device__ __forceinline__ void moe_tables(const Params& p, LAS unsigned char* lds) {
    const int tid = opqv(threadIdx.x);
    LAS int* tstart = (LAS int*)(lds + MOE_LDS); LAS int* roff = (LAS int*)(lds + MOE_LDS + 272); LAS int* cn = (LAS int*)(lds + MOE_LDS + 544);
    if (tid < 64) {
        const int c = (int)__hip_atomic_load((unsigned*)(opqp(p.ws) + OFF_CTL) + tid, __ATOMIC_RELAXED, __HIP_MEMORY_SCOPE_AGENT);
        const int tl = (c + 255) >> 8;
        int st = tl, sr = c;
#pragma unroll
        for (int o = 1; o < 64; o <<= 1) { const int a = __shfl_up(st, o), b = __shfl_up(sr, o); if (tid >= o) { st += a; sr += b; } }
        cn[tid] = c; tstart[tid + 1] = st; roff[tid + 1] = sr;
        if (tid == 0) { tstart[0] = 0; roff[0] = 0; }
        if (tid == 63) { cn[64] = T_TOK; tstart[65] = st + T_TOK / 256; roff[65] = sr + T_TOK; }
    }
    __syncthreads();
}
__device__ __forceinline__ void MoeOrder_prefetch_impl(const int* ltok, const Unit& u, int parity, LAS unsigned char* lds);
__device__ __forceinline__ void MoeOrder_prefetch_sw(const int* lslot, const float* lw, const Unit& u, int parity, LAS unsigned char* lds);
constexpr int MOE_SW = MOE_LDS + 4096;
struct MoeOrder {
    LAS const int* tstart; LAS const int* roff; LAS const int* cn;
    int NT, nunits, G, c, K; const char* Bt; size_t bstride; const int* ltok; bool gather; const int* lslot = nullptr; const float* lw = nullptr;
    __device__ void init(LAS unsigned char* lds, int NT_, int K_, const void* Bt_, size_t bstride_, const int* ltok_, bool gather_, int G_, int c_) {
        tstart = (LAS const int*)(lds + MOE_LDS); roff = (LAS const int*)(lds + MOE_LDS + 272); cn = (LAS const int*)(lds + MOE_LDS + 544);
        NT = NT_; K = K_; Bt = (const char*)Bt_; bstride = bstride_; ltok = ltok_; gather = gather_; G = G_; c = c_; nunits = __builtin_amdgcn_readfirstlane(tstart[NEXPS] * NT_);
    }
    __device__ __forceinline__ bool next(int i, Unit& u) const {
        const int L = i * G + c; if (L >= nunits) return false;
        const int ti = L / NT, nt = L - ti * NT;
        int e = 0;
        if (ti >= tstart[NEXP]) e = NEXP;
        else {
#pragma unroll
            for (int s = 32; s >= 1; s >>= 1) { if (tstart[e + s] <= ti) e += s; }
        }
        e = __builtin_amdgcn_readfirstlane(e);
        const int mt = __builtin_amdgcn_readfirstlane(ti - tstart[e]);
        u.par = i % 3; u.e = e; u.pm = mt; u.pn = nt; u.nvalid = __builtin_amdgcn_readfirstlane(cn[e] - mt * 256); u.rowbase = __builtin_amdgcn_readfirstlane(roff[e] + mt * 256); u.bB = Bt + (size_t)e * bstride + (size_t)nt * 256 * K * 2; return true;
    }
    __device__ __forceinline__ void prefetch(const Unit& u, int parity, LAS unsigned char* lds) const { if (gather) MoeOrder_prefetch_impl(ltok, u, parity, lds); else if (lslot) MoeOrder_prefetch_sw(lslot, lw, u, u.par, lds); }
    __device__ __forceinline__ unsigned a_off_tab(const Unit& u, int h, int R, int C, int parity, LAS unsigned char* lds) const {
        if (!gather) return (unsigned)(((u.rowbase + h * 128 + R) * K + C) * 2);
        const int idx = *(const LAS int*)(lds + MOE_LDS + 1024 + parity * 1024 + (h * 128 + R) * 4); return (unsigned)((idx * K + C) * 2);
    }
    __device__ __forceinline__ unsigned a_off(const Unit& u, int h, int R, int C) const {
        const int r = h * 128 + R;
        if (gather) { const int tok = r < u.nvalid ? ltok[(size_t)u.e * LISTCAP + u.pm * 256 + r] : 0; return (unsigned)((tok * K + C) * 2); }
        return (unsigned)(((u.rowbase + r) * K + C) * 2);
    }
};
__device__ __forceinline__ void MoeOrder_prefetch_impl(const int* ltok, const Unit& u, int parity, LAS unsigned char* lds) {
    const int tid = threadIdx.x, wave = __builtin_amdgcn_readfirstlane(tid >> 6);
    if (wave < 4) {
        const int r = tid < u.nvalid ? tid : u.nvalid - 1;
        __builtin_amdgcn_global_load_lds((const unsigned*)(ltok + (size_t)u.e * LISTCAP + u.pm * 256 + r), (LAS unsigned*)(lds + MOE_LDS + 1024 + parity * 1024 + wave * 256), 4, 0, 0);
    }
}
__device__ __forceinline__ void MoeOrder_prefetch_sw(const int* lslot, const float* lw, const Unit& u, int parity, LAS unsigned char* lds) {
    const int tid = threadIdx.x, wave = __builtin_amdgcn_readfirstlane(tid >> 6), t = tid & 255;
    const int r = t < u.nvalid ? t : u.nvalid - 1;
    const size_t li = (size_t)u.e * LISTCAP + u.pm * 256 + r;
    const unsigned* src = wave < 4 ? (const unsigned*)(lslot + li) : (const unsigned*)(lw + li);
    __builtin_amdgcn_global_load_lds(src, (LAS unsigned*)(lds + MOE_SW + parity * 2048 + wave * 256), 4, 0, 0);
}
__device__ __forceinline__ float silu_mul(float g, float u) { return g * u * __builtin_amdgcn_rcpf(1.f + __expf(-g)); }
template <bool SHARED> struct EpiUp {
    static constexpr int PERM = 1; static constexpr bool AFTER_DRAIN = false;
    bf16_t* H; float* logits;
    __device__ __forceinline__ void operator()(const f32x4 (&acc)[2][2][4][2], const Unit& u, int wr, int wc, int fr, int fq) const {
        const int rbase = SHARED ? u.pm * 256 : u.rowbase;
        if (SHARED && u.pn == 4) {
            if (wc < 2) {
#pragma unroll
                for (int ai = 0; ai < 2; ++ai)
#pragma unroll
                    for (int m = 0; m < 4; ++m) { float* lp = logits + (size_t)(rbase + 128 * ai + 64 * wr + 16 * m + fr) * 64 + 32 * wc + 8 * fq;
                        *(f32x4*)lp = acc[ai][0][m][0]; *(f32x4*)(lp + 4) = acc[ai][0][m][1]; }
            }
            return;
        }
#pragma unroll
        for (int ai = 0; ai < 2; ++ai)
#pragma unroll
            for (int m = 0; m < 4; ++m) {
                const int r = 128 * ai + 64 * wr + 16 * m + fr;
                if (!SHARED) {
                    if (r < u.nvalid) {
                        constexpr float IS = 1.f / W8_SCALE;
                        const f32x4 g0 = acc[ai][0][m][0] * IS, g1 = acc[ai][0][m][1] * IS, u0 = acc[ai][1][m][0] * (IS * H8_SCALE), u1 = acc[ai][1][m][1] * (IS * H8_SCALE);
                        u32x2 w; w.x = pk4_fp8(silu_mul(g0[0], u0[0]), silu_mul(g0[1], u0[1]), silu_mul(g0[2], u0[2]), silu_mul(g0[3], u0[3]));
                        w.y = pk4_fp8(silu_mul(g1[0], u1[0]), silu_mul(g1[1], u1[1]), silu_mul(g1[2], u1[2]), silu_mul(g1[3], u1[3]));
                        *(u32x2*)((unsigned char*)H + (size_t)(rbase + r) * EFF + 128 * u.pn + 32 * wc + 8 * fq) = w;
                    }
                } else {
                    const f32x4 g0 = acc[ai][0][m][0], g1 = acc[ai][0][m][1], u0 = acc[ai][1][m][0], u1 = acc[ai][1][m][1];
                    u32x4 w; w.x = cvt_pk_bf16(silu_mul(g0[0], u0[0]), silu_mul(g0[1], u0[1])); w.y = cvt_pk_bf16(silu_mul(g0[2], u0[2]), silu_mul(g0[3], u0[3]));
                    w.z = cvt_pk_bf16(silu_mul(g1[0], u1[0]), silu_mul(g1[1], u1[1])); w.w = cvt_pk_bf16(silu_mul(g1[2], u1[2]), silu_mul(g1[3], u1[3]));
                    *(u32x4*)(H + (size_t)(rbase + r) * EFF + 128 * u.pn + 32 * wc + 8 * fq) = w;
                }
            }
    }
};
struct EpiMoeDown {
    static constexpr int PERM = 2; static constexpr bool AFTER_DRAIN = false;
    unsigned char* Y; LAS unsigned char* lds;
    __device__ __forceinline__ void operator()(const f32x4 (&acc)[2][2][4][2], const Unit& u, int wr, int wc, int fr, int fq) const {
        const int col0 = u.pn * 256 + wc * 64 + 16 * fq;
        const LAS int* st = (const LAS int*)(lds + MOE_SW + u.par * 2048) + 64 * wr + fr; const LAS float* wt = (const LAS float*)(st + 256);
        int slot[8]; float w[8];
#pragma unroll
        for (int i = 0; i < 8; ++i) { const int r = 128 * (i >> 2) + 16 * (i & 3); const bool ok = (r + 64 * wr + fr) < u.nvalid; slot[i] = ok ? st[r] : -1; w[i] = ok ? wt[r] * (SLOT_SCALE / (W8_SCALE * H8_SCALE)) : 0.f; }
#pragma unroll
        for (int ai = 0; ai < 2; ++ai)
#pragma unroll
            for (int m = 0; m < 4; ++m) {
                const int i = ai * 4 + m;
                if (slot[i] >= 0) {
                    const f32x4 a0 = acc[ai][0][m][0] * w[i], a1 = acc[ai][0][m][1] * w[i], b0 = acc[ai][1][m][0] * w[i], b1 = acc[ai][1][m][1] * w[i];
                    u32x4 o; o.x = pk4_fp8(a0[0], a0[1], a0[2], a0[3]); o.y = pk4_fp8(a1[0], a1[1], a1[2], a1[3]); o.z = pk4_fp8(b0[0], b0[1], b0[2], b0[3]); o.w = pk4_fp8(b1[0], b1[1], b1[2], b1[3]);
                    __builtin_nontemporal_store(o, (u32x4*)(Y + (size_t)slot[i] * DM + col0));
                }
            }
    }
};
struct EpiNull {
    static constexpr int PERM = 1; static constexpr bool AFTER_DRAIN = false;
    __device__ __forceinline__ void operator()(const f32x4 (&acc)[2][2][4][2], const Unit&, int, int, int, int) const {
#pragma unroll
        for (int ai = 0; ai < 2; ++ai)
#pragma unroll
            for (int bj = 0; bj < 2; ++bj)
#pragma unroll
                for (int mm = 0; mm < 4; ++mm)
#pragma unroll
                    for (int n = 0; n < 2; ++n) asm volatile("" :: "v"(acc[ai][bj][mm][n]));
    }
};
constexpr int XC_ALL = NEXPS * 3 * 256, XC0 = 0, XC1 = XC_ALL / 4, XC2 = XC1 + (XC_ALL * 35) / 100, XC3 = XC2 + XC_ALL / 4, XC4 = XC_ALL;
#ifndef PROBE_PH
#define PROBE_PH (-1)
#endif
__global__ void __launch_bounds__(NTHREADS, 2) mega_fwd(Params p) {
    extern __shared__ __attribute__((aligned(16))) unsigned char lds_raw[];
    LAS unsigned char* lds = (LAS unsigned char*)lds_raw;
    cg::grid_group grid = cg::this_grid();
    const int G = gridDim.x, bx = blockIdx.x;
    volatile LAS unsigned* bst = (volatile LAS unsigned*)(lds + LDS_BYTES - 16);
    if (threadIdx.x < 4) bst[threadIdx.x] = 0u;
    __syncthreads();
    const XcdBarrier xbar = xcd_barrier_post((unsigned*)(opqp(p.ws) + OFF_CTL) + 4096, bst);
#define GRID_BAR() xcd_barrier(xbar)
    const int vcu = (G % 8 == 0) ? (bx % 8) * (G / 8) + bx / 8 : bx;
    const int NGW = G * NWAVES;
    unsigned char* ws = opqp(p.ws);

    for (int rep = 0; rep < (PROBE_PH == 0 ? 2 : 1); ++rep) {
    p0_prep(p, lds, vcu, G);
    if (PROBE_PH == 100) { __syncthreads(); p0_prep(p, lds, vcu, G); }
    asm volatile("s_waitcnt vmcnt(0)" ::: "memory");
    grid.sync();
    }
    for (int rep = 0; rep < (PROBE_PH == 1 ? 2 : 1); ++rep)
    {
        pg8::Gemm g{(const char*)(ws + OFF_X8)}; constexpr int K_g = DM / 2, KS_g = 128; pg8::DenseOrder S; S.init(T_TOK, PROJ_LD, DM / 2, ws + OFF_WINT, G, bx);
        EpiStoreBf16 E{(bf16_t*)(ws + OFF_PROJ), PROJ_LD, 1.f / W8_SCALE};
        if ((vcu & 1) && rep == 0) { expert_convert(p, lds, vcu, G, XC0, XC1 - XC0); __syncthreads(); }
        pg8::gemm_phase<K_g, KS_g, true>(lds, g, S, E);
        if (!(vcu & 1) && rep == 0) { __syncthreads(); expert_convert(p, lds, vcu, G, XC0, XC1 - XC0); }
        GRID_BAR();
    }
    for (int rep = 0; rep < (PROBE_PH == 2 ? 2 : 1); ++rep) {
    nsa_rope_layout(p, lds, vcu, G);
    if (PROBE_PH == 20) nsa_rope_layout(p, lds, vcu, G);
    __syncthreads();
    nsa_vtranspose(p, lds, vcu, G);
    __syncthreads();
    s5_pass<false>(p, lds, vcu, G);
    if (PROBE_PH == 22) s5_pass<false>(p, lds, vcu, G);
    __syncthreads();
    nsa_compress(p, lds, vcu, G);
    if (PROBE_PH == 23) nsa_compress(p, lds, vcu, G);
    GRID_BAR();
    }
    for (int rep = 0; rep < (PROBE_PH == 4 ? 2 : 1); ++rep) {
    if ((vcu & 1) && rep == 0) { expert_convert(p, lds, vcu, G, XC1, XC2 - XC1); __syncthreads(); }
    s5_pass<true>(p, lds, vcu, G);
    if (PROBE_PH == 40) s5_pass<true>(p, lds, vcu, G);
    for (int r1 = 0; r1 < (PROBE_PH == 41 ? 2 : 1); ++r1) {
        if (G == 256) {
            const int bk = vcu >> 6, w6 = vcu & 63;
            __syncthreads();
            nsa_cmp_stage(p, lds, bk);
            __syncthreads();
#pragma unroll 1
            for (int k = 0; k < 8; ++k) nsa_cmp_unit(p, lds, bk, 64 * k + ((k & 1) ? 63 - w6 : w6));
        } else {
            for (int bk = 0; bk < 4; ++bk) {
                __syncthreads();
                nsa_cmp_stage(p, lds, bk);
                __syncthreads();
                for (int qt = vcu; qt < 512; qt += G) nsa_cmp_unit(p, lds, bk, qt);
            }
        }
    }
    for (int r2 = 0; r2 < (PROBE_PH == 42 ? 2 : 1); ++r2)
    for (int k = 0; k < 2; ++k) { const int u = k ? 511 - vcu : vcu; if (G == 256 || k == 0) for (int uu = u; uu < 512; uu += (G == 256 ? 512 : G)) nsa_win_unit(p, lds, uu >> 7, uu & 127); }
    if (!(vcu & 1) && rep == 0) { __syncthreads(); expert_convert(p, lds, vcu, G, XC1, XC2 - XC1); }
    GRID_BAR();
    }
    for (int rep = 0; rep < (PROBE_PH == 5 ? 2 : 1); ++rep) {
    if ((vcu & 1) && rep == 0) { expert_convert(p, lds, vcu, G, XC2, XC3 - XC2); __syncthreads(); }
    {
        pg8::Gemm g{(const char*)(ws + OFF_YGELU)}; constexpr int K_g = 1024, KS_g = 128; pg8::DenseOrder S; S.init(T_TOK, 1024, 1024, ws + OFF_WGLUT, G, bx);
        EpiGlu E{(const bf16_t*)(ws + OFF_YGELU), (unsigned char*)(ws + OFF_MIXIN)};
        pg8::gemm_phase<K_g, KS_g>(lds, g, S, E);
    }
    nsa_sel_phase(p, lds, vcu, G);
    if (PROBE_PH == 51) nsa_sel_phase(p, lds, vcu, G);
    if (!(vcu & 1) && rep == 0) { __syncthreads(); expert_convert(p, lds, vcu, G, XC2, XC3 - XC2); }
    GRID_BAR();
    }
    {
        pg8::Gemm g{(const char*)(ws + OFF_MIXIN)}; constexpr int K_g = DM / 2, KS_g = 128; pg8::DenseOrder S; S.init(T_TOK, DM, DM / 2, ws + OFF_WOUTT, G, bx);
        EpiResBf16 E{(const bf16_t*)(ws + OFF_XB), (bf16_t*)(ws + OFF_X1)};
        if (vcu & 1) { expert_convert(p, lds, vcu, G, XC3, XC4 - XC3); __syncthreads(); }
        pg8::gemm_phase<K_g, KS_g, true>(lds, g, S, E);
        if (!(vcu & 1)) { __syncthreads(); expert_convert(p, lds, vcu, G, XC3, XC4 - XC3); }
        if (PROBE_PH == 6) { GRID_BAR(); pg8::gemm_phase<K_g, KS_g, true>(lds, g, S, E); }
    }
    GRID_BAR();
    if (PROBE_PH == 7) { ln1_route_phase<false>(p, lds, vcu, G); GRID_BAR(); }
    ln1_route_phase<true>(p, lds, vcu, G);
    GRID_BAR();
    for (int rep = 0; rep < (PROBE_PH == 11 ? 2 : 1); ++rep) {
    {
        moe_tables(p, lds);
        pg8::Gemm g{(const char*)(ws + OFF_X1Q)}; constexpr int K_g = DM / 2, KS_g = 128; MoeOrder S; S.init(lds, 4, DM / 2, ws + OFF_WEUPT, (size_t)1024 * DM, (const int*)(ws + OFF_LTOK), true, G, bx);
        EpiUp<false> E{(bf16_t*)(ws + OFF_H), nullptr};
        pg8::gemm_phase<K_g, KS_g, true>(lds, g, S, E);
        if (PROBE_PH == 112) { EpiNull EN; pg8::gemm_phase<K_g, KS_g, true>(lds, g, S, EN); }
    }
    GRID_BAR();
    }
    for (int rep = 0; rep < (PROBE_PH == 12 ? 2 : 1); ++rep) {
    {
        pg8::Gemm g{(const char*)(ws + OFF_H)}; constexpr int K_g = EFF / 2, KS_g = 128; MoeOrder S; S.init(lds, 8, EFF / 2, ws + OFF_WEDT, (size_t)DM * EFF, nullptr, false, G, bx);
        S.lslot = (const int*)(ws + OFF_LSLOT); S.lw = (const float*)(ws + OFF_LW);
        EpiMoeDown E{(unsigned char*)(ws + OFF_YSLOT), lds};
        pg8::gemm_phase<K_g, KS_g, true>(lds, g, S, E);
        if (PROBE_PH == 120) pg8::gemm_phase<K_g, KS_g, true>(lds, g, S, E);
        if (PROBE_PH == 122) { EpiNull EN; pg8::gemm_phase<K_g, KS_g, true>(lds, g, S, EN); }
    }
    GRID_BAR();
    }
    const int tid = opqv(threadIdx.x), lane = tid & 63, gw = vcu * NWAVES + (tid >> 6);
    f32x4 g2v[8], b2v[8];
#pragma unroll
    for (int j = 0; j < 8; ++j) { g2v[j] = ((const f32x4*)INP(29))[lane + 64 * j]; b2v[j] = ((const f32x4*)INP(30))[lane + 64 * j]; }
    for (int rep = 0; rep < (PROBE_PH == 14 ? 2 : 1); ++rep)
    for (int m = gw; m < T_TOK; m += NGW) ln_row<NSLOT>((const bf16_t*)(ws + OFF_X1B) + (size_t)m * DM, ALPHA, (const unsigned char*)(ws + OFF_YSLOT) + (size_t)m * NSLOT * DM, g2v, b2v, p.out + (size_t)m * DM, nullptr, nullptr, lane);
}
extern "C" void kernel_launch(void* const* d_in, const int* in_sizes, int n_in, void* d_out, int out_size, void* d_ws, size_t ws_size, hipStream_t stream) {
    static int grid = 0;
    if (grid == 0) {
        int dev = 0, cus = 0, per_cu = 0;
        (void)hipGetDevice(&dev);
        (void)hipDeviceGetAttribute(&cus, hipDeviceAttributeMultiprocessorCount, dev);
        (void)hipFuncSetAttribute((const void*)mega_fwd, hipFuncAttributeMaxDynamicSharedMemorySize, LDS_BYTES);
        (void)hipOccupancyMaxActiveBlocksPerMultiprocessor(&per_cu, (const void*)mega_fwd, NTHREADS, LDS_BYTES);
        if (per_cu < 1) { fprintf(stderr, "kernel_launch: occupancy query says %d blocks/CU\n", per_cu); }
        grid = cus;
        if (n_in != 31 || ws_size < WS_NEED) { fprintf(stderr, "kernel_launch: n_in %d ws %zu (need %zu): nothing launched\n", n_in, ws_size, (size_t)WS_NEED); grid = -1; }
    }
    if (grid < 0) return;
    if (hipMemsetAsync(d_ws, 0, 65536, stream) != hipSuccess) { fprintf(stderr, "kernel_launch: memset failed\n"); return; }
    Params p{};
    for (int i = 0; i < 31; ++i) p.in[i] = (const float*)d_in[i];
    p.out = (float*)d_out; p.ws = (unsigned char*)d_ws; p.ws_size = ws_size;
    void* args[] = {&p};
    hipError_t e = hipLaunchCooperativeKernel((const void*)mega_fwd, dim3(grid), dim3(NTHREADS), args, LDS_BYTES, stream);
    if (e != hipSuccess) fprintf(stderr, "kernel_launch: cooperative launch failed: %s (grid %d)\n", hipGetErrorString(e), grid);
}
```

```cpp
#include <hip/hip_runtime.h>
#include <hip/hip_cooperative_groups.h>
#include <cstdio>
#include <cstdint>
namespace cg = cooperative_groups;

#define LAS __attribute__((address_space(3)))
#define GAS __attribute__((address_space(1)))
typedef unsigned short bf16_t;
typedef short bf16x8 __attribute__((ext_vector_type(8)));
typedef float f32x4 __attribute__((ext_vector_type(4)));
typedef float f32x2 __attribute__((ext_vector_type(2)));
typedef unsigned u32x4 __attribute__((ext_vector_type(4)));
typedef unsigned u32x2 __attribute__((ext_vector_type(2)));

constexpr int NTHREADS = 512, NWAVES = 8;
constexpr int NB = 2, SEQ = 8192, T_TOK = NB * SEQ, DM = 2048;
constexpr int IN_COLS = 2864, PROJ_LD = 3072;
constexpr int SSM_W = 1024, NGRP = 64, NSTATE = 64;
constexpr int NHEAD = 16, NKVH = 2, HD = 64;
constexpr int COL_Q = 1024, COL_KC = 2048, COL_VC = 2176, COL_KS = 2304, COL_VS = 2432, COL_KW = 2560, COL_VW = 2688, COL_G = 2816;
constexpr int NCMP = 511, NSEL = 128, TOPK_SEL = 16, WINDOW = 512;
constexpr int NEXP = 64, TOPK_E = 8, EFF = 512, LISTCAP = T_TOK;
constexpr int NEXPS = NEXP + 1, NSLOT = TOPK_E + 1;
constexpr float ALPHA = 1.189207115002721f;
constexpr float LN_EPS = 1e-5f;
constexpr int S5_SEG = 256, S5_NSEG = SEQ / S5_SEG;

constexpr size_t MiB = 1ull << 20;
constexpr size_t OFF_CTL = 0;
constexpr size_t OFF_S5A = 1 * MiB;
constexpr size_t OFF_S5AC = OFF_S5A + 64 * 1024;
constexpr size_t OFF_S5BB = OFF_S5AC + 64 * 1024;
constexpr size_t OFF_S5CF = 2 * MiB;
constexpr size_t OFF_CBIAS = OFF_S5CF + 256 * 1024;
constexpr size_t OFF_WRT = 2 * MiB + 512 * 1024;
constexpr size_t OFF_KC = 3 * MiB;
constexpr size_t OFF_VCT = OFF_KC + 256 * 1024;
constexpr size_t OFF_SEL = 4 * MiB;
constexpr size_t OFF_E = 6 * MiB;
constexpr size_t OFF_LOGITS = 14 * MiB;
constexpr size_t OFF_LTOK = 14 * MiB;
constexpr size_t OFF_LW = 19 * MiB;
constexpr size_t OFF_LSLOT = 24 * MiB;
constexpr size_t OFF_LROW = 6 * MiB;
constexpr size_t OFF_WEDT = 30 * MiB;
constexpr size_t OFF_WSDT = 158 * MiB;
constexpr size_t OFF_X1 = 160 * MiB;
constexpr size_t OFF_X1B = 95 * MiB;
constexpr size_t OFF_HS = 288 * MiB;
constexpr size_t OFF_H = 304 * MiB;
constexpr size_t OFF_X1Q = 400 * MiB;
constexpr size_t OFF_YGELU = 304 * MiB;
constexpr size_t OFF_MIXIN = 336 * MiB;
constexpr size_t OFF_YSLOT = 433 * MiB;
constexpr size_t OFF_WEUPT = 433 * MiB;
constexpr size_t OFF_WINT = 689 * MiB;
constexpr size_t OFF_WGLUT = 701 * MiB;
constexpr size_t OFF_WOUTT = 703 * MiB;
constexpr size_t OFF_WSUPT = 711 * MiB;
constexpr size_t OFF_WC1T = 716 * MiB;
constexpr size_t OFF_SLOT64 = 717 * MiB;
constexpr size_t OFF_PROJ = 781 * MiB;
constexpr size_t OFF_QR = 877 * MiB;
constexpr size_t OFF_KSEL = 909 * MiB;
constexpr size_t OFF_VSELT = 913 * MiB;
constexpr size_t OFF_KWIN = 917 * MiB;
constexpr size_t OFF_VWINT = 921 * MiB;
constexpr size_t OFF_GATES = 925 * MiB;
constexpr size_t OFF_Q8 = 928 * MiB;
constexpr size_t OFF_X8 = 877 * MiB;
constexpr size_t WS_NEED = 1009 * MiB;

constexpr int LDS_BYTES = 163840;

struct Params {
    const float* in[31];
    float* out;
    unsigned char* ws;
    size_t ws_size;
};

__device__ __forceinline__ int opq(int i) { asm volatile("" : "+s"(i)); return i; }
__device__ __forceinline__ unsigned char* opqp(unsigned char* q) { unsigned long long v = (unsigned long long)q; asm volatile("" : "+s"(v)); return (unsigned char*)(GAS unsigned char*)v; }
__device__ __forceinline__ int opqv(int v) { asm volatile("" : "+v"(v)); return v; }
__device__ __forceinline__ unsigned char* opqf(unsigned char* q) { unsigned long long v = (unsigned long long)q; asm volatile("" : "+s"(v)); return (unsigned char*)v; }
#define INP(i) (p.in[opq(i)])
__device__ __forceinline__ unsigned f2bf(float f) { unsigned u = __builtin_bit_cast(unsigned, f); return (u + 0x7fffu + ((u >> 16) & 1u)) >> 16; }
typedef __bf16 bf16x2_t __attribute__((ext_vector_type(2)));
__device__ __forceinline__ unsigned cvt_pk_bf16(float lo, float hi) { const f32x2 v = {lo, hi}; const bf16x2_t b = __builtin_convertvector(v, bf16x2_t); return __builtin_bit_cast(unsigned, b); }
__device__ __forceinline__ unsigned pk2(float lo, float hi) { return cvt_pk_bf16(lo, hi); }
__device__ __forceinline__ float bf2f(unsigned b) { return __builtin_bit_cast(float, b << 16); }
__device__ __forceinline__ float bflo(unsigned w) { return __builtin_bit_cast(float, w << 16); }
__device__ __forceinline__ float bfhi(unsigned w) { return __builtin_bit_cast(float, w & 0xffff0000u); }
__device__ __forceinline__ void swap16(float& a, float& b) { asm volatile("s_nop 1\n\tv_permlane16_swap_b32 %0, %1" : "+v"(a), "+v"(b)); }
__device__ __forceinline__ void swap32(float& a, float& b) { asm volatile("s_nop 1\n\tv_permlane32_swap_b32 %0, %1" : "+v"(a), "+v"(b)); }
__device__ __forceinline__ float wave_sum(float v) {
#pragma unroll
    for (int o = 1; o < 64; o <<= 1) v += __shfl_xor(v, o);
    return v;
}
__device__ __forceinline__ float gelu_tanh(float x) {
    const float z = 0.7978845608028654f * (x + 0.044715f * x * x * x);
    const float e = __expf(2.f * z);
    const float th = 1.f - 2.f * __builtin_amdgcn_rcpf(e + 1.f);
    return 0.5f * x * (1.f + th);
}
__device__ __forceinline__ unsigned pk4_fp8(float a, float b, float c2, float d) { unsigned w = 0; w = __builtin_amdgcn_cvt_pk_fp8_f32(a, b, w, false); w = __builtin_amdgcn_cvt_pk_fp8_f32(c2, d, w, true); return w; }
constexpr float W8_SCALE = 256.f, H8_SCALE = 8.f, SLOT_SCALE = 64.f, MIX8_SCALE = 8.f;
__device__ __forceinline__ float sigmoidf_(float x) { return __builtin_amdgcn_rcpf(1.f + __expf(-x)); }
#define LDS_WAIT() asm volatile("s_waitcnt lgkmcnt(0)" ::: "memory")
#define GAS __attribute__((address_space(1)))
#define XB_TMO      128
#define XB_XCNT(j)  (256  + 64 * (j))
#define XB_XSUB(j)  (1280 + 64 * (j))
#define XB_XGEN(j)  (2304 + 64 * (j))
#define XB_TOP      3328
#define XB_TOPGEN   3392
#define XCD_BAR_WORDS 3456
#define XB_SPIN_CAP (1u << 18)

__device__ __forceinline__ unsigned xb_ld(unsigned* p)              { return __hip_atomic_load(p, __ATOMIC_RELAXED, __HIP_MEMORY_SCOPE_AGENT); }
__device__ __forceinline__ unsigned xb_add(unsigned* p, unsigned v) { return __hip_atomic_fetch_add(p, v, __ATOMIC_RELAXED, __HIP_MEMORY_SCOPE_AGENT); }
__device__ __forceinline__ unsigned xb_xcc_id() { return (unsigned)__builtin_amdgcn_s_getreg((3 << 11) | 20) & 0xFu; }
#define XB_SPIN(cond, bar) do { unsigned _sp = 0; while (cond) { __builtin_amdgcn_s_sleep(1); \
    if ((++_sp & 255u) == 0u) { if (xb_ld(&(bar)[XB_TMO])) break; if (_sp > XB_SPIN_CAP) { atomicAdd(&(bar)[XB_TMO], 1u); break; } } } } while (0)

struct XcdBarrier {
    unsigned* bar; unsigned x;
    volatile LAS unsigned* st;
};

__device__ __forceinline__ XcdBarrier xcd_barrier_post(unsigned* bar, volatile LAS unsigned* st) {
    XcdBarrier b; b.bar = bar; b.x = xb_xcc_id(); b.st = st;
    if (threadIdx.x == 0) (void)xb_add(&bar[XB_XCNT(b.x)], 1u);
    return b;
}
__device__ __forceinline__ void xcd_barrier_complete(unsigned* bar, unsigned x, unsigned& nloc, unsigned& nx) {
    const unsigned G = gridDim.x * gridDim.y * gridDim.z;
    unsigned sum, cnt, mine, sp = 0u;
    for (;;) {
        sum = 0u; cnt = 0u; mine = 0u;
#pragma unroll
        for (unsigned j = 0; j < 16; ++j) { const unsigned c = xb_ld(&bar[XB_XCNT(j)]); sum += c; cnt += (c > 0u) ? 1u : 0u; mine = (j == x) ? c : mine; }
        if (sum == G) break;
        __builtin_amdgcn_s_sleep(1);
        if ((++sp & 255u) == 0u) { if (xb_ld(&bar[XB_TMO])) break; if (sp > XB_SPIN_CAP) { atomicAdd(&bar[XB_TMO], 1u); break; } }
    }
    nloc = mine > 0u ? mine : 1u; nx = cnt > 0u ? cnt : 1u;
}

__device__ __forceinline__ void xcd_barrier(const XcdBarrier& b) {
    asm volatile("s_waitcnt vmcnt(0)" ::: "memory");
    __syncthreads();
    if (threadIdx.x == 0) {
        unsigned* bar = b.bar;
        __builtin_amdgcn_s_waitcnt(0);
        unsigned nloc = b.st[0], nx = b.st[1];
        if (nloc == 0u) { xcd_barrier_complete(bar, b.x, nloc, nx); b.st[0] = nloc; b.st[1] = nx; }
        const unsigned old = xb_add(&bar[XB_XSUB(b.x)], 1u);
        const unsigned gen = old / nloc;
        if (old + 1u == (gen + 1u) * nloc) {
            __builtin_amdgcn_fence(__ATOMIC_RELEASE, "agent");
            asm volatile("s_waitcnt vmcnt(0)" ::: "memory");
            const unsigned og = xb_add(&bar[XB_TOP], 1u);
            const unsigned tg = og / nx;
            if (og + 1u == (tg + 1u) * nx) xb_add(&bar[XB_TOPGEN], 1u);
            else XB_SPIN(xb_ld(&bar[XB_TOPGEN]) == tg, bar);
            __builtin_amdgcn_fence(__ATOMIC_ACQUIRE, "agent");
            xb_add(&bar[XB_XGEN(b.x)], 1u);
            asm volatile("s_waitcnt vmcnt(0)" ::: "memory");
        } else {
            XB_SPIN(xb_ld(&bar[XB_XGEN(b.x)]) == gen, bar);
            __builtin_amdgcn_fence(__ATOMIC_ACQUIRE, "agent");
            asm volatile("s_waitcnt vmcnt(0)" ::: "memory");
        }
    }
    __syncthreads();
}

namespace pg8 {
#define PG8_LAS __attribute__((address_space(3)))
constexpr int BM = 256, BK = 64, HALF = 128, HTB = HALF * BK * 2  , STAGE_BYTES = 8 * HTB;

__host__ __device__ __forceinline__ int lds_byte(int r, int c) { const int st = (r >> 4) * 2 + (c >> 5), rr = r & 15, cc = c & 31, ob = rr * 64 + cc * 2; return st * 1024 + (ob ^ (((ob >> 9) & 1) << 5)); }
__host__ __device__ __forceinline__ void stage_rc(int b, int& R, int& C) { const int st = b / 1024, sb = b % 1024, swz = sb ^ (((sb >> 9) & 1) << 5); R = (st >> 1) * 16 + swz / 64; C = (st & 1) * 32 + (swz % 64) / 2; }
__host__ __device__ __forceinline__ int perm32(int rho) { const int n = rho >> 4, i = rho & 15; return 8 * (i >> 2) + 4 * n + (i & 3); }

struct Unit { int pm, pn; const char* bB; int e, nvalid, rowbase, par; };
struct Gemm { const char* A; };

typedef int v8i_t __attribute__((ext_vector_type(8)));
typedef int v4i_t __attribute__((ext_vector_type(4)));
__device__ __forceinline__ v8i_t cat8(const bf16x8 lo, const bf16x8 hi) { const v4i_t a = __builtin_bit_cast(v4i_t, lo), b = __builtin_bit_cast(v4i_t, hi); return __builtin_shufflevector(a, b, 0, 1, 2, 3, 4, 5, 6, 7); }
template <int K, int KSTEPA, bool FP8 = false, bool ALIGN = true, class Epi, class Sched>
__device__ __forceinline__ void gemm_phase(PG8_LAS unsigned char* lds, const Gemm g, const Sched& S, const Epi& E) {
    const int tid = opqv(threadIdx.x), wid = __builtin_amdgcn_readfirstlane(tid >> 6), lane = tid & 63, wr = wid >> 2, wc = wid & 3, fr = lane & 15, fq = lane >> 4;
    constexpr int nt = K / BK;
    constexpr int PERMI = (int)Epi::PERM;
    unsigned voffB[2], voffB1[2];
#pragma unroll
    for (int i = 0; i < 2; ++i) { int R, C; stage_rc(tid * 16 + i * 8192, R, C);
        if constexpr (PERMI == 2) { const int w0 = 64 * (R >> 5) + 16 * ((R & 15) >> 2) + 4 * ((R >> 4) & 1) + (R & 3); voffB[i] = (unsigned)(w0 * K + C) * 2u; voffB1[i] = (unsigned)((w0 + 8) * K + C) * 2u; }
        else { const int Rb = PERMI == 1 ? ((R & ~31) + perm32(R & 31)) : R; voffB[i] = (unsigned)(Rb * K + C) * 2u; voffB1[i] = voffB[i]; } }
#define PG8_AOFF2T(U, h, par, o0, o1) do { int R0_, C0_, R1_, C1_; const int t_ = opqv(tid); stage_rc(t_ * 16, R0_, C0_); stage_rc(t_ * 16 + 8192, R1_, C1_); o0 = (unsigned)opqv((int)S.a_off_tab(U, h, R0_, C0_, par, lds)); o1 = (unsigned)opqv((int)S.a_off_tab(U, h, R1_, C1_, par, lds)); } while (0)
#define PG8_AOFF2(U, h, o0, o1) do { int R0_, C0_, R1_, C1_; const int t_ = opqv(tid); stage_rc(t_ * 16, R0_, C0_); stage_rc(t_ * 16 + 8192, R1_, C1_); o0 = (unsigned)opqv((int)S.a_off(U, h, R0_, C0_)); o1 = (unsigned)opqv((int)S.a_off(U, h, R1_, C1_)); } while (0)
#define PG8_AOFFS(U, o00, o01, o10, o11) do { int R0_, C0_, R1_, C1_; const int t_ = opqv(tid); stage_rc(t_ * 16, R0_, C0_); stage_rc(t_ * 16 + 8192, R1_, C1_); \
        o00 = (unsigned)opqv((int)S.a_off(U, 0, R0_, C0_)); o01 = (unsigned)opqv((int)S.a_off(U, 0, R1_, C1_)); o10 = (unsigned)opqv((int)S.a_off(U, 1, R0_, C0_)); o11 = (unsigned)opqv((int)S.a_off(U, 1, R1_, C1_)); } while (0)
    constexpr size_t kstepA = (size_t)KSTEPA;
    const size_t kstep = (size_t)(BK * 2);
    const size_t hstep = (size_t)HALF * K * 2;
    const size_t hstepB = PERMI == 2 ? (size_t)0 : hstep;
    const unsigned ldsw = (unsigned)wid * 1024u;
    const int aoff = lds_byte(wr * 64 + fr, fq * 8), boff = lds_byte(wc * 32 + fr, fq * 8);
#define PG8_SA(b, h) (((b) * 2 + (h)) * HTB)
#define PG8_SB(b, h) ((4 + (b) * 2 + (h)) * HTB)
#define PG8_STAGE(bufoff, gbase, voff) do { _Pragma("unroll") for (int _i = 0; _i < 2; ++_i) \
        __builtin_amdgcn_global_load_lds((const unsigned*)((const char*)(gbase) + (voff)[_i]), (PG8_LAS unsigned*)(lds + (bufoff) + ldsw + _i * 8192), 16, 0, 0); } while (0)
#define PG8_STAGEA(bufoff, o0, o1, kb) do { \
        __builtin_amdgcn_global_load_lds((const unsigned*)(g.A + (kb) + (o0)), (PG8_LAS unsigned*)(lds + (bufoff) + ldsw), 16, 0, 0); \
        __builtin_amdgcn_global_load_lds((const unsigned*)(g.A + (kb) + (o1)), (PG8_LAS unsigned*)(lds + (bufoff) + ldsw + 8192), 16, 0, 0); } while (0)
#define PG8_LDA8(dst, b, h) do { _Pragma("unroll") for (int m = 0; m < 4; ++m) dst[m] = cat8(*(const PG8_LAS bf16x8*)(lds + PG8_SA(b, h) + aoff + m * 2048), *(const PG8_LAS bf16x8*)(lds + PG8_SA(b, h) + aoff + m * 2048 + 1024)); } while (0)
#define PG8_LDB8(dst, b, h) do { _Pragma("unroll") for (int n = 0; n < 2; ++n) dst[n] = cat8(*(const PG8_LAS bf16x8*)(lds + PG8_SB(b, h) + boff + n * 2048), *(const PG8_LAS bf16x8*)(lds + PG8_SB(b, h) + boff + n * 2048 + 1024)); } while (0)
#define PG8_LDA_(dst, dst8, b, h) do { if constexpr (FP8) PG8_LDA8(dst8, b, h); else PG8_LDA(dst, b, h); } while (0)
#define PG8_LDB_(dst, dst8, b, h) do { if constexpr (FP8) PG8_LDB8(dst8, b, h); else PG8_LDB(dst, b, h); } while (0)
#define PG8_LDA(dst, b, h) do { _Pragma("unroll") for (int m = 0; m < 4; ++m) _Pragma("unroll") for (int k = 0; k < 2; ++k) dst[m][k] = *(const PG8_LAS bf16x8*)(lds + PG8_SA(b, h) + aoff + m * 2048 + k * 1024); } while (0)
#define PG8_LDB(dst, b, h) do { _Pragma("unroll") for (int n = 0; n < 2; ++n) _Pragma("unroll") for (int k = 0; k < 2; ++k) dst[n][k] = *(const PG8_LAS bf16x8*)(lds + PG8_SB(b, h) + boff + n * 2048 + k * 1024); } while (0)
#define PG8_MMA(ai, bj, At, Bt) do { __builtin_amdgcn_s_setprio(1); if constexpr (FP8) { _Pragma("unroll") for (int m = 0; m < 4; ++m) _Pragma("unroll") for (int n = 0; n < 2; ++n) \
        acc[ai][bj][m][n] = __builtin_amdgcn_mfma_scale_f32_16x16x128_f8f6f4(Bt##8[n], At##8[m], acc[ai][bj][m][n], 0, 0, 0, 0x7f7f7f7f, 0, 0x7f7f7f7f); } else { \
        _Pragma("unroll") for (int m = 0; m < 4; ++m) _Pragma("unroll") for (int n = 0; n < 2; ++n) _Pragma("unroll") for (int k = 0; k < 2; ++k) \
        acc[ai][bj][m][n] = __builtin_amdgcn_mfma_f32_16x16x32_bf16(Bt[n][k], At[m][k], acc[ai][bj][m][n], 0, 0, 0); } __builtin_amdgcn_s_setprio(0); } while (0)
#define PG8_WAIT_V(n) asm volatile("s_waitcnt vmcnt(" #n ")" ::: "memory")
#define PG8_WAIT_L(n) asm volatile("s_waitcnt lgkmcnt(" #n ")" ::: "memory")
#define PG8_BAR __builtin_amdgcn_s_barrier()
#define PG8_SCHED __builtin_amdgcn_sched_barrier(0)
#define PG8_SCHED8 do { if constexpr (FP8) __builtin_amdgcn_sched_barrier(0); } while (0)
#define PG8_PIN(ai) do { if constexpr (FP8) { _Pragma("unroll") for (int bj_ = 0; bj_ < 2; ++bj_) _Pragma("unroll") for (int m_ = 0; m_ < 4; ++m_) _Pragma("unroll") for (int n_ = 0; n_ < 2; ++n_) asm volatile("" : "+v"(acc[ai][bj_][m_][n_])); } } while (0)
    Unit cur, nxt; int ui = 0;
    if (!S.next(0, cur)) return;
    S.prefetch(cur, 0, lds);
    f32x4 acc[2][2][4][2];
#pragma unroll
    for (int a = 0; a < 2; ++a)
#pragma unroll
        for (int b = 0; b < 2; ++b)
#pragma unroll
            for (int m = 0; m < 4; ++m)
#pragma unroll
                for (int n = 0; n < 2; ++n) acc[a][b][m][n] = (f32x4){0.f, 0.f, 0.f, 0.f};
    bf16x8 At[4][2], B0[2][2], B1[2][2]; v8i_t At8[4], B08[2], B18[2];
    unsigned ca00, ca01, ca10, ca11; PG8_AOFFS(cur, ca00, ca01, ca10, ca11);
    const char* cB = cur.bB;
    PG8_STAGE(PG8_SB(0, 0), cB, voffB); PG8_STAGE(PG8_SB(0, 1), cB + hstepB, voffB1); PG8_STAGEA(PG8_SA(0, 0), ca00, ca01, (size_t)0); PG8_STAGEA(PG8_SA(0, 1), ca10, ca11, (size_t)0);
    if (wr == 1) PG8_BAR;
    PG8_WAIT_V(2); PG8_BAR;
    PG8_STAGE(PG8_SB(1, 0), cB + kstep, voffB); PG8_STAGEA(PG8_SA(1, 0), ca00, ca01, kstepA); PG8_STAGE(PG8_SB(1, 1), cB + hstepB + kstep, voffB1);
    PG8_WAIT_V(6); PG8_BAR;
    for (;;) {
        const bool has_next = S.next(ui + 1, nxt);
        const char* nB = has_next ? nxt.bB : cB;
        const int npar = (ui + 1) & 1;
        if (has_next) S.prefetch(nxt, npar, lds);

#pragma unroll 1
        for (int t = 0; t < nt; t += 2) {
            const bool last = (t == nt - 2);
            const bool fromnext = last && has_next;
            const size_t k1 = (size_t)(t + 1) * kstepA;
            const size_t k2 = last ? (size_t)0 : (size_t)(t + 2) * kstepA;
            const size_t k3 = k2 + kstepA;
            const char* b2 = last ? nB : cB + (size_t)(t + 2) * kstep; const char* b3 = b2 + kstep;
            unsigned y0, y1;
            PG8_LDB_(B0, B08, 0, 0); PG8_LDB_(B1, B18, 0, 1); PG8_SCHED; PG8_LDA_(At, At8, 0, 0); PG8_STAGEA(PG8_SA(1, 1), ca10, ca11, k1);
            PG8_WAIT_V(8); PG8_WAIT_L(0); PG8_BAR; PG8_SCHED8; PG8_MMA(0, 0, At, B0); PG8_MMA(0, 1, At, B1); PG8_PIN(0); PG8_SCHED8; PG8_BAR; PG8_SCHED;
            y0 = ca00; y1 = ca01; if (fromnext) PG8_AOFF2T(nxt, 0, npar, y0, y1);
            PG8_LDA_(At, At8, 0, 1); PG8_STAGE(PG8_SB(0, 0), b2, voffB); PG8_STAGE(PG8_SB(0, 1), b2 + hstepB, voffB1); PG8_STAGEA(PG8_SA(0, 0), y0, y1, k2);
            PG8_WAIT_V(8); PG8_WAIT_L(0); PG8_BAR; PG8_SCHED8; PG8_MMA(1, 0, At, B0); PG8_MMA(1, 1, At, B1); PG8_PIN(1); PG8_SCHED8; PG8_BAR; PG8_SCHED;
            y0 = ca10; y1 = ca11; if (fromnext) PG8_AOFF2T(nxt, 1, npar, y0, y1);
            PG8_LDB_(B0, B08, 1, 0); PG8_LDB_(B1, B18, 1, 1); PG8_SCHED; PG8_LDA_(At, At8, 1, 0); PG8_STAGEA(PG8_SA(0, 1), y0, y1, k2);
            PG8_WAIT_V(8); PG8_WAIT_L(0); PG8_BAR; PG8_SCHED8; PG8_MMA(0, 0, At, B0); PG8_MMA(0, 1, At, B1); PG8_PIN(0); PG8_SCHED8; PG8_BAR; PG8_SCHED;
            y0 = ca00; y1 = ca01; if (fromnext) PG8_AOFF2T(nxt, 0, npar, y0, y1);
            PG8_LDA_(At, At8, 1, 1); PG8_STAGE(PG8_SB(1, 0), b3, voffB); PG8_STAGE(PG8_SB(1, 1), b3 + hstepB, voffB1); PG8_STAGEA(PG8_SA(1, 0), y0, y1, k3);
            PG8_WAIT_V(8); PG8_WAIT_L(0); PG8_BAR; PG8_SCHED8; PG8_MMA(1, 0, At, B0); PG8_MMA(1, 1, At, B1); PG8_PIN(1); PG8_SCHED8; PG8_BAR; PG8_SCHED;
        }
        if (ALIGN && wr == 0) PG8_BAR;
        if constexpr (!Epi::AFTER_DRAIN) { E(acc, cur, wr, wc, fr, fq); }
        if (!has_next) break;
#pragma unroll
        for (int a = 0; a < 2; ++a)
#pragma unroll
            for (int b = 0; b < 2; ++b)
#pragma unroll
                for (int m = 0; m < 4; ++m)
#pragma unroll
                    for (int n = 0; n < 2; ++n) acc[a][b][m][n] = (f32x4){0.f, 0.f, 0.f, 0.f};
        cur = nxt; cB = nB; ++ui; PG8_AOFF2T(cur, 0, npar, ca00, ca01); PG8_AOFF2T(cur, 1, npar, ca10, ca11);
        if (ALIGN && wr == 1) PG8_BAR;
    }
    PG8_WAIT_V(0);
    if (!ALIGN && wr == 0) PG8_BAR;
    PG8_BAR;
    if constexpr (Epi::AFTER_DRAIN) { E.fused(acc, cur, wr, wc, fr, fq, lds, wid, lane); }
#undef PG8_SA
#undef PG8_SB
#undef PG8_STAGE
#undef PG8_STAGEA
#undef PG8_AOFFS
#undef PG8_AOFF2
#undef PG8_AOFF2T
#undef PG8_LDA
#undef PG8_LDA8
#undef PG8_LDB8
#undef PG8_LDA_
#undef PG8_LDB_
#undef PG8_LDB
#undef PG8_MMA
#undef PG8_WAIT_V
#undef PG8_WAIT_L
#undef PG8_BAR
#undef PG8_SCHED
#undef PG8_SCHED8
#undef PG8_PIN
}

struct DenseOrder {
    int nM, nN, nwg, G, c, K; const char* Bt;
    __device__ void init(int M, int N, int K_, const void* Bt_, int G_, int c_) { nM = M / BM; nN = N / BM; nwg = nM * nN; G = G_; c = c_; K = K_; Bt = (const char*)Bt_; }
    __device__ __forceinline__ bool next(int i, Unit& u) const {
        const int L = i * G + c; if (L >= nwg) return false;
        int wgid = L; { const int q = nwg / 8, r = nwg % 8, xcd = wgid % 8, off = wgid / 8; wgid = (xcd < r ? xcd * (q + 1) : r * (q + 1) + (xcd - r) * q) + off; }
        const int nig = 8 * nN, gid = wgid / nig, fm = gid * 8, gsz = (nM - fm) < 8 ? (nM - fm) : 8;
        u.pm = fm + ((wgid % nig) % gsz); u.pn = (wgid % nig) / gsz; u.bB = Bt + (size_t)u.pn * BM * K * 2; u.e = 0; u.nvalid = 256; u.rowbase = 0; u.par = 0; return true;
    }
    __device__ __forceinline__ unsigned a_off(const Unit& u, int h, int R, int C) const { return (unsigned)(((u.pm * BM + h * HALF + R) * K + C) * 2); }
    __device__ __forceinline__ void prefetch(const Unit&, int, PG8_LAS unsigned char*) const {}
    __device__ __forceinline__ unsigned a_off_tab(const Unit& u, int h, int R, int C, int, PG8_LAS unsigned char*) const { return a_off(u, h, R, C); }
};
}
template <class RowMap>
__device__ __forceinline__ void transpose_item(const float* W, int K, int N, bf16_t* dst, const RowMap& rowmap, LAS float* scr, int kb, int nb, int lane) {
    const int k0 = 64 * kb, n0 = 64 * nb;
    const int cc = 4 * (lane & 15), rr = lane >> 4;
    const bool ok = (n0 + cc) < N;
    f32x4 v[16];
#pragma unroll
    for (int i = 0; i < 16; ++i) { v[i] = (f32x4){0.f, 0.f, 0.f, 0.f}; if (ok) v[i] = __builtin_nontemporal_load((const f32x4*)(W + (size_t)(k0 + 4 * i + rr) * N + n0 + cc)); }
#pragma unroll
    for (int i = 0; i < 16; ++i) { LAS float* s = scr + (4 * i + rr) * 65 + cc; s[0] = v[i].x; s[1] = v[i].y; s[2] = v[i].z; s[3] = v[i].w; }
    LDS_WAIT();
    const int c = lane & 7;
#pragma unroll
    for (int j = 0; j < 8; ++j) {
        const int n = (lane >> 3) + 8 * j;
        const LAS float* s = scr + (8 * c) * 65 + n;
        u32x4 o; o.x = pk2(s[0 * 65], s[1 * 65]); o.y = pk2(s[2 * 65], s[3 * 65]); o.z = pk2(s[4 * 65], s[5 * 65]); o.w = pk2(s[6 * 65], s[7 * 65]);
        if (n0 + n < N) *(u32x4*)(dst + (size_t)rowmap(n0 + n) * K + k0 + 8 * c) = o;
    }
    LDS_WAIT();
}
template <class RowMap>
__device__ __forceinline__ void transpose_item_fp8(const float* W, int K, int N, unsigned char* dst, const RowMap& rowmap, float scale, LAS float* scr, int kb, int nb, int lane) {
    const int k0 = 64 * kb, n0 = 64 * nb;
    const int cc = 4 * (lane & 15), rr = lane >> 4;
    const bool ok = (n0 + cc) < N;
    f32x4 v[16];
#pragma unroll
    for (int i = 0; i < 16; ++i) { v[i] = (f32x4){0.f, 0.f, 0.f, 0.f}; if (ok) v[i] = __builtin_nontemporal_load((const f32x4*)(W + (size_t)(k0 + 4 * i + rr) * N + n0 + cc)); }
#pragma unroll
    for (int i = 0; i < 16; ++i) { LAS float* s = scr + (4 * i + rr) * 65 + cc; s[0] = v[i].x; s[1] = v[i].y; s[2] = v[i].z; s[3] = v[i].w; }
    LDS_WAIT();
    const int c = lane & 7;
#pragma unroll
    for (int j = 0; j < 8; ++j) {
        const int n = (lane >> 3) + 8 * j;
        const LAS float* s = scr + (8 * c) * 65 + n;
        u32x2 o; o.x = pk4_fp8(s[0 * 65] * scale, s[1 * 65] * scale, s[2 * 65] * scale, s[3 * 65] * scale); o.y = pk4_fp8(s[4 * 65] * scale, s[5 * 65] * scale, s[6 * 65] * scale, s[7 * 65] * scale);
        if (n0 + n < N) *(u32x2*)(dst + (size_t)rowmap(n0 + n) * K + k0 + 8 * c) = o;
    }
    LDS_WAIT();
}
struct MapId { int off; __device__ __forceinline__ int operator()(int n) const { return off + n; } };
struct MapGU { int off; __device__ __forceinline__ int operator()(int n) const { return (n >> 7) * 256 + off + (n & 127); } };

struct XItem { const float* src; unsigned char* dst; int N, K; };
__device__ __forceinline__ XItem xitem(const Params& p, unsigned char* ws, int id_, int lane) {
    const int id = __builtin_amdgcn_readfirstlane(id_);
    const int t = id & 255, ew = id >> 8, e = ew / 3, which = ew - 3 * e;
    XItem it;
    if (which < 2) {
        const int kb = t >> 3, nb = t & 7;
        it.N = EFF; it.K = DM;
        it.src = (e < NEXP ? INP(23 + which) + (size_t)e * DM * EFF : INP(26 + which)) + (size_t)(64 * kb) * EFF + 64 * nb;
        const int n0 = 64 * nb; const int r0 = (n0 >> 7) * 256 + which * 128 + (n0 & 127);
        it.dst = (unsigned char*)(ws + OFF_WEUPT) + (size_t)e * 1024 * DM + (size_t)r0 * DM + 64 * kb;
    } else {
        const int kb = t >> 5, nb = t & 31;
        it.N = DM; it.K = EFF;
        it.src = (e < NEXP ? INP(25) + (size_t)e * EFF * DM : INP(28)) + (size_t)(64 * kb) * DM + 64 * nb;
        it.dst = (unsigned char*)(ws + OFF_WEDT) + (size_t)e * DM * EFF + (size_t)(64 * nb) * EFF + 64 * kb;
    }
    return it;
}
__device__ __forceinline__ void xload(f32x4 (&v)[16], const XItem& it, int lane) {
    const int cc = 4 * (lane & 15), rr = lane >> 4;
#pragma unroll
    for (int i = 0; i < 16; ++i) v[i] = __builtin_nontemporal_load((const f32x4*)(it.src + (size_t)(4 * i + rr) * it.N + cc));
}
__device__ __forceinline__ void xstore(const f32x4 (&v)[16], const XItem& it, LAS float* scr, int lane) {
    const int cc = 4 * (lane & 15), rr = lane >> 4;
#pragma unroll
    for (int i = 0; i < 16; ++i) { LAS float* s = scr + (4 * i + rr) * 65 + cc; s[0] = v[i].x; s[1] = v[i].y; s[2] = v[i].z; s[3] = v[i].w; }
    LDS_WAIT();
    const int c = lane & 7;
#pragma unroll
    for (int j = 0; j < 8; ++j) {
        const int n = (lane >> 3) + 8 * j;
        const LAS float* s = scr + (8 * c) * 65 + n;
        u32x2 o; o.x = pk4_fp8(s[0 * 65] * W8_SCALE, s[1 * 65] * W8_SCALE, s[2 * 65] * W8_SCALE, s[3 * 65] * W8_SCALE); o.y = pk4_fp8(s[4 * 65] * W8_SCALE, s[5 * 65] * W8_SCALE, s[6 * 65] * W8_SCALE, s[7 * 65] * W8_SCALE);
        *(u32x2*)(it.dst + (size_t)n * it.K + 8 * c) = o;
    }
    LDS_WAIT();
}
__device__ __forceinline__ void expert_convert(const Params& p, LAS unsigned char* lds, int vcu, int G, int first, int count) {
    const int tid = opqv(threadIdx.x), lane = tid & 63, wave = tid >> 6;
    const int gw = vcu * NWAVES + wave, NGW = G * NWAVES;
    unsigned char* ws = opqf(p.ws);
    LAS float* scr = (LAS float*)(lds + wave * 16640);
#ifdef PROBE_PH
    for (int rp = 0; rp < (PROBE_PH == 99 ? 2 : 1); ++rp) {
#endif
    int j = gw;
    if (j >= count) return;
    f32x4 va[16], vb[16];
    XItem ia = xitem(p, ws, first + j, lane), ib = ia;
    xload(va, ia, lane);
    for (;;) {
        const int j1 = j + NGW; const bool m1 = j1 < count;
        if (m1) { ib = xitem(p, ws, first + j1, lane); xload(vb, ib, lane); }
        xstore(va, ia, scr, lane);
        if (!m1) break;
        const int j2 = j1 + NGW; const bool m2 = j2 < count;
        if (m2) { ia = xitem(p, ws, first + j2, lane); xload(va, ia, lane); }
        xstore(vb, ib, scr, lane);
        if (!m2) break;
        j = j2;
    }
#ifdef PROBE_PH
    }
#endif
}
__device__ __forceinline__ void p0_prep(const Params& p, LAS unsigned char* lds, int vcu, int G) {
    const int tid = opqv(threadIdx.x), lane = tid & 63, wave = tid >> 6;
    const int gw = vcu * NWAVES + wave, NGW = G * NWAVES;
    const int gt = vcu * NTHREADS + tid, NGT = G * NTHREADS;
    unsigned char* ws = opqf(p.ws);
    if (vcu == 0 && tid < 64) ((unsigned*)(ws + OFF_CTL))[tid] = 0u;
    {
        const f32x4* x4 = (const f32x4*)INP(0);
        const int n8 = T_TOK * DM / 8;
        for (int i0 = gt; i0 < n8; i0 += 4 * NGT) {
            f32x4 a[4], b[4];
#pragma unroll
            for (int k = 0; k < 4; ++k) { const int i = i0 + k * NGT; if (i < n8) { a[k] = x4[2 * i]; b[k] = x4[2 * i + 1]; } }
#pragma unroll
            for (int k = 0; k < 4; ++k) { const int i = i0 + k * NGT; if (i < n8) {
                ((u32x2*)(ws + OFF_X8))[i] = (u32x2){pk4_fp8(a[k].x, a[k].y, a[k].z, a[k].w), pk4_fp8(b[k].x, b[k].y, b[k].z, b[k].w)}; } }
        }
    }
    {
        u32x4* z1 = (u32x4*)(ws + OFF_WINT + (size_t)IN_COLS * DM); const int n1 = (PROJ_LD - IN_COLS) * DM / 16;
        for (int i = gt; i < n1; i += NGT) z1[i] = (u32x4){0u, 0u, 0u, 0u};

    }
    for (int i = gt; i < NGRP * NSTATE; i += NGT) {
        const int g = i >> 6, pp = i & 63;
        const float lr = INP(3)[i], li = INP(4)[i], dt = expf(INP(5)[g]);
        const float mag = expf(lr * dt); float sn, cs; sincosf(li * dt, &sn, &cs);
        const float ar = mag * cs, ai = mag * sn;
        const float zr = ar - 1.f, zi = ai, den = lr * lr + li * li;
        const float fr = (zr * lr + zi * li) / den, fi = (zi * lr - zr * li) / den;
        ((f32x2*)(ws + OFF_S5A))[i] = (f32x2){ar, ai};
        float pr = ar, pi = ai;
#pragma unroll
        for (int k = 0; k < 8; ++k) { const float nr = pr * pr - pi * pi, ni = 2.f * pr * pi; pr = nr; pi = ni; }
        ((f32x2*)(ws + OFF_S5AC))[i] = (f32x2){pr, pi};
        (void)fr; (void)fi;
    }
    for (int i = gt; i < NGRP * 4 * 64; i += NGT) {
        const int g = i >> 8, v = (i >> 6) & 3, l = i & 63, pp = 32 * (v >> 1) + (l & 31), h0 = 8 * (l >> 5), gp = g * 64 + pp;
        const float lr = INP(3)[gp], li = INP(4)[gp], dt = expf(INP(5)[g]);
        const float mag = expf(lr * dt); float sn, cs; sincosf(li * dt, &sn, &cs);
        const float ar = mag * cs, ai = mag * sn, zr = ar - 1.f, zi = ai, den = lr * lr + li * li;
        const float fr = (zr * lr + zi * li) / den, fi = (zi * lr - zr * li) / den;
        const float* br = INP(6) + (size_t)gp * 16 + h0; const float* bi = INP(7) + (size_t)gp * 16 + h0;
        unsigned w[4];
#pragma unroll
        for (int jj = 0; jj < 4; ++jj) {
            const float r0 = fr * br[2 * jj] - fi * bi[2 * jj], i0 = fr * bi[2 * jj] + fi * br[2 * jj], r1 = fr * br[2 * jj + 1] - fi * bi[2 * jj + 1], i1 = fr * bi[2 * jj + 1] + fi * br[2 * jj + 1];
            w[jj] = (v & 1) ? pk2(i0, i1) : pk2(r0, r1);
        }
        ((u32x4*)(ws + OFF_S5BB))[i] = (u32x4){w[0], w[1], w[2], w[3]};
    }
    for (int i = gt; i < NGRP * 4 * 64; i += NGT) {
        const int g = i >> 8, ks = (i >> 6) & 3, l = i & 63, h = l & 15, q = l >> 4;
        const float* cre = INP(8) + ((size_t)g * 16 + h) * 64; const float* cim = INP(9) + ((size_t)g * 16 + h) * 64;
        unsigned w[4];
#pragma unroll
        for (int jj = 0; jj < 4; ++jj) { const int k = 32 * ks + 8 * q + 2 * jj, pp = k >> 1; w[jj] = pk2(cre[pp], -cim[pp]); }
        ((u32x4*)(ws + OFF_S5CF))[i] = (u32x4){w[0], w[1], w[2], w[3]};
    }
    if (vcu < 32) {
        const int which = vcu >> 4, pt = vcu & 15;
        const float* pe = INP(12 + which); const float* w1 = INP(which == 0 ? 14 : 16);
        LAS float* red = (LAS float*)lds;
        const int j = tid & 127, sub = tid >> 7; float s = 0.f;
        const int kb0 = pt * 128 + sub * 32;
        float wv[32];
#pragma unroll
        for (int k = 0; k < 32; ++k) wv[k] = w1[(size_t)(kb0 + k) * 128 + j];
#pragma unroll
        for (int k = 0; k < 32; ++k) s += pe[kb0 + k] * wv[k];
        red[tid] = s; __syncthreads();
        if (tid < 128) ((float*)(ws + OFF_CBIAS))[(which * 16 + pt) * 128 + tid] = red[tid] + red[tid + 128] + red[tid + 256] + red[tid + 384];
        __syncthreads();
    }
    LAS float* scr = (LAS float*)(lds + wave * 16640);
    auto run = [&](const float* W, int K, int N, bf16_t* dst, auto map, int& base) {
        const int nkb = K / 64, nnb = (N + 63) / 64, items = nkb * nnb;
        int j0 = (gw - (base % NGW) + NGW) % NGW;
        for (int j = j0; j < items; j += NGW) transpose_item(W, K, N, dst, map, scr, j / nnb, j % nnb, lane);
        base += items;
    };
    auto run8 = [&](const float* W, int K, int N, unsigned char* dst, auto map, int& base) {
        const int nnb = (N + 63) / 64, items = (K / 64) * nnb;
        int j0 = (gw - (base % NGW) + NGW) % NGW;
        for (int j = j0; j < items; j += NGW) transpose_item_fp8(W, K, N, dst, map, W8_SCALE, scr, j / nnb, j % nnb, lane);
        base += items;
    };
    int base = 0;
    run8(INP(2), DM, IN_COLS, (unsigned char*)(ws + OFF_WINT), MapId{0}, base);
    run(INP(11), 1024, 1024, (bf16_t*)(ws + OFF_WGLUT), MapId{0}, base);
    run8(INP(18), DM, DM, (unsigned char*)(ws + OFF_WOUTT), MapId{0}, base);
    run(INP(14), DM, 128, (bf16_t*)(ws + OFF_WC1T), MapId{0}, base);
    run(INP(16), DM, 128, (bf16_t*)(ws + OFF_WC1T), MapId{128}, base);
    run(INP(21), DM, NEXP, (bf16_t*)(ws + OFF_WRT), MapId{0}, base);
    (void)run8;
}
using pg8::Unit;
struct EpiStoreBf16 {
    static constexpr int PERM = 1; static constexpr bool AFTER_DRAIN = false;
    bf16_t* O; int ldc; float sc;
    __device__ __forceinline__ void operator()(const f32x4 (&acc)[2][2][4][2], const Unit& u, int wr, int wc, int fr, int fq) const {
        const int row0 = u.pm * 256 + wr * 64 + fr, col0 = u.pn * 256 + wc * 32 + 8 * fq;
#pragma unroll
        for (int ai = 0; ai < 2; ++ai)
#pragma unroll
            for (int m = 0; m < 4; ++m) { bf16_t* rowp = O + (size_t)(row0 + ai * 128 + m * 16) * ldc + col0;
#pragma unroll
                for (int bj = 0; bj < 2; ++bj) { const f32x4 v0 = acc[ai][bj][m][0] * sc, v1 = acc[ai][bj][m][1] * sc;
                    u32x4 w; w.x = cvt_pk_bf16(v0[0], v0[1]); w.y = cvt_pk_bf16(v0[2], v0[3]); w.z = cvt_pk_bf16(v1[0], v1[1]); w.w = cvt_pk_bf16(v1[2], v1[3]);
                    *(u32x4*)(rowp + bj * 128) = w; } }
    }
};
struct EpiGlu {
    static constexpr int PERM = 1; static constexpr bool AFTER_DRAIN = false;
    const bf16_t* Y; unsigned char* O;
    __device__ __forceinline__ void operator()(const f32x4 (&acc)[2][2][4][2], const Unit& u, int wr, int wc, int fr, int fq) const {
        const int row0 = u.pm * 256 + wr * 64 + fr, col0 = u.pn * 256 + wc * 32 + 8 * fq;
#pragma unroll
        for (int ai = 0; ai < 2; ++ai) {
            u32x4 yv[4][2];
#pragma unroll
            for (int m = 0; m < 4; ++m)
#pragma unroll
                for (int bj = 0; bj < 2; ++bj) yv[m][bj] = *(const u32x4*)(Y + (size_t)(row0 + ai * 128 + m * 16) * 1024 + col0 + bj * 128);
#pragma unroll
            for (int m = 0; m < 4; ++m) { const size_t r = (size_t)(row0 + ai * 128 + m * 16);
#pragma unroll
                for (int bj = 0; bj < 2; ++bj) { const f32x4 v0 = acc[ai][bj][m][0], v1 = acc[ai][bj][m][1];
                    const u32x4 y = yv[m][bj];
                    u32x2 w;
                    w.x = pk4_fp8(bflo(y.x) * sigmoidf_(v0[0]) * MIX8_SCALE, bfhi(y.x) * sigmoidf_(v0[1]) * MIX8_SCALE, bflo(y.y) * sigmoidf_(v0[2]) * MIX8_SCALE, bfhi(y.y) * sigmoidf_(v0[3]) * MIX8_SCALE);
                    w.y = pk4_fp8(bflo(y.z) * sigmoidf_(v1[0]) * MIX8_SCALE, bfhi(y.z) * sigmoidf_(v1[1]) * MIX8_SCALE, bflo(y.w) * sigmoidf_(v1[2]) * MIX8_SCALE, bfhi(y.w) * sigmoidf_(v1[3]) * MIX8_SCALE);
                    *(u32x2*)(O + r * 2048 + col0 + bj * 128) = w; } }
        }
    }
};
struct EpiResF32 {
    static constexpr int PERM = 0; static constexpr bool AFTER_DRAIN = false;
    const float* X; float* O;
    __device__ __forceinline__ void operator()(const f32x4 (&acc)[2][2][4][2], const Unit& u, int wr, int wc, int fr, int fq) const {
        const int row0 = u.pm * 256 + wr * 64 + fr, col0 = u.pn * 256 + wc * 32 + 4 * fq;
#pragma unroll
        for (int ai = 0; ai < 2; ++ai)
#pragma unroll
            for (int m = 0; m < 4; ++m) { const size_t off = (size_t)(row0 + ai * 128 + m * 16) * DM + col0;
#pragma unroll
                for (int bj = 0; bj < 2; ++bj)
#pragma unroll
                    for (int n = 0; n < 2; ++n) { const f32x4 xv = *(const f32x4*)(X + off + bj * 128 + n * 16); *(f32x4*)(O + off + bj * 128 + n * 16) = xv * ALPHA + acc[ai][bj][m][n]; } }
    }
};

struct EpiResBf16 {
    static constexpr int PERM = 1; static constexpr bool AFTER_DRAIN = false;
    const float* X; bf16_t* O;
    __device__ __forceinline__ void operator()(const f32x4 (&acc)[2][2][4][2], const Unit& u, int wr, int wc, int fr, int fq) const {
        const int row0 = u.pm * 256 + wr * 64 + fr, col0 = u.pn * 256 + wc * 32 + 8 * fq;
#pragma unroll
        for (int ai = 0; ai < 2; ++ai)
#pragma unroll
            for (int mh = 0; mh < 2; ++mh) {
                f32x4 xv[2][2][2];
#pragma unroll
                for (int m2 = 0; m2 < 2; ++m2)
#pragma unroll
                    for (int bj = 0; bj < 2; ++bj) { const float* xp = X + (size_t)(row0 + ai * 128 + (2 * mh + m2) * 16) * DM + col0 + bj * 128; xv[m2][bj][0] = *(const f32x4*)xp; xv[m2][bj][1] = *(const f32x4*)(xp + 4); }
#pragma unroll
                for (int m2 = 0; m2 < 2; ++m2) { const int m = 2 * mh + m2; const size_t off = (size_t)(row0 + ai * 128 + m * 16) * DM + col0;
#pragma unroll
                    for (int bj = 0; bj < 2; ++bj) { const f32x4 v0 = acc[ai][bj][m][0] * (1.f / (W8_SCALE * MIX8_SCALE)), v1 = acc[ai][bj][m][1] * (1.f / (W8_SCALE * MIX8_SCALE));
                        const f32x4 x0 = xv[m2][bj][0], x1 = xv[m2][bj][1];
                        u32x4 w; w.x = cvt_pk_bf16(x0[0] * ALPHA + v0[0], x0[1] * ALPHA + v0[1]); w.y = cvt_pk_bf16(x0[2] * ALPHA + v0[2], x0[3] * ALPHA + v0[3]);
                        w.z = cvt_pk_bf16(x1[0] * ALPHA + v1[0], x1[1] * ALPHA + v1[1]); w.w = cvt_pk_bf16(x1[2] * ALPHA + v1[2], x1[3] * ALPHA + v1[3]);
                        *(u32x4*)(O + off + bj * 128) = w; } }
            }
    }
};

template <int NSL>
__device__ __forceinline__ void ln_row(const bf16_t* inrow, float inscale, const unsigned char* slots  , const f32x4 (&gv)[8], const f32x4 (&bv)[8]  , float* outrow, bf16_t* outb, unsigned char* outq, int lane) {
    const u32x2* xr = (const u32x2*)inrow + lane;
    f32x4 v[8]; float s = 0.f;
#pragma unroll
    for (int j = 0; j < 8; ++j) { const u32x2 w = xr[64 * j]; v[j] = (f32x4){bflo(w.x), bfhi(w.x), bflo(w.y), bfhi(w.y)} * inscale; }
    if (NSL > 0) {
#pragma unroll
        for (int k = 0; k < NSL; ++k) { const unsigned* sr = (const unsigned*)(slots + (size_t)k * DM) + lane;
#pragma unroll
            for (int j = 0; j < 8; ++j) { const unsigned w = sr[64 * j]; const f32x2 lo = __builtin_amdgcn_cvt_pk_f32_fp8(w, false), hi = __builtin_amdgcn_cvt_pk_f32_fp8(w, true);
                v[j].x += lo.x * (1.f / SLOT_SCALE); v[j].y += lo.y * (1.f / SLOT_SCALE); v[j].z += hi.x * (1.f / SLOT_SCALE); v[j].w += hi.y * (1.f / SLOT_SCALE); } }
    }
#pragma unroll
    for (int j = 0; j < 8; ++j) s += (v[j].x + v[j].y) + (v[j].z + v[j].w);
    const float mean = wave_sum(s) * (1.f / DM); float s2 = 0.f;
#pragma unroll
    for (int j = 0; j < 8; ++j) { v[j] = v[j] - mean; s2 += (v[j].x * v[j].x + v[j].y * v[j].y) + (v[j].z * v[j].z + v[j].w * v[j].w); }
    const float rstd = 1.f / sqrtf(wave_sum(s2) * (1.f / DM) + LN_EPS);
    f32x4* o = (f32x4*)outrow + lane;
    u32x2* ob = (u32x2*)outb + lane; unsigned* oq = (unsigned*)outq + lane;
#pragma unroll
    for (int j = 0; j < 8; ++j) { const f32x4 r = v[j] * rstd * gv[j] + bv[j]; __builtin_nontemporal_store(r, &o[64 * j]); if (outb) ob[64 * j] = (u32x2){pk2(r.x, r.y), pk2(r.z, r.w)}; if (outq) oq[64 * j] = pk4_fp8(r.x, r.y, r.z, r.w); }
}
typedef float f32x16 __attribute__((ext_vector_type(16)));
constexpr int S5_WAVE_LDS = 2 * 16 * 272;
template <bool PASS2>
__device__ __forceinline__ void s5_pass(const Params& p, LAS unsigned char* lds, int vcu, int G) {
    const int tid = opqv(threadIdx.x), lane = tid & 63, wave = __builtin_amdgcn_readfirstlane(tid >> 6);
    const int gw = vcu * NWAVES + wave, NGW = G * NWAVES;
    unsigned char* ws = opqf(p.ws);
    const bf16_t* proj = (const bf16_t*)(ws + OFF_PROJ);
    LAS unsigned char* sl = lds + wave * S5_WAVE_LDS;
    f32x2* Ebuf = (f32x2*)(ws + OFF_E);
    const int c = lane & 31, hh = lane >> 5;
    const int arow = lane & 31, ab = (arow >> 2) & 1, atok = (arow & 3) + 4 * (arow >> 3), ak = 8 * (lane >> 5);
    const int h = lane & 15, q = lane >> 4;
    for (int task = gw; task < NGRP * S5_NSEG; task += NGW) {
        const int g = task % NGRP, sg = task / NGRP;
        bf16x8 bf[4];
#pragma unroll
        for (int v = 0; v < 4; ++v) bf[v] = ((const bf16x8*)(ws + OFF_S5BB))[(g * 4 + v) * 64 + lane];
        const f32x2 a0 = ((const f32x2*)(ws + OFF_S5A))[g * 64 + c], a1 = ((const f32x2*)(ws + OFF_S5A))[g * 64 + 32 + c];
        float s0r = 0.f, s0i = 0.f, s1r = 0.f, s1i = 0.f;
        bf16x8 cf[4]; float dsk = 0.f;
        if (PASS2) {
            const f32x2 c0 = ((const f32x2*)(ws + OFF_S5AC))[g * 64 + c], c1 = ((const f32x2*)(ws + OFF_S5AC))[g * 64 + 32 + c];
            const f32x2* Ep = Ebuf + ((size_t)(hh * NGRP + g) * S5_NSEG) * 64 + c;
#pragma unroll 1
            for (int cc = 0; cc < sg; cc += 4) {
                f32x2 e0[4], e1[4];
#pragma unroll
                for (int k = 0; k < 4; ++k) { e0[k] = (f32x2){0.f, 0.f}; e1[k] = e0[k]; if (cc + k < sg) { e0[k] = Ep[(size_t)(cc + k) * 64]; e1[k] = Ep[(size_t)(cc + k) * 64 + 32]; } }
#pragma unroll
                for (int k = 0; k < 4; ++k) if (cc + k < sg) {
                    const float n0r = c0.x * s0r - c0.y * s0i + e0[k].x, n0i = c0.x * s0i + c0.y * s0r + e0[k].y; s0r = n0r; s0i = n0i;
                    const float n1r = c1.x * s1r - c1.y * s1i + e1[k].x, n1i = c1.x * s1i + c1.y * s1r + e1[k].y; s1r = n1r; s1i = n1i;
                }
            }
#pragma unroll
            for (int ks = 0; ks < 4; ++ks) cf[ks] = ((const bf16x8*)(ws + OFF_S5CF))[(g * 4 + ks) * 64 + lane];
            dsk = INP(10)[g * 16 + h];
        }
        const bf16_t* ubase = proj + (size_t)(ab * SEQ + sg * S5_SEG + atok) * PROJ_LD + g * 16 + ak;
        bf16x8 ua = *(const bf16x8*)ubase;
#pragma unroll 1
        for (int st = 0; st < S5_SEG / 16; ++st) {
            const bf16x8 ucur = ua;
            if (st + 1 < S5_SEG / 16) ua = *(const bf16x8*)(ubase + (size_t)(st + 1) * 16 * PROJ_LD);
            unsigned short uraw[2][4];
            if (PASS2) {
#pragma unroll
                for (int bb = 0; bb < 2; ++bb)
#pragma unroll
                    for (int r = 0; r < 4; ++r) uraw[bb][r] = proj[(size_t)(bb * SEQ + sg * S5_SEG + st * 16 + 4 * q + r) * PROJ_LD + g * 16 + h];
            }
            f32x16 x0r = {0.f, 0.f, 0.f, 0.f, 0.f, 0.f, 0.f, 0.f, 0.f, 0.f, 0.f, 0.f, 0.f, 0.f, 0.f, 0.f}, x0i = x0r, x1r = x0r, x1i = x0r;
            asm volatile("" : "+v"(x0r), "+v"(x0i), "+v"(x1r), "+v"(x1i));
            x0r = __builtin_amdgcn_mfma_f32_32x32x16_bf16(ucur, bf[0], x0r, 0, 0, 0); x0i = __builtin_amdgcn_mfma_f32_32x32x16_bf16(ucur, bf[1], x0i, 0, 0, 0);
            x1r = __builtin_amdgcn_mfma_f32_32x32x16_bf16(ucur, bf[2], x1r, 0, 0, 0); x1i = __builtin_amdgcn_mfma_f32_32x32x16_bf16(ucur, bf[3], x1i, 0, 0, 0);
#pragma unroll
            for (int t = 0; t < 16; ++t) {
                const float n0r = a0.x * s0r - a0.y * s0i + x0r[t], n0i = a0.x * s0i + a0.y * s0r + x0i[t]; s0r = n0r; s0i = n0i;
                const float n1r = a1.x * s1r - a1.y * s1i + x1r[t], n1i = a1.x * s1i + a1.y * s1r + x1i[t]; s1r = n1r; s1i = n1i;
                if (PASS2) { *(LAS unsigned*)(sl + (hh * 16 + t) * 272 + c * 4) = cvt_pk_bf16(s0r, s0i); *(LAS unsigned*)(sl + (hh * 16 + t) * 272 + 128 + c * 4) = cvt_pk_bf16(s1r, s1i); }
            }
            if (PASS2) {
                LDS_WAIT();
#pragma unroll
                for (int bb = 0; bb < 2; ++bb) {
                    f32x4 acc = (f32x4){0.f, 0.f, 0.f, 0.f};
#pragma unroll
                    for (int ks = 0; ks < 4; ++ks) { const bf16x8 av = *(const LAS bf16x8*)(sl + (bb * 16 + h) * 272 + ks * 64 + q * 16); acc = __builtin_amdgcn_mfma_f32_16x16x32_bf16(av, cf[ks], acc, 0, 0, 0); }
                    const size_t trow = (size_t)(bb * SEQ + sg * S5_SEG + st * 16 + 4 * q);
                    bf16_t* yo = (bf16_t*)(ws + OFF_YGELU) + trow * SSM_W + g * 16 + h;
#pragma unroll
                    for (int r = 0; r < 4; ++r) { const float uu = bf2f(uraw[bb][r]); const float y = gelu_tanh(acc[r] + dsk * uu); yo[(size_t)r * SSM_W] = (bf16_t)f2bf(y); }
                }
                LDS_WAIT();
            }
        }
        if (!PASS2) { f32x2* Eo = Ebuf + ((size_t)(hh * NGRP + g) * S5_NSEG + sg) * 64 + c; Eo[0] = (f32x2){s0r, s0i}; Eo[32] = (f32x2){s1r, s1i}; }
    }
}
__device__ __forceinline__ int vperm32(int k) { return 8 * ((k >> 2) & 3) + 4 * (k >> 4) + (k & 3); }

__device__ __forceinline__ void rope8(const u32x4 a, const u32x4 b, const float* cs, const float* sn, float (&o1)[8], float (&o2)[8]) {
    const unsigned aw[4] = {a.x, a.y, a.z, a.w}, bw[4] = {b.x, b.y, b.z, b.w};
#pragma unroll
    for (int k = 0; k < 4; ++k) {
        const float x1l = bflo(aw[k]), x1h = bfhi(aw[k]), x2l = bflo(bw[k]), x2h = bfhi(bw[k]);
        o1[2 * k] = x1l * cs[2 * k] - x2l * sn[2 * k]; o2[2 * k] = x2l * cs[2 * k] + x1l * sn[2 * k];
        o1[2 * k + 1] = x1h * cs[2 * k + 1] - x2h * sn[2 * k + 1]; o2[2 * k + 1] = x2h * cs[2 * k + 1] + x1h * sn[2 * k + 1];
    }
}
__device__ __forceinline__ void nsa_rope_layout(const Params& p, LAS unsigned char* lds, int vcu, int G) {
    const int tid = opqv(threadIdx.x), lane = tid & 63, wave = __builtin_amdgcn_readfirstlane(tid >> 6);
    const int gw = vcu * NWAVES + wave, NGW = G * NWAVES;
    unsigned char* ws = opqp(p.ws);
    const bf16_t* proj = (const bf16_t*)(ws + OFF_PROJ);
    bf16_t* Qr = (bf16_t*)(ws + OFF_QR);
    unsigned char* Q8 = (unsigned char*)(ws + OFF_Q8);
    const int* positions = (const int*)INP(1);
    LAS float* tab = (LAS float*)(lds + wave * 256);
    const float inv = powf(10000.f, -(float)(lane & 31) * (1.f / 32.f));
    const int hd = lane >> 2, qq = lane & 3;
    const int kidx = (lane >> 2) & 3, ktype = kidx >> 1, kkvh = kidx & 1, kcol = (ktype == 0 ? COL_KS : COL_KW) + kkvh * 64;
    u32x4 qa, qb, ka, kb; unsigned short gr = 0;
    auto fetch = [&](int t, u32x4& qa_, u32x4& qb_, u32x4& ka_, u32x4& kb_, unsigned short& g_) {
        const bf16_t* prow = proj + (size_t)t * PROJ_LD;
        qa_ = *(const u32x4*)(prow + COL_Q + hd * 64 + 8 * qq); qb_ = *(const u32x4*)(prow + COL_Q + hd * 64 + 32 + 8 * qq);
        ka_ = (u32x4){0u, 0u, 0u, 0u}; kb_ = ka_;
        if (lane < 16) { ka_ = *(const u32x4*)(prow + kcol + 8 * qq); kb_ = *(const u32x4*)(prow + kcol + 32 + 8 * qq); }
        g_ = lane < 48 ? prow[COL_G + lane] : (unsigned short)0;
    };
    if (gw < T_TOK) fetch(gw, qa, qb, ka, kb, gr);
    for (int t = gw; t < T_TOK; t += NGW) {
        const int b = t / SEQ, tl = t % SEQ;
        const float pos = (float)positions[t];
        u32x4 nqa = qa, nqb = qb, nka = ka, nkb = kb; unsigned short ngr = gr;
        if (t + NGW < T_TOK) fetch(t + NGW, nqa, nqb, nka, nkb, ngr);
        if (lane < 32) { float sn, cs; sincosf(pos * inv, &sn, &cs); tab[lane] = cs; tab[32 + lane] = sn; }
        LDS_WAIT();
        float cs[8], sn[8];
        { const f32x4 c0 = *(const LAS f32x4*)(tab + 8 * qq), c1 = *(const LAS f32x4*)(tab + 8 * qq + 4), s0 = *(const LAS f32x4*)(tab + 32 + 8 * qq), s1 = *(const LAS f32x4*)(tab + 32 + 8 * qq + 4);
#pragma unroll
          for (int k = 0; k < 4; ++k) { cs[k] = c0[k]; cs[4 + k] = c1[k]; sn[k] = s0[k]; sn[4 + k] = s1[k]; } }
        {
            float o1[8], o2[8]; rope8(qa, qb, cs, sn, o1, o2);
            bf16_t* qd = Qr + (size_t)t * 1024 + hd * 64 + 8 * qq;
            *(u32x4*)qd = (u32x4){pk2(o1[0] * 0.125f, o1[1] * 0.125f), pk2(o1[2] * 0.125f, o1[3] * 0.125f), pk2(o1[4] * 0.125f, o1[5] * 0.125f), pk2(o1[6] * 0.125f, o1[7] * 0.125f)};
            *(u32x4*)(qd + 32) = (u32x4){pk2(o2[0] * 0.125f, o2[1] * 0.125f), pk2(o2[2] * 0.125f, o2[3] * 0.125f), pk2(o2[4] * 0.125f, o2[5] * 0.125f), pk2(o2[6] * 0.125f, o2[7] * 0.125f)};
            unsigned char* q8 = Q8 + (size_t)t * 1024 + hd * 64 + 8 * qq;
            *(u32x2*)q8 = (u32x2){pk4_fp8(o1[0], o1[1], o1[2], o1[3]), pk4_fp8(o1[4], o1[5], o1[6], o1[7])};
            *(u32x2*)(q8 + 32) = (u32x2){pk4_fp8(o2[0], o2[1], o2[2], o2[3]), pk4_fp8(o2[4], o2[5], o2[6], o2[7])};
        }
        if (lane < 16) {
            float o1[8], o2[8]; rope8(ka, kb, cs, sn, o1, o2);
            if (ktype == 0) {
                unsigned char* dst = (unsigned char*)(ws + OFF_KSEL) + ((size_t)(b * 2 + kkvh) * SEQ + (tl & ~63)) * 64 + ((tl & 63) >> 4) * 1024 + (qq * 16 + (tl & 15)) * 16;
                *(u32x4*)dst = (u32x4){pk4_fp8(o1[0], o1[1], o1[2], o1[3]), pk4_fp8(o1[4], o1[5], o1[6], o1[7]), pk4_fp8(o2[0], o2[1], o2[2], o2[3]), pk4_fp8(o2[4], o2[5], o2[6], o2[7])};
            } else {
                bf16_t* dst = (bf16_t*)(ws + OFF_KWIN) + ((size_t)(b * 2 + kkvh) * SEQ + tl) * 64 + 8 * qq;
                *(u32x4*)dst = (u32x4){pk2(o1[0], o1[1]), pk2(o1[2], o1[3]), pk2(o1[4], o1[5]), pk2(o1[6], o1[7])};
                *(u32x4*)(dst + 32) = (u32x4){pk2(o2[0], o2[1]), pk2(o2[2], o2[3]), pk2(o2[4], o2[5]), pk2(o2[6], o2[7])};
            }
        }
        if (lane < 48) ((float*)(ws + OFF_GATES))[(size_t)t * 48 + lane] = sigmoidf_(bf2f(gr));
        LDS_WAIT();
        qa = nqa; qb = nqb; ka = nka; kb = nkb; gr = ngr;
    }
}

__device__ __forceinline__ void nsa_vtranspose(const Params& p, LAS unsigned char* lds, int vcu, int G) {
    const int tid = opqv(threadIdx.x), lane = tid & 63, wave = __builtin_amdgcn_readfirstlane(tid >> 6);
    const int gw = vcu * NWAVES + wave, NGW = G * NWAVES;
    unsigned char* ws = opqp(p.ws);
    const bf16_t* proj = (const bf16_t*)(ws + OFF_PROJ);
    LAS unsigned char* sl = lds + wave * 9216;
    for (int task = gw; task < 2 * 4 * 128; task += NGW) {
        const int blk = task & 127, bk = (task >> 7) & 3, type = task >> 9, b = bk >> 1, kvh = bk & 1;
        const bf16_t* src = proj + (size_t)(b * SEQ + blk * 64 + lane) * PROJ_LD + (type == 0 ? COL_VS : COL_VW) + kvh * 64;
#pragma unroll
        for (int i = 0; i < 8; ++i) *(LAS u32x4*)(sl + lane * 144 + 16 * i) = *(const u32x4*)(src + 8 * i);
        LDS_WAIT();
        if (type == 0) {
            unsigned char* dst8 = (unsigned char*)(ws + OFF_VSELT) + (size_t)(bk * 128 + blk) * 4096 + (lane >> 4) * 1024 + (lane & 15) * 16;
#pragma unroll
            for (int qv = 0; qv < 4; ++qv) {
                unsigned w[4];
#pragma unroll
                for (int jj = 0; jj < 4; ++jj) {
                    float f[4];
#pragma unroll
                    for (int e = 0; e < 4; ++e) { const int p0 = 32 * (jj >> 1) + 8 * qv + 4 * (jj & 1) + e; const int k0 = 32 * (p0 >> 5) + ((p0 & 7) >> 2) * 16 + 4 * ((p0 >> 3) & 3) + (p0 & 3); f[e] = bf2f(*(const LAS bf16_t*)(sl + k0 * 144 + lane * 2)); }
                    w[jj] = pk4_fp8(f[0], f[1], f[2], f[3]);
                }
                *(u32x4*)(dst8 + 256 * qv) = (u32x4){w[0], w[1], w[2], w[3]};
            }
            LDS_WAIT();
            continue;
        }
        bf16_t* dst = (bf16_t*)(ws + OFF_VWINT) + ((size_t)(bk * 128 + blk) * 64 + lane) * 64;
#pragma unroll
        for (int c8 = 0; c8 < 8; ++c8) {
            unsigned w[4];
#pragma unroll
            for (int jj = 0; jj < 4; ++jj) {
                const int p0 = c8 * 8 + 2 * jj, p1 = p0 + 1;
                const int k0 = 32 * (p0 >> 5) + ((p0 & 7) >> 2) * 16 + 4 * ((p0 >> 3) & 3) + (p0 & 3), k1 = 32 * (p1 >> 5) + ((p1 & 7) >> 2) * 16 + 4 * ((p1 >> 3) & 3) + (p1 & 3);
                const unsigned lo = *(const LAS bf16_t*)(sl + k0 * 144 + lane * 2), hi = *(const LAS bf16_t*)(sl + k1 * 144 + lane * 2);
                w[jj] = lo | (hi << 16);
            }
            *(u32x4*)(dst + 8 * c8) = (u32x4){w[0], w[1], w[2], w[3]};
        }
        LDS_WAIT();
    }
}

__device__ __forceinline__ void nsa_compress(const Params& p, LAS unsigned char* lds, int vcu, int G) {
    const int tid = opqv(threadIdx.x), lane = tid & 63, wave = __builtin_amdgcn_readfirstlane(tid >> 6), fr = lane & 15, fq = lane >> 4;
    unsigned char* ws = opqp(p.ws);
    const bf16_t* proj = (const bf16_t*)(ws + OFF_PROJ);
    LAS float* hid = (LAS float*)lds;
    LAS float* w2s = (LAS float*)(lds + 16384);
    for (int rt = vcu; rt < 256; rt += G) {
        const int rr0 = rt * 16, which = rr0 >> 11, bk = (rr0 >> 9) & 3, b = bk >> 1, kvh = bk & 1, n0 = rr0 & 511;
        const int na = (n0 + fr) > (NCMP - 1) ? (NCMP - 1) : (n0 + fr);
        const bf16_t* arow = proj + (size_t)(b * SEQ + 16 * na) * PROJ_LD + COL_KC + which * 128 + kvh * 64 + 8 * fq;
        const bf16_t* brow = (const bf16_t*)(ws + OFF_WC1T) + (size_t)(which * 128 + wave * 16 + fr) * DM + 8 * fq;
        {
            const float* w2 = INP(which ? 17 : 15);
            f32x4 wv[4];
#pragma unroll
            for (int i = 0; i < 4; ++i) wv[i] = *(const f32x4*)(w2 + 4 * (tid + i * NTHREADS));
#pragma unroll
            for (int i = 0; i < 4; ++i) *(LAS f32x4*)(w2s + 4 * (tid + i * NTHREADS)) = wv[i];
        }
        f32x4 acc = (f32x4){0.f, 0.f, 0.f, 0.f};
#pragma unroll 8
        for (int ks = 0; ks < 64; ++ks) {
            const bf16x8 a = *(const bf16x8*)(arow + (size_t)(ks >> 1) * PROJ_LD + (ks & 1) * 32);
            const bf16x8 bv = *(const bf16x8*)(brow + ks * 32);
            acc = __builtin_amdgcn_mfma_f32_16x16x32_bf16(a, bv, acc, 0, 0, 0);
        }
        float bias = 0.f;
#pragma unroll
        for (int pt = 0; pt < 16; ++pt) bias += ((const float*)(ws + OFF_CBIAS))[(which * 16 + pt) * 128 + wave * 16 + fr];
#pragma unroll
        for (int r = 0; r < 4; ++r) hid[(4 * fq + r) * 132 + wave * 16 + fr] = gelu_tanh(acc[r] + bias);
        __syncthreads();
        {
            const int row = tid >> 5, d = tid & 31;
            float o1 = 0.f, o2 = 0.f;
#pragma unroll 8
            for (int c = 0; c < 128; ++c) { const float hv = hid[row * 132 + c]; o1 += hv * w2s[c * 64 + d]; o2 += hv * w2s[c * 64 + 32 + d]; }
            const int n = n0 + row; const bool valid = n < NCMP;
            if (which == 0) {
                const int* positions = (const int*)INP(1);
                const int nn = valid ? n : NCMP - 1;
                float ps = 0.f;
#pragma unroll
                for (int t = 0; t < 32; ++t) ps += (float)positions[b * SEQ + 16 * nn + t];
                const float posm = ps * (1.f / 32.f);
                const float inv = powf(10000.f, -(float)d * (1.f / 32.f));
                float sn, cs; sincosf(posm * inv, &sn, &cs);
                bf16_t* dst = (bf16_t*)(ws + OFF_KC) + ((size_t)bk * 512 + n) * 64;
                dst[d] = valid ? (bf16_t)f2bf(o1 * cs - o2 * sn) : (bf16_t)0;
                dst[32 + d] = valid ? (bf16_t)f2bf(o2 * cs + o1 * sn) : (bf16_t)0;
            } else {
                const int pos = 32 * (n >> 5) + vperm32(n & 31);
                bf16_t* dst = (bf16_t*)(ws + OFF_VCT) + (size_t)bk * 64 * 512 + pos;
                dst[(size_t)d * 512] = valid ? (bf16_t)f2bf(o1) : (bf16_t)0;
                dst[(size_t)(d + 32) * 512] = valid ? (bf16_t)f2bf(o2) : (bf16_t)0;
            }
        }
        __syncthreads();
    }
}
__device__ __forceinline__ bf16x8 pack_p(const f32x4 a, const f32x4 b) {
    u32x4 w; w.x = cvt_pk_bf16(a[0], a[1]); w.y = cvt_pk_bf16(a[2], a[3]); w.z = cvt_pk_bf16(b[0], b[1]); w.w = cvt_pk_bf16(b[2], b[3]);
    return __builtin_bit_cast(bf16x8, w);
}
__device__ __forceinline__ f32x4 mfma16(const bf16x8 a, const bf16x8 b, const f32x4 c) { return __builtin_amdgcn_mfma_f32_16x16x32_bf16(a, b, c, 0, 0, 0); }
#define ZERO4 ((f32x4){0.f, 0.f, 0.f, 0.f})
__device__ __forceinline__ float xq_max(float x) {
    float a = x, b = x; swap16(a, b); float y = fmaxf(a, b);
    a = y; b = y; swap32(a, b); return fmaxf(a, b);
}
__device__ __forceinline__ float xq_sum(float x) {
    float a = x, b = x; swap16(a, b); float y = a + b;
    a = y; b = y; swap32(a, b); return a + b;
}
__device__ __forceinline__ float oct_sum(float x) {
    x += __builtin_bit_cast(float, __builtin_amdgcn_update_dpp(0, __builtin_bit_cast(int, x), 0xB1, 0xf, 0xf, false));
    x += __builtin_bit_cast(float, __builtin_amdgcn_update_dpp(0, __builtin_bit_cast(int, x), 0x4E, 0xf, 0xf, false));
    x += __builtin_bit_cast(float, __builtin_amdgcn_update_dpp(0, __builtin_bit_cast(int, x), 0x141, 0xf, 0xf, false));
    return x;
}
__device__ __forceinline__ unsigned wave_umax(unsigned x) {
    unsigned t;
    t = (unsigned)__builtin_amdgcn_update_dpp(0, (int)x, 0xB1, 0xf, 0xf, false); x = t > x ? t : x;
    t = (unsigned)__builtin_amdgcn_update_dpp(0, (int)x, 0x4E, 0xf, 0xf, false); x = t > x ? t : x;
    t = (unsigned)__builtin_amdgcn_update_dpp(0, (int)x, 0x141, 0xf, 0xf, false); x = t > x ? t : x;
    t = (unsigned)__builtin_amdgcn_update_dpp(0, (int)x, 0x140, 0xf, 0xf, false); x = t > x ? t : x;
    const unsigned a = __builtin_amdgcn_readlane(x, 0), b = __builtin_amdgcn_readlane(x, 16), c = __builtin_amdgcn_readlane(x, 32), d = __builtin_amdgcn_readlane(x, 48);
    const unsigned ab = a > b ? a : b, cd = c > d ? c : d; return ab > cd ? ab : cd;
}
__device__ __forceinline__ int swz128(int row, int ch) { return row * 128 + ((ch ^ ((row >> 1) & 7)) << 4); }
__device__ __forceinline__ int swz1024(int row, int ch) { return row * 1024 + ((ch ^ (row & 15)) << 4); }

constexpr int CMP_LDS_K = 0, CMP_LDS_V = 65536, CMP_LDS_IMP = 131072, CMP_LDS_SC = 131072 + 8192;
__device__ __forceinline__ void nsa_cmp_stage(const Params& p, LAS unsigned char* lds, int bk) {
    const int tid = opqv(threadIdx.x);
    const u32x4* kc = (const u32x4*)(opqp(p.ws) + OFF_KC) + (size_t)bk * 4096;
    const u32x4* vc = (const u32x4*)(opqp(p.ws) + OFF_VCT) + (size_t)bk * 4096;
    for (int i = tid; i < 4096; i += NTHREADS) {
        *(LAS u32x4*)(lds + CMP_LDS_K + swz128(i >> 3, i & 7)) = kc[i];
        *(LAS u32x4*)(lds + CMP_LDS_V + swz1024(i >> 6, i & 63)) = vc[i];
    }
}
__device__ __forceinline__ void nsa_cmp_unit(const Params& p, LAS unsigned char* lds, int bk, int qt) {
    const int tid = opqv(threadIdx.x), lane = tid & 63, wave = __builtin_amdgcn_readfirstlane(tid >> 6);
    const int qrow = lane & 15, q = lane >> 4, b = bk >> 1, kvh = bk & 1;
    unsigned char* ws = opqp(p.ws);
    const int t0 = qt * 16 + wave * 2, tok = t0 + (qrow >> 3), head = kvh * 8 + (qrow & 7);
    const bf16_t* qp = (const bf16_t*)(ws + OFF_QR) + (size_t)(b * SEQ + tok) * 1024 + head * 64 + 8 * q;
    const bf16x8 qf0 = *(const bf16x8*)qp, qf1 = *(const bf16x8*)(qp + 32);
    const float gate = ((const float*)(ws + OFF_GATES))[(size_t)(b * SEQ + tok) * 48 + head * 3 + 0];
    const int nv = tok >= 31 ? ((tok - 31) >> 4) + 1 : 0;
    const int nvmax = (t0 + 1) >= 31 ? ((t0 + 1 - 31) >> 4) + 1 : 0;
    const int NBk = (nvmax + 15) >> 4;
    f32x4 S[32];
#pragma unroll
    for (int jb = 0; jb < 32; ++jb) {
        S[jb] = ZERO4;
        if (jb < NBk) {
            const bf16x8 a0 = *(const LAS bf16x8*)(lds + CMP_LDS_K + swz128(16 * jb + qrow, q)), a1 = *(const LAS bf16x8*)(lds + CMP_LDS_K + swz128(16 * jb + qrow, 4 + q));
            S[jb] = mfma16(a1, qf1, mfma16(a0, qf0, ZERO4));
        }
        if ((jb & 3) == 3) __builtin_amdgcn_sched_barrier(0);
    }
    float m = -1e30f;
    int c0 = opqv(4 * q), c1 = opqv(4 * q + 1), c2 = opqv(4 * q + 2), c3 = opqv(4 * q + 3);
    const int cr[4] = {c0, c1, c2, c3};
    const int nv0 = t0 >= 31 ? ((t0 - 31) >> 4) + 1 : 0;
#pragma unroll
    for (int jb = 0; jb < 32; ++jb) if (jb < NBk) {
        if (16 * jb + 16 > nv0) {
            const int rem = nv - 16 * jb;
#pragma unroll
            for (int r = 0; r < 4; ++r) S[jb][r] = (cr[r] < rem) ? S[jb][r] : -1e30f;
        }
        m = fmaxf(m, fmaxf(fmaxf(S[jb][0], S[jb][1]), fmaxf(S[jb][2], S[jb][3])));
        if ((jb & 7) == 7) __builtin_amdgcn_sched_barrier(0);
    }
    m = xq_max(m);
    float l = 0.f;
    constexpr float L2E = 1.4426950408889634f;
#pragma unroll
    for (int jb = 0; jb < 32; ++jb) if (jb < NBk) {
#pragma unroll
        for (int r = 0; r < 4; ++r) { const float e = __builtin_amdgcn_exp2f((S[jb][r] - m) * L2E); S[jb][r] = e; l += e; }
        if ((jb & 3) == 3) __builtin_amdgcn_sched_barrier(0);
    }
    l = xq_sum(l);
    const float linv = (l > 0.f && nv > 0) ? 1.f / l : 0.f;
#pragma unroll
    for (int jb = 0; jb < 32; ++jb) if (jb < NBk) S[jb] = S[jb] * linv;
    LAS float* impL = (LAS float*)(lds + CMP_LDS_IMP + wave * 1024);
#pragma unroll
    for (int jb = 0; jb < 32; ++jb) {
        const float rs = (S[jb][0] + S[jb][1]) + (S[jb][2] + S[jb][3]);
        const float prev3 = jb > 0 ? S[jb > 0 ? jb - 1 : 0][3] : 0.f;
        const float prov = (q == 3) ? prev3 : S[jb][3];
        const float nbv = __shfl(prov, (lane - 16) & 63);
        float im = rs + nbv;
        im = oct_sum(im);
        if ((lane & 7) == 0) impL[(qrow >> 3) * 128 + 4 * jb + q] = im;
        if ((jb & 3) == 3) __builtin_amdgcn_sched_barrier(0);
    }
    LDS_WAIT();
    int* selo = (int*)(ws + OFF_SEL);
#pragma unroll 1
    for (int tk = 0; tk < 2; ++tk) {
        const int tokn = t0 + tk, cur = tokn >> 6;
        const int sa = lane, sb = lane + 64;
        const bool fa = (sa == 0) | (sa == cur) | (sa == cur - 1), fb = (sb == cur) | (sb == cur - 1);
        const float ia = impL[tk * 128 + sa], ib = impL[tk * 128 + sb];
        unsigned ka = (!fa && sa <= cur) ? (0x80000000u | ((__builtin_bit_cast(unsigned, ia) >> 8) << 7) | (unsigned)(127 - sa)) : 0u;
        unsigned kb = (!fb && sb <= cur) ? (0x80000000u | ((__builtin_bit_cast(unsigned, ib) >> 8) << 7) | (unsigned)(127 - sb)) : 0u;
        int* so = selo + ((size_t)bk * SEQ + tokn) * 16;
        int nf = 1;
        if (lane == 0) { so[0] = 0; if (cur >= 2) { so[1] = cur - 1; so[2] = cur; } else if (cur == 1) so[1] = 1; }
        nf = cur >= 2 ? 3 : (cur == 1 ? 2 : 1);
#pragma unroll 1
        for (int r = nf; r < 16; ++r) {
            const unsigned k = wave_umax(ka > kb ? ka : kb);
            if (k == 0u) { if (lane == 0) so[r] = 127; continue; }
            if (ka == k) ka = 0u;
            if (kb == k) kb = 0u;
            if (lane == 0) so[r] = 127 - (int)(k & 127u);
        }
    }
    f32x4 O[4] = {ZERO4, ZERO4, ZERO4, ZERO4};
#pragma unroll
    for (int s32 = 0; s32 < 16; ++s32) if (2 * s32 < NBk) {
        const bf16x8 pb = pack_p(S[2 * s32], S[2 * s32 + 1]);
#pragma unroll
        for (int dg = 0; dg < 4; ++dg) { const bf16x8 va = *(const LAS bf16x8*)(lds + CMP_LDS_V + swz1024(16 * dg + qrow, 4 * s32 + q)); O[dg] = mfma16(va, pb, O[dg]); }
    }
    bf16_t* yo = (bf16_t*)(ws + OFF_SLOT64) + (size_t)(b * SEQ + tok) * 1024 + head * 64 + 4 * q;
#pragma unroll
    for (int dg = 0; dg < 4; ++dg) *(u32x2*)(yo + 16 * dg) = (u32x2){pk2(O[dg][0] * gate, O[dg][1] * gate), pk2(O[dg][2] * gate, O[dg][3] * gate)};
}

__device__ __forceinline__ void nsa_win_unit(const Params& p, LAS unsigned char* lds, int bk, int kb64) {
    const int tid = opqv(threadIdx.x), lane = tid & 63, wave = __builtin_amdgcn_readfirstlane(tid >> 6);
    const int qrow = lane & 15, q = lane >> 4, b = bk >> 1, kvh = bk & 1;
    unsigned char* ws = opqp(p.ws);
    const int t0 = kb64 * 64, kt_lo = kb64 > 8 ? kb64 - 8 : 0, ntile = kb64 - kt_lo + 1;
    const u32x4* Kg = (const u32x4*)(ws + OFF_KWIN) + (size_t)bk * SEQ * 8 + (size_t)kt_lo * 512;
    const u32x4* Vg = (const u32x4*)(ws + OFF_VWINT) + (size_t)bk * 128 * 512 + (size_t)kt_lo * 512;
    bf16x8 qv0[4], qv1[4]; float gv[4];
#pragma unroll
    for (int ss = 0; ss < 4; ++ss) {
        const int tok = t0 + 16 * ss + wave * 2 + (qrow >> 3), head = kvh * 8 + (qrow & 7);
        const bf16_t* qp = (const bf16_t*)(ws + OFF_QR) + (size_t)(b * SEQ + tok) * 1024 + head * 64 + 8 * q;
        qv0[ss] = *(const bf16x8*)qp; qv1[ss] = *(const bf16x8*)(qp + 32);
        gv[ss] = ((const float*)(ws + OFF_GATES))[(size_t)(b * SEQ + tok) * 48 + head * 3 + 2];
    }
    __syncthreads();
    for (int i = 0; i < ntile; ++i) {
        *(LAS u32x4*)(lds + i * 16384 + swz128(tid >> 3, tid & 7)) = Kg[(size_t)i * 512 + tid];
        *(LAS u32x4*)(lds + i * 16384 + 8192 + swz128(tid >> 3, tid & 7)) = Vg[(size_t)i * 512 + tid];
    }
    __syncthreads();
#pragma unroll
    for (int ss = 0; ss < 4; ++ss) {
        const int tok = t0 + 16 * ss + wave * 2 + (qrow >> 3), head = kvh * 8 + (qrow & 7);
        const bf16x8 qf0 = qv0[ss], qf1 = qv1[ss];
        float m_run = -1e30f, l_run = 0.f;
        f32x4 O[4] = {ZERO4, ZERO4, ZERO4, ZERO4};
#pragma unroll 1
        for (int i = 0; i < ntile; ++i) {
            const int kt = kt_lo + i;
            LAS unsigned char* kl = lds + i * 16384; LAS unsigned char* vl = kl + 8192;
            f32x4 S[4]; float mt = -1e30f;
#pragma unroll
            for (int kb = 0; kb < 4; ++kb) {
                const bf16x8 a0 = *(const LAS bf16x8*)(kl + swz128(16 * kb + qrow, q)), a1 = *(const LAS bf16x8*)(kl + swz128(16 * kb + qrow, 4 + q));
                S[kb] = mfma16(a1, qf1, mfma16(a0, qf0, ZERO4));
            }
            if (kt == kb64 || kt + 8 <= kb64) {
#pragma unroll
                for (int kb = 0; kb < 4; ++kb)
#pragma unroll
                    for (int r = 0; r < 4; ++r) { const int kp = kt * 64 + 16 * kb + 4 * q + r; const bool ok = (kp <= tok) & (kp > tok - WINDOW); S[kb][r] = ok ? S[kb][r] : -1e30f; }
            }
#pragma unroll
            for (int kb = 0; kb < 4; ++kb) mt = fmaxf(mt, fmaxf(fmaxf(S[kb][0], S[kb][1]), fmaxf(S[kb][2], S[kb][3])));
            mt = xq_max(mt);
            constexpr float L2E = 1.4426950408889634f;
            const float m_new = fmaxf(m_run, mt), alpha = __builtin_amdgcn_exp2f((m_run - m_new) * L2E);
            float ls = 0.f;
            if (m_new > -1e29f) {
#pragma unroll
                for (int kb = 0; kb < 4; ++kb)
#pragma unroll
                    for (int r = 0; r < 4; ++r) { const float e = __builtin_amdgcn_exp2f((S[kb][r] - m_new) * L2E); S[kb][r] = e; ls += e; }
            } else {
#pragma unroll
                for (int kb = 0; kb < 4; ++kb) S[kb] = ZERO4;
            }
            l_run = l_run * alpha + ls; m_run = m_new;
#pragma unroll
            for (int dg = 0; dg < 4; ++dg) O[dg] = O[dg] * alpha;
#pragma unroll
            for (int s32 = 0; s32 < 2; ++s32) {
                const bf16x8 pb = pack_p(S[2 * s32], S[2 * s32 + 1]);
#pragma unroll
                for (int dg = 0; dg < 4; ++dg) { const bf16x8 va = *(const LAS bf16x8*)(vl + swz128(16 * dg + qrow, 4 * s32 + q)); O[dg] = mfma16(va, pb, O[dg]); }
            }
        }
        l_run = xq_sum(l_run);
        const float gate = gv[ss];
        const float sc = l_run > 0.f ? gate / l_run : 0.f;
        bf16_t* yo = (bf16_t*)(ws + OFF_SLOT64) + (size_t)T_TOK * 1024 + (size_t)(b * SEQ + tok) * 1024 + head * 64 + 4 * q;
#pragma unroll
        for (int dg = 0; dg < 4; ++dg) *(u32x2*)(yo + 16 * dg) = (u32x2){pk2(O[dg][0] * sc, O[dg][1] * sc), pk2(O[dg][2] * sc, O[dg][3] * sc)};
    }
}

typedef long l2 __attribute__((ext_vector_type(2)));
__device__ __forceinline__ f32x4 mfma8(long a, long b, const f32x4 c) { return __builtin_amdgcn_mfma_f32_16x16x32_fp8_fp8(a, b, c, 0, 0, 0); }
__device__ __forceinline__ long pack_p8(const f32x4 a, const f32x4 b) { const unsigned lo = pk4_fp8(a[0], a[1], a[2], a[3]), hi = pk4_fp8(b[0], b[1], b[2], b[3]); return (long)(((unsigned long long)hi << 32) | lo); }
__device__ __forceinline__ void sel_ld(l2 (&d)[4], const char* gblk, int lane) {
    const GAS l2* src = (const GAS l2*)(unsigned long long)gblk + lane;
#pragma unroll
    for (int i = 0; i < 4; ++i) d[i] = src[64 * i];
}
__device__ __forceinline__ void sel_iter(l2 (&kA)[4], l2 (&kB)[4], l2 (&vA)[4], l2 (&vB)[4], const long (&qA)[2], const long (&qB)[2], f32x4 (&O)[4], float& m_run, float& l_run,
                                         int s0, int s1, int sn0, int sn1, const char* Kg, const char* Vg, int cur, int tokm, bool lo, int q, int lane) {
    constexpr float SC = 0.125f * 1.4426950408889634f;
    f32x4 S[4];
#pragma unroll
    for (int kb = 0; kb < 4; ++kb) S[kb] = mfma8(kA[kb][0], qA[0], ZERO4);
#pragma unroll
    for (int kb = 0; kb < 4; ++kb) S[kb] = mfma8(kA[kb][1], qA[1], S[kb]);
#pragma unroll
    for (int kb = 0; kb < 4; ++kb) S[kb] = mfma8(kB[kb][0], qB[0], S[kb]);
#pragma unroll
    for (int kb = 0; kb < 4; ++kb) S[kb] = mfma8(kB[kb][1], qB[1], S[kb]);
    __builtin_amdgcn_sched_barrier(0);
    sel_ld(kA, Kg + (size_t)sn0 * 4096, lane); sel_ld(kB, Kg + (size_t)sn1 * 4096, lane);
    __builtin_amdgcn_sched_barrier(0);
    if (s0 == cur || s1 == cur) {
        const int lim = tokm - (lo ? s0 : s1) * 64 - 4 * q;
#pragma unroll
        for (int kb = 0; kb < 4; ++kb)
#pragma unroll
            for (int r = 0; r < 4; ++r) S[kb][r] = (16 * kb + r <= lim) ? S[kb][r] : -1e30f;
    }
    float mt = -1e30f;
#pragma unroll
    for (int kb = 0; kb < 4; ++kb) mt = fmaxf(mt, fmaxf(fmaxf(S[kb][0], S[kb][1]), fmaxf(S[kb][2], S[kb][3])));
    mt = xq_max(mt);
    const float m_new = fmaxf(m_run, mt), alpha = __builtin_amdgcn_exp2f((m_run - m_new) * SC);
    const float mb = m_new * SC;
    float ls = 0.f;
#pragma unroll
    for (int kb = 0; kb < 4; ++kb)
#pragma unroll
        for (int r = 0; r < 4; ++r) { const float e = __builtin_amdgcn_exp2f(S[kb][r] * SC - mb); S[kb][r] = e; ls += e; }
    l_run = l_run * alpha + ls; m_run = m_new;
#pragma unroll
    for (int dg = 0; dg < 4; ++dg) O[dg] = O[dg] * alpha;
    const long pb0 = pack_p8(S[0], S[1]), pb1 = pack_p8(S[2], S[3]);
    const long pA0 = lo ? pb0 : 0l, pA1 = lo ? pb1 : 0l, pB0 = lo ? 0l : pb0, pB1 = lo ? 0l : pb1;
#pragma unroll
    for (int dg = 0; dg < 4; ++dg) O[dg] = mfma8(vA[dg][0], pA0, O[dg]);
#pragma unroll
    for (int dg = 0; dg < 4; ++dg) O[dg] = mfma8(vA[dg][1], pA1, O[dg]);
#pragma unroll
    for (int dg = 0; dg < 4; ++dg) O[dg] = mfma8(vB[dg][0], pB0, O[dg]);
#pragma unroll
    for (int dg = 0; dg < 4; ++dg) O[dg] = mfma8(vB[dg][1], pB1, O[dg]);
    __builtin_amdgcn_sched_barrier(0);
    sel_ld(vA, Vg + (size_t)sn0 * 4096, lane); sel_ld(vB, Vg + (size_t)sn1 * 4096, lane);
    __builtin_amdgcn_sched_barrier(0);
}
struct SelTask { int bk, tok0, b, kvh, cur, nval; const char* Kg; const char* Vg; };
__device__ __forceinline__ SelTask sel_task(unsigned char* ws, int task) {
    SelTask t; t.bk = task / (SEQ / 2); t.tok0 = (task % (SEQ / 2)) * 2; t.b = t.bk >> 1; t.kvh = t.bk & 1; t.cur = t.tok0 >> 6; t.nval = t.cur + 1 < 16 ? t.cur + 1 : 16;
    t.Kg = (const char*)(ws + OFF_KSEL) + (size_t)t.bk * SEQ * 64; t.Vg = (const char*)(ws + OFF_VSELT) + (size_t)t.bk * 128 * 4096;
    return t;
}
struct SelOps { long q0, q1; int l0, l1; };
__device__ __forceinline__ SelOps sel_ops(unsigned char* ws, const SelTask& t, int lane) {
    const int qrow = lane & 15, q = lane >> 4;
    const GAS int* selg = (const GAS int*)(unsigned long long)(ws + OFF_SEL);
    const GAS unsigned char* qp = (const GAS unsigned char*)(unsigned long long)(ws + OFF_Q8) + (size_t)(t.b * SEQ + t.tok0 + (qrow >> 3)) * 1024 + (t.kvh * 8 + (qrow & 7)) * 64 + 8 * q;
    SelOps o; o.q0 = *(const GAS long*)qp; o.q1 = *(const GAS long*)(qp + 32);
    o.l0 = selg[((size_t)t.bk * SEQ + t.tok0) * 16 + qrow]; o.l1 = selg[((size_t)t.bk * SEQ + t.tok0 + 1) * 16 + qrow];
    return o;
}
__device__ __forceinline__ void nsa_sel_phase(const Params& p, LAS unsigned char* lds, int vcu, int G) {
    const int tid = opqv(threadIdx.x), lane = tid & 63, wave = __builtin_amdgcn_readfirstlane(tid >> 6);
    const int gw = vcu * NWAVES + wave, NGW = G * NWAVES;
    const int qrow = lane & 15, q = lane >> 4;
    const bool lo = qrow < 8;
    unsigned char* ws = opqp(p.ws);
    l2 kA0[4], kB0[4], vA0[4], vB0[4], kA1[4], kB1[4], vA1[4], vB1[4];
    SelOps oc = {0l, 0l, 0, 0}, on = {0l, 0l, 0, 0};
    if (gw < 2 * SEQ) oc = sel_ops(ws, sel_task(ws, gw), lane);
    if (gw + NGW < 2 * SEQ) on = sel_ops(ws, sel_task(ws, gw + NGW), lane);
    asm volatile("" : "+v"(oc.q0), "+v"(oc.q1), "+v"(oc.l0), "+v"(oc.l1), "+v"(on.q0), "+v"(on.q1), "+v"(on.l0), "+v"(on.l1));
    bool have = false;
    for (int task = gw; task < 2 * SEQ; task += NGW) {
        const SelTask t = sel_task(ws, task);
        const int tok0 = t.tok0, b = t.b, head = t.kvh * 8 + (qrow & 7), cur = t.cur, nval = t.nval;
        const int tokm = tok0 + (qrow >> 3);
        const char* Kg = t.Kg; const char* Vg = t.Vg;
        long qA[2], qB[2];
        qA[0] = lo ? oc.q0 : 0l; qA[1] = lo ? oc.q1 : 0l; qB[0] = lo ? 0l : oc.q0; qB[1] = lo ? 0l : oc.q1;
        const int taskN = task + NGW; const bool hasN = taskN < 2 * SEQ;
        const SelTask tn = sel_task(ws, hasN ? taskN : task);
        const bool chain = hasN && nval == 16 && tn.nval == 16;
        const float gate = ((const GAS float*)(unsigned long long)(ws + OFF_GATES))[(size_t)(b * SEQ + tokm) * 48 + head * 3 + 1];
        u32x2 cv[4], wv[4];
        {
            const GAS bf16_t* yc = (const GAS bf16_t*)(unsigned long long)(ws + OFF_SLOT64) + (size_t)(b * SEQ + tokm) * 1024 + head * 64 + 4 * q; const GAS bf16_t* yw = yc + (size_t)T_TOK * 1024;
#pragma unroll
            for (int dg = 0; dg < 4; ++dg) { cv[dg] = *(const GAS u32x2*)(yc + 16 * dg); wv[dg] = *(const GAS u32x2*)(yw + 16 * dg); }
        }
        const int selv0 = (lane & 16) ? on.l0 : oc.l0, selv1 = (lane & 16) ? on.l1 : oc.l1;
        if (!have) {
            const int a0 = __builtin_amdgcn_readlane(selv0, 0), a1 = __builtin_amdgcn_readlane(selv1, 0);
            const int j1 = nval > 1 ? 1 : 0;
            const int c0 = __builtin_amdgcn_readlane(selv0, j1), c1 = __builtin_amdgcn_readlane(selv1, j1);
            __builtin_amdgcn_sched_barrier(0);
            sel_ld(kA0, Kg + (size_t)a0 * 4096, lane); sel_ld(kB0, Kg + (size_t)a1 * 4096, lane);
            __builtin_amdgcn_sched_barrier(0);
            sel_ld(vA0, Vg + (size_t)a0 * 4096, lane); sel_ld(vB0, Vg + (size_t)a1 * 4096, lane);
            __builtin_amdgcn_sched_barrier(0);
            sel_ld(kA1, Kg + (size_t)c0 * 4096, lane); sel_ld(kB1, Kg + (size_t)c1 * 4096, lane);
            __builtin_amdgcn_sched_barrier(0);
            sel_ld(vA1, Vg + (size_t)c0 * 4096, lane); sel_ld(vB1, Vg + (size_t)c1 * 4096, lane);
            __builtin_amdgcn_sched_barrier(0);
        }
        float m_run = -1e30f, l_run = 0.f;
        f32x4 O[4] = {ZERO4, ZERO4, ZERO4, ZERO4};
        int j = 0;
#pragma unroll 1
        for (; j + 1 < nval; j += 2) {
            const bool in0 = j + 2 < nval, in1 = j + 3 < nval;
            const bool nx0 = !in0 && chain, nx1 = !in1 && chain;
            const int jn0 = in0 ? j + 2 : (chain ? 16 + j + 2 - nval : nval - 1), jn1 = in1 ? j + 3 : (chain ? 16 + j + 3 - nval : nval - 1);
            sel_iter(kA0, kB0, vA0, vB0, qA, qB, O, m_run, l_run, __builtin_amdgcn_readlane(selv0, j), __builtin_amdgcn_readlane(selv1, j),
                     __builtin_amdgcn_readlane(selv0, jn0), __builtin_amdgcn_readlane(selv1, jn0), nx0 ? tn.Kg : Kg, nx0 ? tn.Vg : Vg, cur, tokm, lo, q, lane);
            sel_iter(kA1, kB1, vA1, vB1, qA, qB, O, m_run, l_run, __builtin_amdgcn_readlane(selv0, j + 1), __builtin_amdgcn_readlane(selv1, j + 1),
                     __builtin_amdgcn_readlane(selv0, jn1), __builtin_amdgcn_readlane(selv1, jn1), nx1 ? tn.Kg : Kg, nx1 ? tn.Vg : Vg, cur, tokm, lo, q, lane);
        }
        if (j < nval) {
            const int sl0 = __builtin_amdgcn_readlane(selv0, j), sl1 = __builtin_amdgcn_readlane(selv1, j);
            sel_iter(kA0, kB0, vA0, vB0, qA, qB, O, m_run, l_run, sl0, sl1, sl0, sl1, Kg, Vg, cur, tokm, lo, q, lane);
        }
        SelOps onn = {0l, 0l, 0, 0};
        if (taskN + NGW < 2 * SEQ) onn = sel_ops(ws, sel_task(ws, taskN + NGW), lane);
        {
            const float lr = xq_sum(l_run);
            const float sc = lr > 0.f ? gate / lr : 0.f;
            GAS unsigned char* mo = (GAS unsigned char*)(unsigned long long)(ws + OFF_MIXIN) + (size_t)(b * SEQ + tokm) * 2048 + 1024 + head * 64 + 4 * q;
#pragma unroll
            for (int dg = 0; dg < 4; ++dg) {
                const u32x2 c = cv[dg], w = wv[dg];
                const float o0 = O[dg][0] * sc + bflo(c.x) + bflo(w.x), o1 = O[dg][1] * sc + bfhi(c.x) + bfhi(w.x), o2 = O[dg][2] * sc + bflo(c.y) + bflo(w.y), o3 = O[dg][3] * sc + bfhi(c.y) + bfhi(w.y);
                *(GAS unsigned*)(mo + 16 * dg) = pk4_fp8(o0 * MIX8_SCALE, o1 * MIX8_SCALE, o2 * MIX8_SCALE, o3 * MIX8_SCALE);
            }
        }
        asm volatile("" : "+v"(onn.q0), "+v"(onn.q1), "+v"(onn.l0), "+v"(onn.l1));
        have = chain; oc = on; on = onn;
    }
}
__device__ __forceinline__ float rl(float v, int l) { return __builtin_bit_cast(float, __builtin_amdgcn_readlane(__builtin_bit_cast(int, v), l)); }

__device__ __forceinline__ void route_token(const Params& p, unsigned char* ws, int t, float logit, float rb, int lane) {
    unsigned* cnt = (unsigned*)(ws + OFF_CTL);
    int* ltok = (int*)(ws + OFF_LTOK); float* lw = (float*)(ws + OFF_LW); int* lslot = (int*)(ws + OFF_LSLOT);
    const float affin = sigmoidf_(logit);
    const float biased = affin + rb;
    float m1 = biased; m1 = fmaxf(m1, __shfl_xor(m1, 1)); m1 = fmaxf(m1, __shfl_xor(m1, 2)); m1 = fmaxf(m1, __shfl_xor(m1, 4));
    const unsigned long long bal = __ballot(biased == m1);
    const unsigned grpbits = (unsigned)((bal >> (lane & ~7)) & 0xffull);
    const int first = (lane & ~7) + __builtin_ctz(grpbits);
    float m2 = (lane == first) ? -3e38f : biased; m2 = fmaxf(m2, __shfl_xor(m2, 1)); m2 = fmaxf(m2, __shfl_xor(m2, 2)); m2 = fmaxf(m2, __shfl_xor(m2, 4));
    const float gs = m1 + m2; const int myg = lane >> 3;
    int grank = 0;
#pragma unroll
    for (int gg = 0; gg < 8; ++gg) { const float og = rl(gs, 8 * gg); grank += (og > gs) | ((og == gs) & (gg < myg)); }
    const float mv = grank < 4 ? biased : -1e30f;
    int er = 0;
#pragma unroll
    for (int e2 = 0; e2 < 64; ++e2) { const float o = rl(mv, e2); er += (o > mv) | ((o == mv) & (e2 < lane)); }
    const bool sel = er < TOPK_E;
    const float wsum = wave_sum(sel ? affin : 0.f);
    if (sel) {
        const unsigned pos = atomicAdd(&cnt[lane], 1u);
        const size_t li = (size_t)lane * LISTCAP + pos;
        ltok[li] = t; lw[li] = affin / wsum * 2.5f; lslot[li] = t * NSLOT + er;
    }
    if (lane == 0) { const size_t li = (size_t)NEXP * LISTCAP + t; ltok[li] = t; lw[li] = 1.f; lslot[li] = t * NSLOT + TOPK_E; }
}

constexpr int RT_ROWB = 4096 + 16, RT_PART = 16 * RT_ROWB;
template <bool ROUTE>
__device__ __forceinline__ void ln1_route_phase(const Params& p, LAS unsigned char* lds, int vcu, int G) {
    const int tid = opqv(threadIdx.x), lane = tid & 63, wave = __builtin_amdgcn_readfirstlane(tid >> 6);
    unsigned char* ws = opqp(p.ws);
    const bf16_t* x1 = (const bf16_t*)(ws + OFF_X1);
    const float* g1 = INP(19); const float* b1 = INP(20);
    const float rb = INP(22)[lane];
    const bf16_t* WrT = (const bf16_t*)(ws + OFF_WRT);
    LAS float* part = (LAS float*)(lds + RT_PART);
    bf16x8 wfr[8][4];
    {
        const int fr = lane & 15, q = lane >> 4;
#pragma unroll
        for (int k8 = 0; k8 < 8; ++k8)
#pragma unroll
            for (int nb = 0; nb < 4; ++nb) wfr[k8][nb] = *(const bf16x8*)(WrT + (size_t)(16 * nb + fr) * DM + 256 * wave + 32 * k8 + 8 * q);
    }
    for (int tile = vcu; tile < T_TOK / 16; tile += G) {
        const int r0 = tile * 16;
#pragma unroll
        for (int rr = 0; rr < 2; ++rr) {
            const int rl_ = 2 * wave + rr; const size_t row = (size_t)(r0 + rl_);
            const u32x2* xr = (const u32x2*)(x1 + row * DM) + lane;
            f32x4 v[8]; float s = 0.f;
#pragma unroll
            for (int j = 0; j < 8; ++j) { const u32x2 w = xr[64 * j]; v[j] = (f32x4){bflo(w.x), bfhi(w.x), bflo(w.y), bfhi(w.y)}; s += (v[j].x + v[j].y) + (v[j].z + v[j].w); }
            const float mean = wave_sum(s) * (1.f / DM); float s2 = 0.f;
#pragma unroll
            for (int j = 0; j < 8; ++j) { v[j] = v[j] - mean; s2 += (v[j].x * v[j].x + v[j].y * v[j].y) + (v[j].z * v[j].z + v[j].w * v[j].w); }
            const float rstd = 1.f / sqrtf(wave_sum(s2) * (1.f / DM) + LN_EPS);
            const f32x4* gr = (const f32x4*)g1 + lane; const f32x4* br = (const f32x4*)b1 + lane;
            u32x2* o = (u32x2*)((bf16_t*)(ws + OFF_X1B) + row * DM) + lane; unsigned* oq = (unsigned*)(ws + OFF_X1Q + row * DM) + lane;
#pragma unroll
            for (int j = 0; j < 8; ++j) {
                const f32x4 r = v[j] * rstd * gr[64 * j] + br[64 * j]; const u32x2 rb2 = (u32x2){pk2(r.x, r.y), pk2(r.z, r.w)};
                o[64 * j] = rb2; oq[64 * j] = pk4_fp8(r.x, r.y, r.z, r.w);
                *(LAS u32x2*)(lds + rl_ * RT_ROWB + (64 * j + lane) * 8) = rb2;
            }
        }
        __syncthreads();
        {
            const int fr = lane & 15, q = lane >> 4;
            f32x4 acc[4] = {(f32x4){0.f, 0.f, 0.f, 0.f}, (f32x4){0.f, 0.f, 0.f, 0.f}, (f32x4){0.f, 0.f, 0.f, 0.f}, (f32x4){0.f, 0.f, 0.f, 0.f}};
#pragma unroll
            for (int k8 = 0; k8 < 8; ++k8) {
                const int k0 = 256 * wave + 32 * k8 + 8 * q;
                const bf16x8 a = *(const LAS bf16x8*)(lds + fr * RT_ROWB + k0 * 2);
#pragma unroll
                for (int nb = 0; nb < 4; ++nb) acc[nb] = __builtin_amdgcn_mfma_f32_16x16x32_bf16(a, wfr[k8][nb], acc[nb], 0, 0, 0);
            }
#pragma unroll
            for (int nb = 0; nb < 4; ++nb)
#pragma unroll
                for (int r = 0; r < 4; ++r) part[(wave * 16 + 4 * q + r) * 64 + 16 * nb + fr] = acc[nb][r];
        }
        __syncthreads();
#pragma unroll 1
        for (int rr = 0; rr < 2; ++rr) {
            const int rl_ = 2 * wave + rr;
            float lg = 0.f;
#pragma unroll
            for (int w = 0; w < 8; ++w) lg += part[(w * 16 + rl_) * 64 + lane];
            if (ROUTE) route_token(p, ws, r0 + rl_, lg, rb, lane); else asm volatile("" :: "v"(lg));
        }
        __syncthreads();
    }
}

constexpr int MOE_LDS = 131072;
__device__ __forceinline__ void moe_tables(const Params& p, LAS unsigned char* lds) {
    const int tid = opqv(threadIdx.x);
    LAS int* tstart = (LAS int*)(lds + MOE_LDS); LAS int* roff = (LAS int*)(lds + MOE_LDS + 272); LAS int* cn = (LAS int*)(lds + MOE_LDS + 544);
    if (tid < 64) {
        const int c = (int)__hip_atomic_load((unsigned*)(opqp(p.ws) + OFF_CTL) + tid, __ATOMIC_RELAXED, __HIP_MEMORY_SCOPE_AGENT);
        const int tl = (c + 255) >> 8;
        int st = tl, sr = c;
#pragma unroll
        for (int o = 1; o < 64; o <<= 1) { const int a = __shfl_up(st, o), b = __shfl_up(sr, o); if (tid >= o) { st += a; sr += b; } }
        cn[tid] = c; tstart[tid + 1] = st; roff[tid + 1] = sr;
        if (tid == 0) { tstart[0] = 0; roff[0] = 0; }
        if (tid == 63) { cn[64] = T_TOK; tstart[65] = st + T_TOK / 256; roff[65] = sr + T_TOK; }
    }
    __syncthreads();
}
__device__ __forceinline__ void MoeOrder_prefetch_impl(const int* ltok, const Unit& u, int parity, LAS unsigned char* lds);
__device__ __forceinline__ void MoeOrder_prefetch_sw(const int* lslot, const float* lw, const Unit& u, int parity, LAS unsigned char* lds);
constexpr int MOE_SW = MOE_LDS + 4096;
struct MoeOrder {
    LAS const int* tstart; LAS const int* roff; LAS const int* cn;
    int NT, nunits, G, c, K; const char* Bt; size_t bstride; const int* ltok; bool gather; const int* lslot = nullptr; const float* lw = nullptr;
    __device__ void init(LAS unsigned char* lds, int NT_, int K_, const void* Bt_, size_t bstride_, const int* ltok_, bool gather_, int G_, int c_) {
        tstart = (LAS const int*)(lds + MOE_LDS); roff = (LAS const int*)(lds + MOE_LDS + 272); cn = (LAS const int*)(lds + MOE_LDS + 544);
        NT = NT_; K = K_; Bt = (const char*)Bt_; bstride = bstride_; ltok = ltok_; gather = gather_; G = G_; c = c_; nunits = __builtin_amdgcn_readfirstlane(tstart[NEXPS] * NT_);
    }
    __device__ __forceinline__ bool next(int i, Unit& u) const {
        const int L = i * G + c; if (L >= nunits) return false;
        const int ti = L / NT, nt = L - ti * NT;
        int e = 0;
        if (ti >= tstart[NEXP]) e = NEXP;
        else {
#pragma unroll
            for (int s = 32; s >= 1; s >>= 1) { if (tstart[e + s] <= ti) e += s; }
        }
        e = __builtin_amdgcn_readfirstlane(e);
        const int mt = __builtin_amdgcn_readfirstlane(ti - tstart[e]);
        u.par = i % 3; u.e = e; u.pm = mt; u.pn = nt; u.nvalid = __builtin_amdgcn_readfirstlane(cn[e] - mt * 256); u.rowbase = __builtin_amdgcn_readfirstlane(roff[e] + mt * 256); u.bB = Bt + (size_t)e * bstride + (size_t)nt * 256 * K * 2; return true;
    }
    __device__ __forceinline__ void prefetch(const Unit& u, int parity, LAS unsigned char* lds) const { if (gather) MoeOrder_prefetch_impl(ltok, u, parity, lds); else if (lslot) MoeOrder_prefetch_sw(lslot, lw, u, u.par, lds); }
    __device__ __forceinline__ unsigned a_off_tab(const Unit& u, int h, int R, int C, int parity, LAS unsigned char* lds) const {
        if (!gather) return (unsigned)(((u.rowbase + h * 128 + R) * K + C) * 2);
        const int idx = *(const LAS int*)(lds + MOE_LDS + 1024 + parity * 1024 + (h * 128 + R) * 4); return (unsigned)((idx * K + C) * 2);
    }
    __device__ __forceinline__ unsigned a_off(const Unit& u, int h, int R, int C) const {
        const int r = h * 128 + R;
        if (gather) { const int tok = r < u.nvalid ? ltok[(size_t)u.e * LISTCAP + u.pm * 256 + r] : 0; return (unsigned)((tok * K + C) * 2); }
        return (unsigned)(((u.rowbase + r) * K + C) * 2);
    }
};
__device__ __forceinline__ void MoeOrder_prefetch_impl(const int* ltok, const Unit& u, int parity, LAS unsigned char* lds) {
    const int tid = threadIdx.x, wave = __builtin_amdgcn_readfirstlane(tid >> 6);
    if (wave < 4) {
        const int r = tid < u.nvalid ? tid : u.nvalid - 1;
        __builtin_amdgcn_global_load_lds((const unsigned*)(ltok + (size_t)u.e * LISTCAP + u.pm * 256 + r), (LAS unsigned*)(lds + MOE_LDS + 1024 + parity * 1024 + wave * 256), 4, 0, 0);
    }
}
__device__ __forceinline__ void MoeOrder_prefetch_sw(const int* lslot, const float* lw, const Unit& u, int parity, LAS unsigned char* lds) {
    const int tid = threadIdx.x, wave = __builtin_amdgcn_readfirstlane(tid >> 6), t = tid & 255;
    const int r = t < u.nvalid ? t : u.nvalid - 1;
    const size_t li = (size_t)u.e * LISTCAP + u.pm * 256 + r;
    const unsigned* src = wave < 4 ? (const unsigned*)(lslot + li) : (const unsigned*)(lw + li);
    __builtin_amdgcn_global_load_lds(src, (LAS unsigned*)(lds + MOE_SW + parity * 2048 + wave * 256), 4, 0, 0);
}
__device__ __forceinline__ float silu_mul(float g, float u) { return g * u * __builtin_amdgcn_rcpf(1.f + __expf(-g)); }
template <bool SHARED> struct EpiUp {
    static constexpr int PERM = 1; static constexpr bool AFTER_DRAIN = false;
    bf16_t* H; float* logits;
    __device__ __forceinline__ void operator()(const f32x4 (&acc)[2][2][4][2], const Unit& u, int wr, int wc, int fr, int fq) const {
        const int rbase = SHARED ? u.pm * 256 : u.rowbase;
        if (SHARED && u.pn == 4) {
            if (wc < 2) {
#pragma unroll
                for (int ai = 0; ai < 2; ++ai)
#pragma unroll
                    for (int m = 0; m < 4; ++m) { float* lp = logits + (size_t)(rbase + 128 * ai + 64 * wr + 16 * m + fr) * 64 + 32 * wc + 8 * fq;
                        *(f32x4*)lp = acc[ai][0][m][0]; *(f32x4*)(lp + 4) = acc[ai][0][m][1]; }
            }
            return;
        }
#pragma unroll
        for (int ai = 0; ai < 2; ++ai)
#pragma unroll
            for (int m = 0; m < 4; ++m) {
                const int r = 128 * ai + 64 * wr + 16 * m + fr;
                if (!SHARED) {
                    if (r < u.nvalid) {
                        constexpr float IS = 1.f / W8_SCALE;
                        const f32x4 g0 = acc[ai][0][m][0] * IS, g1 = acc[ai][0][m][1] * IS, u0 = acc[ai][1][m][0] * (IS * H8_SCALE), u1 = acc[ai][1][m][1] * (IS * H8_SCALE);
                        u32x2 w; w.x = pk4_fp8(silu_mul(g0[0], u0[0]), silu_mul(g0[1], u0[1]), silu_mul(g0[2], u0[2]), silu_mul(g0[3], u0[3]));
                        w.y = pk4_fp8(silu_mul(g1[0], u1[0]), silu_mul(g1[1], u1[1]), silu_mul(g1[2], u1[2]), silu_mul(g1[3], u1[3]));
                        *(u32x2*)((unsigned char*)H + (size_t)(rbase + r) * EFF + 128 * u.pn + 32 * wc + 8 * fq) = w;
                    }
                } else {
                    const f32x4 g0 = acc[ai][0][m][0], g1 = acc[ai][0][m][1], u0 = acc[ai][1][m][0], u1 = acc[ai][1][m][1];
                    u32x4 w; w.x = cvt_pk_bf16(silu_mul(g0[0], u0[0]), silu_mul(g0[1], u0[1])); w.y = cvt_pk_bf16(silu_mul(g0[2], u0[2]), silu_mul(g0[3], u0[3]));
                    w.z = cvt_pk_bf16(silu_mul(g1[0], u1[0]), silu_mul(g1[1], u1[1])); w.w = cvt_pk_bf16(silu_mul(g1[2], u1[2]), silu_mul(g1[3], u1[3]));
                    *(u32x4*)(H + (size_t)(rbase + r) * EFF + 128 * u.pn + 32 * wc + 8 * fq) = w;
                }
            }
    }
};
struct EpiMoeDown {
    static constexpr int PERM = 2; static constexpr bool AFTER_DRAIN = false;
    unsigned char* Y; LAS unsigned char* lds;
    __device__ __forceinline__ void operator()(const f32x4 (&acc)[2][2][4][2], const Unit& u, int wr, int wc, int fr, int fq) const {
        const int col0 = u.pn * 256 + wc * 64 + 16 * fq;
        const LAS int* st = (const LAS int*)(lds + MOE_SW + u.par * 2048) + 64 * wr + fr; const LAS float* wt = (const LAS float*)(st + 256);
        int slot[8]; float w[8];
#pragma unroll
        for (int i = 0; i < 8; ++i) { const int r = 128 * (i >> 2) + 16 * (i & 3); const bool ok = (r + 64 * wr + fr) < u.nvalid; slot[i] = ok ? st[r] : -1; w[i] = ok ? wt[r] * (SLOT_SCALE / (W8_SCALE * H8_SCALE)) : 0.f; }
#pragma unroll
        for (int ai = 0; ai < 2; ++ai)
#pragma unroll
            for (int m = 0; m < 4; ++m) {
                const int i = ai * 4 + m;
                if (slot[i] >= 0) {
                    const f32x4 a0 = acc[ai][0][m][0] * w[i], a1 = acc[ai][0][m][1] * w[i], b0 = acc[ai][1][m][0] * w[i], b1 = acc[ai][1][m][1] * w[i];
                    u32x4 o; o.x = pk4_fp8(a0[0], a0[1], a0[2], a0[3]); o.y = pk4_fp8(a1[0], a1[1], a1[2], a1[3]); o.z = pk4_fp8(b0[0], b0[1], b0[2], b0[3]); o.w = pk4_fp8(b1[0], b1[1], b1[2], b1[3]);
                    __builtin_nontemporal_store(o, (u32x4*)(Y + (size_t)slot[i] * DM + col0));
                }
            }
    }
};
struct EpiNull {
    static constexpr int PERM = 1; static constexpr bool AFTER_DRAIN = false;
    __device__ __forceinline__ void operator()(const f32x4 (&acc)[2][2][4][2], const Unit&, int, int, int, int) const {
#pragma unroll
        for (int ai = 0; ai < 2; ++ai)
#pragma unroll
            for (int bj = 0; bj < 2; ++bj)
#pragma unroll
                for (int mm = 0; mm < 4; ++mm)
#pragma unroll
                    for (int n = 0; n < 2; ++n) asm volatile("" :: "v"(acc[ai][bj][mm][n]));
    }
};
constexpr int XC_ALL = NEXPS * 3 * 256, XC0 = 0, XC1 = XC_ALL / 4, XC2 = XC1 + (XC_ALL * 35) / 100, XC3 = XC2 + XC_ALL / 4, XC4 = XC_ALL;
#ifndef PROBE_PH
#define PROBE_PH (-1)
#endif
__global__ void __launch_bounds__(NTHREADS, 2) mega_fwd(Params p) {
    extern __shared__ __attribute__((aligned(16))) unsigned char lds_raw[];
    LAS unsigned char* lds = (LAS unsigned char*)lds_raw;
    cg::grid_group grid = cg::this_grid();
    const int G = gridDim.x, bx = blockIdx.x;
    volatile LAS unsigned* bst = (volatile LAS unsigned*)(lds + LDS_BYTES - 16);
    if (threadIdx.x < 4) bst[threadIdx.x] = 0u;
    __syncthreads();
    const XcdBarrier xbar = xcd_barrier_post((unsigned*)(opqp(p.ws) + OFF_CTL) + 4096, bst);
#define GRID_BAR() xcd_barrier(xbar)
    const int vcu = (G % 8 == 0) ? (bx % 8) * (G / 8) + bx / 8 : bx;
    const int NGW = G * NWAVES;
    unsigned char* ws = opqp(p.ws);

    for (int rep = 0; rep < (PROBE_PH == 0 ? 2 : 1); ++rep) {
    p0_prep(p, lds, vcu, G);
    if (PROBE_PH == 100) { __syncthreads(); p0_prep(p, lds, vcu, G); }
    asm volatile("s_waitcnt vmcnt(0)" ::: "memory");
    grid.sync();
    }
    for (int rep = 0; rep < (PROBE_PH == 1 ? 2 : 1); ++rep)
    {
        pg8::Gemm g{(const char*)(ws + OFF_X8)}; constexpr int K_g = DM / 2, KS_g = 128; pg8::DenseOrder S; S.init(T_TOK, PROJ_LD, DM / 2, ws + OFF_WINT, G, bx);
        EpiStoreBf16 E{(bf16_t*)(ws + OFF_PROJ), PROJ_LD, 1.f / W8_SCALE};
        if ((vcu & 1) && rep == 0) { expert_convert(p, lds, vcu, G, XC0, XC1 - XC0); __syncthreads(); }
        pg8::gemm_phase<K_g, KS_g, true>(lds, g, S, E);
        if (!(vcu & 1) && rep == 0) { __syncthreads(); expert_convert(p, lds, vcu, G, XC0, XC1 - XC0); }
        GRID_BAR();
    }
    for (int rep = 0; rep < (PROBE_PH == 2 ? 2 : 1); ++rep) {
    nsa_rope_layout(p, lds, vcu, G);
    if (PROBE_PH == 20) nsa_rope_layout(p, lds, vcu, G);
    __syncthreads();
    nsa_vtranspose(p, lds, vcu, G);
    __syncthreads();
    s5_pass<false>(p, lds, vcu, G);
    if (PROBE_PH == 22) s5_pass<false>(p, lds, vcu, G);
    __syncthreads();
    nsa_compress(p, lds, vcu, G);
    if (PROBE_PH == 23) nsa_compress(p, lds, vcu, G);
    GRID_BAR();
    }
    for (int rep = 0; rep < (PROBE_PH == 4 ? 2 : 1); ++rep) {
    if ((vcu & 1) && rep == 0) { expert_convert(p, lds, vcu, G, XC1, XC2 - XC1); __syncthreads(); }
    s5_pass<true>(p, lds, vcu, G);
    if (PROBE_PH == 40) s5_pass<true>(p, lds, vcu, G);
    for (int r1 = 0; r1 < (PROBE_PH == 41 ? 2 : 1); ++r1) {
        if (G == 256) {
            const int bk = vcu >> 6, w6 = vcu & 63;
            __syncthreads();
            nsa_cmp_stage(p, lds, bk);
            __syncthreads();
#pragma unroll 1
            for (int k = 0; k < 8; ++k) nsa_cmp_unit(p, lds, bk, 64 * k + ((k & 1) ? 63 - w6 : w6));
        } else {
            for (int bk = 0; bk < 4; ++bk) {
                __syncthreads();
                nsa_cmp_stage(p, lds, bk);
                __syncthreads();
                for (int qt = vcu; qt < 512; qt += G) nsa_cmp_unit(p, lds, bk, qt);
            }
        }
    }
    for (int r2 = 0; r2 < (PROBE_PH == 42 ? 2 : 1); ++r2)
    for (int k = 0; k < 2; ++k) { const int u = k ? 511 - vcu : vcu; if (G == 256 || k == 0) for (int uu = u; uu < 512; uu += (G == 256 ? 512 : G)) nsa_win_unit(p, lds, uu >> 7, uu & 127); }
    if (!(vcu & 1) && rep == 0) { __syncthreads(); expert_convert(p, lds, vcu, G, XC1, XC2 - XC1); }
    GRID_BAR();
    }
    for (int rep = 0; rep < (PROBE_PH == 5 ? 2 : 1); ++rep) {
    if ((vcu & 1) && rep == 0) { expert_convert(p, lds, vcu, G, XC2, XC3 - XC2); __syncthreads(); }
    {
        pg8::Gemm g{(const char*)(ws + OFF_YGELU)}; constexpr int K_g = 1024, KS_g = 128; pg8::DenseOrder S; S.init(T_TOK, 1024, 1024, ws + OFF_WGLUT, G, bx);
        EpiGlu E{(const bf16_t*)(ws + OFF_YGELU), (unsigned char*)(ws + OFF_MIXIN)};
        pg8::gemm_phase<K_g, KS_g>(lds, g, S, E);
    }
    nsa_sel_phase(p, lds, vcu, G);
    if (PROBE_PH == 51) nsa_sel_phase(p, lds, vcu, G);
    if (!(vcu & 1) && rep == 0) { __syncthreads(); expert_convert(p, lds, vcu, G, XC2, XC3 - XC2); }
    GRID_BAR();
    }
    {
        pg8::Gemm g{(const char*)(ws + OFF_MIXIN)}; constexpr int K_g = DM / 2, KS_g = 128; pg8::DenseOrder S; S.init(T_TOK, DM, DM / 2, ws + OFF_WOUTT, G, bx);
        EpiResBf16 E{INP(0), (bf16_t*)(ws + OFF_X1)};
        if (vcu & 1) { expert_convert(p, lds, vcu, G, XC3, XC4 - XC3); __syncthreads(); }
        pg8::gemm_phase<K_g, KS_g, true>(lds, g, S, E);
        if (!(vcu & 1)) { __syncthreads(); expert_convert(p, lds, vcu, G, XC3, XC4 - XC3); }
        if (PROBE_PH == 6) { GRID_BAR(); pg8::gemm_phase<K_g, KS_g, true>(lds, g, S, E); }
    }
    GRID_BAR();
    if (PROBE_PH == 7) { ln1_route_phase<false>(p, lds, vcu, G); GRID_BAR(); }
    ln1_route_phase<true>(p, lds, vcu, G);
    GRID_BAR();
    for (int rep = 0; rep < (PROBE_PH == 11 ? 2 : 1); ++rep) {
    {
        moe_tables(p, lds);
        pg8::Gemm g{(const char*)(ws + OFF_X1Q)}; constexpr int K_g = DM / 2, KS_g = 128; MoeOrder S; S.init(lds, 4, DM / 2, ws + OFF_WEUPT, (size_t)1024 * DM, (const int*)(ws + OFF_LTOK), true, G, bx);
        EpiUp<false> E{(bf16_t*)(ws + OFF_H), nullptr};
        pg8::gemm_phase<K_g, KS_g, true>(lds, g, S, E);
        if (PROBE_PH == 112) { EpiNull EN; pg8::gemm_phase<K_g, KS_g, true>(lds, g, S, EN); }
    }
    GRID_BAR();
    }
    for (int rep = 0; rep < (PROBE_PH == 12 ? 2 : 1); ++rep) {
    {
        pg8::Gemm g{(const char*)(ws + OFF_H)}; constexpr int K_g = EFF / 2, KS_g = 128; MoeOrder S; S.init(lds, 8, EFF / 2, ws + OFF_WEDT, (size_t)DM * EFF, nullptr, false, G, bx);
        S.lslot = (const int*)(ws + OFF_LSLOT); S.lw = (const float*)(ws + OFF_LW);
        EpiMoeDown E{(unsigned char*)(ws + OFF_YSLOT), lds};
        pg8::gemm_phase<K_g, KS_g, true>(lds, g, S, E);
        if (PROBE_PH == 120) pg8::gemm_phase<K_g, KS_g, true>(lds, g, S, E);
        if (PROBE_PH == 122) { EpiNull EN; pg8::gemm_phase<K_g, KS_g, true>(lds, g, S, EN); }
    }
    GRID_BAR();
    }
    const int tid = opqv(threadIdx.x), lane = tid & 63, gw = vcu * NWAVES + (tid >> 6);
    f32x4 g2v[8], b2v[8];
#pragma unroll
    for (int j = 0; j < 8; ++j) { g2v[j] = ((const f32x4*)INP(29))[lane + 64 * j]; b2v[j] = ((const f32x4*)INP(30))[lane + 64 * j]; }
    for (int rep = 0; rep < (PROBE_PH == 14 ? 2 : 1); ++rep)
    for (int m = gw; m < T_TOK; m += NGW) ln_row<NSLOT>((const bf16_t*)(ws + OFF_X1B) + (size_t)m * DM, ALPHA, (const unsigned char*)(ws + OFF_YSLOT) + (size_t)m * NSLOT * DM, g2v, b2v, p.out + (size_t)m * DM, nullptr, nullptr, lane);
}
extern "C" void kernel_launch(void* const* d_in, const int* in_sizes, int n_in, void* d_out, int out_size, void* d_ws, size_t ws_size, hipStream_t stream) {
    static int grid = 0;
    if (grid == 0) {
        int dev = 0, cus = 0, per_cu = 0;
        (void)hipGetDevice(&dev);
        (void)hipDeviceGetAttribute(&cus, hipDeviceAttributeMultiprocessorCount, dev);
        (void)hipFuncSetAttribute((const void*)mega_fwd, hipFuncAttributeMaxDynamicSharedMemorySize, LDS_BYTES);
        (void)hipOccupancyMaxActiveBlocksPerMultiprocessor(&per_cu, (const void*)mega_fwd, NTHREADS, LDS_BYTES);
        if (per_cu < 1) { fprintf(stderr, "kernel_launch: occupancy query says %d blocks/CU\n", per_cu); }
        grid = cus;
        if (n_in != 31 || ws_size < WS_NEED) { fprintf(stderr, "kernel_launch: n_in %d ws %zu (need %zu): nothing launched\n", n_in, ws_size, (size_t)WS_NEED); grid = -1; }
    }
    if (grid < 0) return;
    if (hipMemsetAsync(d_ws, 0, 65536, stream) != hipSuccess) { fprintf(stderr, "kernel_launch: memset failed\n"); return; }
    Params p{};
    for (int i = 0; i < 31; ++i) p.in[i] = (const float*)d_in[i];
    p.out = (float*)d_out; p.ws = (unsigned char*)d_ws; p.ws_size = ws_size;
    void* args[] = {&p};
    hipError_t e = hipLaunchCooperativeKernel((const void*)mega_fwd, dim3(grid), dim3(NTHREADS), args, LDS_BYTES, stream);
    if (e != hipSuccess) fprintf(stderr, "kernel_launch: cooperative launch failed: %s (grid %d)\n", hipGetErrorString(e), grid);
}
```

```cpp
#include <hip/hip_runtime.h>
#include <hip/hip_cooperative_groups.h>
#include <cstdio>
#include <cstdint>
namespace cg = cooperative_groups;

#define LAS __attribute__((address_space(3)))
#define GAS __attribute__((address_space(1)))
typedef unsigned short bf16_t;
typedef short bf16x8 __attribute__((ext_vector_type(8)));
typedef float f32x4 __attribute__((ext_vector_type(4)));
typedef float f32x2 __attribute__((ext_vector_type(2)));
typedef unsigned u32x4 __attribute__((ext_vector_type(4)));
typedef unsigned u32x2 __attribute__((ext_vector_type(2)));

constexpr int NTHREADS = 512, NWAVES = 8;
constexpr int NB = 2, SEQ = 8192, T_TOK = NB * SEQ, DM = 2048;
constexpr int IN_COLS = 2864, PROJ_LD = 3072;
constexpr int SSM_W = 1024, NGRP = 64, NSTATE = 64;
constexpr int NHEAD = 16, NKVH = 2, HD = 64;
constexpr int COL_Q = 1024, COL_KC = 2048, COL_VC = 2176, COL_KS = 2304, COL_VS = 2432, COL_KW = 2560, COL_VW = 2688, COL_G = 2816;
constexpr int NCMP = 511, NSEL = 128, TOPK_SEL = 16, WINDOW = 512;
constexpr int NEXP = 64, TOPK_E = 8, EFF = 512, LISTCAP = T_TOK;
constexpr int NEXPS = NEXP + 1, NSLOT = TOPK_E + 1;
constexpr float ALPHA = 1.189207115002721f;
constexpr float LN_EPS = 1e-5f;
constexpr int S5_SEG = 256, S5_NSEG = SEQ / S5_SEG;

constexpr size_t MiB = 1ull << 20;
constexpr size_t OFF_CTL = 0;
constexpr size_t OFF_S5A = 1 * MiB;
constexpr size_t OFF_S5AC = OFF_S5A + 64 * 1024;
constexpr size_t OFF_S5BB = OFF_S5AC + 64 * 1024;
constexpr size_t OFF_S5CF = 2 * MiB;
constexpr size_t OFF_CBIAS = OFF_S5CF + 256 * 1024;
constexpr size_t OFF_WRT = 2 * MiB + 512 * 1024;
constexpr size_t OFF_KC = 3 * MiB;
constexpr size_t OFF_VCT = OFF_KC + 256 * 1024;
constexpr size_t OFF_SEL = 4 * MiB;
constexpr size_t OFF_E = 6 * MiB;
constexpr size_t OFF_LOGITS = 14 * MiB;
constexpr size_t OFF_LTOK = 14 * MiB;
constexpr size_t OFF_LW = 19 * MiB;
constexpr size_t OFF_LSLOT = 24 * MiB;
constexpr size_t OFF_LROW = 6 * MiB;
constexpr size_t OFF_WEDT = 30 * MiB;
constexpr size_t OFF_WSDT = 158 * MiB;
constexpr size_t OFF_X1 = 160 * MiB;
constexpr size_t OFF_X1B = 95 * MiB;
constexpr size_t OFF_HS = 288 * MiB;
constexpr size_t OFF_H = 304 * MiB;
constexpr size_t OFF_X1Q = 400 * MiB;
constexpr size_t OFF_YGELU = 304 * MiB;
constexpr size_t OFF_MIXIN = 336 * MiB;
constexpr size_t OFF_YSLOT = 433 * MiB;
constexpr size_t OFF_WEUPT = 433 * MiB;
constexpr size_t OFF_WINT = 689 * MiB;
constexpr size_t OFF_WGLUT = 701 * MiB;
constexpr size_t OFF_WOUTT = 703 * MiB;
constexpr size_t OFF_WSUPT = 711 * MiB;
constexpr size_t OFF_WC1T = 716 * MiB;
constexpr size_t OFF_SLOT64 = 717 * MiB;
constexpr size_t OFF_PROJ = 781 * MiB;
constexpr size_t OFF_QR = 877 * MiB;
constexpr size_t OFF_KSEL = 909 * MiB;
constexpr size_t OFF_VSELT = 913 * MiB;
constexpr size_t OFF_KWIN = 917 * MiB;
constexpr size_t OFF_VWINT = 921 * MiB;
constexpr size_t OFF_GATES = 925 * MiB;
constexpr size_t OFF_Q8 = 928 * MiB;
constexpr size_t OFF_X8 = 877 * MiB;
constexpr size_t WS_NEED = 1009 * MiB;

constexpr int LDS_BYTES = 163840;

struct Params {
    const float* in[31];
    float* out;
    unsigned char* ws;
    size_t ws_size;
};

__device__ __forceinline__ int opq(int i) { asm volatile("" : "+s"(i)); return i; }
__device__ __forceinline__ unsigned char* opqp(unsigned char* q) { unsigned long long v = (unsigned long long)q; asm volatile("" : "+s"(v)); return (unsigned char*)(GAS unsigned char*)v; }
__device__ __forceinline__ int opqv(int v) { asm volatile("" : "+v"(v)); return v; }
__device__ __forceinline__ unsigned char* opqf(unsigned char* q) { unsigned long long v = (unsigned long long)q; asm volatile("" : "+s"(v)); return (unsigned char*)v; }
#define INP(i) (p.in[opq(i)])
__device__ __forceinline__ unsigned f2bf(float f) { unsigned u = __builtin_bit_cast(unsigned, f); return (u + 0x7fffu + ((u >> 16) & 1u)) >> 16; }
typedef __bf16 bf16x2_t __attribute__((ext_vector_type(2)));
__device__ __forceinline__ unsigned cvt_pk_bf16(float lo, float hi) { const f32x2 v = {lo, hi}; const bf16x2_t b = __builtin_convertvector(v, bf16x2_t); return __builtin_bit_cast(unsigned, b); }
__device__ __forceinline__ unsigned pk2(float lo, float hi) { return cvt_pk_bf16(lo, hi); }
__device__ __forceinline__ float bf2f(unsigned b) { return __builtin_bit_cast(float, b << 16); }
__device__ __forceinline__ float bflo(unsigned w) { return __builtin_bit_cast(float, w << 16); }
__device__ __forceinline__ float bfhi(unsigned w) { return __builtin_bit_cast(float, w & 0xffff0000u); }
__device__ __forceinline__ void swap16(float& a, float& b) { asm volatile("s_nop 1\n\tv_permlane16_swap_b32 %0, %1" : "+v"(a), "+v"(b)); }
__device__ __forceinline__ void swap32(float& a, float& b) { asm volatile("s_nop 1\n\tv_permlane32_swap_b32 %0, %1" : "+v"(a), "+v"(b)); }
__device__ __forceinline__ float wave_sum(float v) {
#pragma unroll
    for (int o = 1; o < 64; o <<= 1) v += __shfl_xor(v, o);
    return v;
}
__device__ __forceinline__ float gelu_tanh(float x) {
    const float z = 0.7978845608028654f * (x + 0.044715f * x * x * x);
    const float e = __expf(2.f * z);
    const float th = 1.f - 2.f * __builtin_amdgcn_rcpf(e + 1.f);
    return 0.5f * x * (1.f + th);
}
__device__ __forceinline__ unsigned pk4_fp8(float a, float b, float c2, float d) { unsigned w = 0; w = __builtin_amdgcn_cvt_pk_fp8_f32(a, b, w, false); w = __builtin_amdgcn_cvt_pk_fp8_f32(c2, d, w, true); return w; }
constexpr float W8_SCALE = 256.f, H8_SCALE = 8.f, SLOT_SCALE = 64.f, MIX8_SCALE = 8.f;
__device__ __forceinline__ float sigmoidf_(float x) { return __builtin_amdgcn_rcpf(1.f + __expf(-x)); }
#define LDS_WAIT() asm volatile("s_waitcnt lgkmcnt(0)" ::: "memory")
#define GAS __attribute__((address_space(1)))
#define XB_TMO      128
#define XB_XCNT(j)  (256  + 64 * (j))
#define XB_XSUB(j)  (1280 + 64 * (j))
#define XB_XGEN(j)  (2304 + 64 * (j))
#define XB_TOP      3328
#define XB_TOPGEN   3392
#define XCD_BAR_WORDS 3456
#define XB_SPIN_CAP (1u << 18)

__device__ __forceinline__ unsigned xb_ld(unsigned* p)              { return __hip_atomic_load(p, __ATOMIC_RELAXED, __HIP_MEMORY_SCOPE_AGENT); }
__device__ __forceinline__ unsigned xb_add(unsigned* p, unsigned v) { return __hip_atomic_fetch_add(p, v, __ATOMIC_RELAXED, __HIP_MEMORY_SCOPE_AGENT); }
__device__ __forceinline__ unsigned xb_xcc_id() { return (unsigned)__builtin_amdgcn_s_getreg((3 << 11) | 20) & 0xFu; }
#define XB_SPIN(cond, bar) do { unsigned _sp = 0; while (cond) { __builtin_amdgcn_s_sleep(1); \
    if ((++_sp & 255u) == 0u) { if (xb_ld(&(bar)[XB_TMO])) break; if (_sp > XB_SPIN_CAP) { atomicAdd(&(bar)[XB_TMO], 1u); break; } } } } while (0)

struct XcdBarrier {
    unsigned* bar; unsigned x;
    volatile LAS unsigned* st;
};

__device__ __forceinline__ XcdBarrier xcd_barrier_post(unsigned* bar, volatile LAS unsigned* st) {
    XcdBarrier b; b.bar = bar; b.x = xb_xcc_id(); b.st = st;
    if (threadIdx.x == 0) (void)xb_add(&bar[XB_XCNT(b.x)], 1u);
    return b;
}
__device__ __forceinline__ void xcd_barrier_complete(unsigned* bar, unsigned x, unsigned& nloc, unsigned& nx) {
    const unsigned G = gridDim.x * gridDim.y * gridDim.z;
    unsigned sum, cnt, mine, sp = 0u;
    for (;;) {
        sum = 0u; cnt = 0u; mine = 0u;
#pragma unroll
        for (unsigned j = 0; j < 16; ++j) { const unsigned c = xb_ld(&bar[XB_XCNT(j)]); sum += c; cnt += (c > 0u) ? 1u : 0u; mine = (j == x) ? c : mine; }
        if (sum == G) break;
        __builtin_amdgcn_s_sleep(1);
        if ((++sp & 255u) == 0u) { if (xb_ld(&bar[XB_TMO])) break; if (sp > XB_SPIN_CAP) { atomicAdd(&bar[XB_TMO], 1u); break; } }
    }
    nloc = mine > 0u ? mine : 1u; nx = cnt > 0u ? cnt : 1u;
}

__device__ __forceinline__ void xcd_barrier(const XcdBarrier& b) {
    asm volatile("s_waitcnt vmcnt(0)" ::: "memory");
    __syncthreads();
    if (threadIdx.x == 0) {
        unsigned* bar = b.bar;
        __builtin_amdgcn_s_waitcnt(0);
        unsigned nloc = b.st[0], nx = b.st[1];
        if (nloc == 0u) { xcd_barrier_complete(bar, b.x, nloc, nx); b.st[0] = nloc; b.st[1] = nx; }
        const unsigned old = xb_add(&bar[XB_XSUB(b.x)], 1u);
        const unsigned gen = old / nloc;
        if (old + 1u == (gen + 1u) * nloc) {
            __builtin_amdgcn_fence(__ATOMIC_RELEASE, "agent");
            asm volatile("s_waitcnt vmcnt(0)" ::: "memory");
            const unsigned og = xb_add(&bar[XB_TOP], 1u);
            const unsigned tg = og / nx;
            if (og + 1u == (tg + 1u) * nx) xb_add(&bar[XB_TOPGEN], 1u);
            else XB_SPIN(xb_ld(&bar[XB_TOPGEN]) == tg, bar);
            __builtin_amdgcn_fence(__ATOMIC_ACQUIRE, "agent");
            xb_add(&bar[XB_XGEN(b.x)], 1u);
            asm volatile("s_waitcnt vmcnt(0)" ::: "memory");
        } else {
            XB_SPIN(xb_ld(&bar[XB_XGEN(b.x)]) == gen, bar);
            __builtin_amdgcn_fence(__ATOMIC_ACQUIRE, "agent");
            asm volatile("s_waitcnt vmcnt(0)" ::: "memory");
        }
    }
    __syncthreads();
}

namespace pg8 {
#define PG8_LAS __attribute__((address_space(3)))
constexpr int BM = 256, BK = 64, HALF = 128, HTB = HALF * BK * 2  , STAGE_BYTES = 8 * HTB;

__host__ __device__ __forceinline__ int lds_byte(int r, int c) { const int st = (r >> 4) * 2 + (c >> 5), rr = r & 15, cc = c & 31, ob = rr * 64 + cc * 2; return st * 1024 + (ob ^ (((ob >> 9) & 1) << 5)); }
__host__ __device__ __forceinline__ void stage_rc(int b, int& R, int& C) { const int st = b / 1024, sb = b % 1024, swz = sb ^ (((sb >> 9) & 1) << 5); R = (st >> 1) * 16 + swz / 64; C = (st & 1) * 32 + (swz % 64) / 2; }
__host__ __device__ __forceinline__ int perm32(int rho) { const int n = rho >> 4, i = rho & 15; return 8 * (i >> 2) + 4 * n + (i & 3); }

struct Unit { int pm, pn; const char* bB; int e, nvalid, rowbase, par; };
struct Gemm { const char* A; };

typedef int v8i_t __attribute__((ext_vector_type(8)));
typedef int v4i_t __attribute__((ext_vector_type(4)));
__device__ __forceinline__ v8i_t cat8(const bf16x8 lo, const bf16x8 hi) { const v4i_t a = __builtin_bit_cast(v4i_t, lo), b = __builtin_bit_cast(v4i_t, hi); return __builtin_shufflevector(a, b, 0, 1, 2, 3, 4, 5, 6, 7); }
template <int K, int KSTEPA, bool FP8 = false, bool ALIGN = true, class Epi, class Sched>
__device__ __forceinline__ void gemm_phase(PG8_LAS unsigned char* lds, const Gemm g, const Sched& S, const Epi& E) {
    const int tid = opqv(threadIdx.x), wid = __builtin_amdgcn_readfirstlane(tid >> 6), lane = tid & 63, wr = wid >> 2, wc = wid & 3, fr = lane & 15, fq = lane >> 4;
    constexpr int nt = K / BK;
    constexpr int PERMI = (int)Epi::PERM;
    unsigned voffB[2], voffB1[2];
#pragma unroll
    for (int i = 0; i < 2; ++i) { int R, C; stage_rc(tid * 16 + i * 8192, R, C);
        if constexpr (PERMI == 2) { const int w0 = 64 * (R >> 5) + 16 * ((R & 15) >> 2) + 4 * ((R >> 4) & 1) + (R & 3); voffB[i] = (unsigned)(w0 * K + C) * 2u; voffB1[i] = (unsigned)((w0 + 8) * K + C) * 2u; }
        else { const int Rb = PERMI == 1 ? ((R & ~31) + perm32(R & 31)) : R; voffB[i] = (unsigned)(Rb * K + C) * 2u; voffB1[i] = voffB[i]; } }
#define PG8_AOFF2T(U, h, par, o0, o1) do { int R0_, C0_, R1_, C1_; const int t_ = opqv(tid); stage_rc(t_ * 16, R0_, C0_); stage_rc(t_ * 16 + 8192, R1_, C1_); o0 = (unsigned)opqv((int)S.a_off_tab(U, h, R0_, C0_, par, lds)); o1 = (unsigned)opqv((int)S.a_off_tab(U, h, R1_, C1_, par, lds)); } while (0)
#define PG8_AOFF2(U, h, o0, o1) do { int R0_, C0_, R1_, C1_; const int t_ = opqv(tid); stage_rc(t_ * 16, R0_, C0_); stage_rc(t_ * 16 + 8192, R1_, C1_); o0 = (unsigned)opqv((int)S.a_off(U, h, R0_, C0_)); o1 = (unsigned)opqv((int)S.a_off(U, h, R1_, C1_)); } while (0)
#define PG8_AOFFS(U, o00, o01, o10, o11) do { int R0_, C0_, R1_, C1_; const int t_ = opqv(tid); stage_rc(t_ * 16, R0_, C0_); stage_rc(t_ * 16 + 8192, R1_, C1_); \
        o00 = (unsigned)opqv((int)S.a_off(U, 0, R0_, C0_)); o01 = (unsigned)opqv((int)S.a_off(U, 0, R1_, C1_)); o10 = (unsigned)opqv((int)S.a_off(U, 1, R0_, C0_)); o11 = (unsigned)opqv((int)S.a_off(U, 1, R1_, C1_)); } while (0)
    constexpr size_t kstepA = (size_t)KSTEPA;
    const size_t kstep = (size_t)(BK * 2);
    const size_t hstep = (size_t)HALF * K * 2;
    const size_t hstepB = PERMI == 2 ? (size_t)0 : hstep;
    const unsigned ldsw = (unsigned)wid * 1024u;
    const int aoff = lds_byte(wr * 64 + fr, fq * 8), boff = lds_byte(wc * 32 + fr, fq * 8);
#define PG8_SA(b, h) (((b) * 2 + (h)) * HTB)
#define PG8_SB(b, h) ((4 + (b) * 2 + (h)) * HTB)
#define PG8_STAGE(bufoff, gbase, voff) do { _Pragma("unroll") for (int _i = 0; _i < 2; ++_i) \
        __builtin_amdgcn_global_load_lds((const unsigned*)((const char*)(gbase) + (voff)[_i]), (PG8_LAS unsigned*)(lds + (bufoff) + ldsw + _i * 8192), 16, 0, 0); } while (0)
#define PG8_STAGEA(bufoff, o0, o1, kb) do { \
        __builtin_amdgcn_global_load_lds((const unsigned*)(g.A + (kb) + (o0)), (PG8_LAS unsigned*)(lds + (bufoff) + ldsw), 16, 0, 0); \
        __builtin_amdgcn_global_load_lds((const unsigned*)(g.A + (kb) + (o1)), (PG8_LAS unsigned*)(lds + (bufoff) + ldsw + 8192), 16, 0, 0); } while (0)
#define PG8_LDA8(dst, b, h) do { _Pragma("unroll") for (int m = 0; m < 4; ++m) dst[m] = cat8(*(const PG8_LAS bf16x8*)(lds + PG8_SA(b, h) + aoff + m * 2048), *(const PG8_LAS bf16x8*)(lds + PG8_SA(b, h) + aoff + m * 2048 + 1024)); } while (0)
#define PG8_LDB8(dst, b, h) do { _Pragma("unroll") for (int n = 0; n < 2; ++n) dst[n] = cat8(*(const PG8_LAS bf16x8*)(lds + PG8_SB(b, h) + boff + n * 2048), *(const PG8_LAS bf16x8*)(lds + PG8_SB(b, h) + boff + n * 2048 + 1024)); } while (0)
#define PG8_LDA_(dst, dst8, b, h) do { if constexpr (FP8) PG8_LDA8(dst8, b, h); else PG8_LDA(dst, b, h); } while (0)
#define PG8_LDB_(dst, dst8, b, h) do { if constexpr (FP8) PG8_LDB8(dst8, b, h); else PG8_LDB(dst, b, h); } while (0)
#define PG8_LDA(dst, b, h) do { _Pragma("unroll") for (int m = 0; m < 4; ++m) _Pragma("unroll") for (int k = 0; k < 2; ++k) dst[m][k] = *(const PG8_LAS bf16x8*)(lds + PG8_SA(b, h) + aoff + m * 2048 + k * 1024); } while (0)
#define PG8_LDB(dst, b, h) do { _Pragma("unroll") for (int n = 0; n < 2; ++n) _Pragma("unroll") for (int k = 0; k < 2; ++k) dst[n][k] = *(const PG8_LAS bf16x8*)(lds + PG8_SB(b, h) + boff + n * 2048 + k * 1024); } while (0)
#define PG8_MMA(ai, bj, At, Bt) do { __builtin_amdgcn_s_setprio(1); if constexpr (FP8) { _Pragma("unroll") for (int m = 0; m < 4; ++m) _Pragma("unroll") for (int n = 0; n < 2; ++n) \
        acc[ai][bj][m][n] = __builtin_amdgcn_mfma_scale_f32_16x16x128_f8f6f4(Bt##8[n], At##8[m], acc[ai][bj][m][n], 0, 0, 0, 0x7f7f7f7f, 0, 0x7f7f7f7f); } else { \
        _Pragma("unroll") for (int m = 0; m < 4; ++m) _Pragma("unroll") for (int n = 0; n < 2; ++n) _Pragma("unroll") for (int k = 0; k < 2; ++k) \
        acc[ai][bj][m][n] = __builtin_amdgcn_mfma_f32_16x16x32_bf16(Bt[n][k], At[m][k], acc[ai][bj][m][n], 0, 0, 0); } __builtin_amdgcn_s_setprio(0); } while (0)
#define PG8_WAIT_V(n) asm volatile("s_waitcnt vmcnt(" #n ")" ::: "memory")
#define PG8_WAIT_L(n) asm volatile("s_waitcnt lgkmcnt(" #n ")" ::: "memory")
#define PG8_BAR __builtin_amdgcn_s_barrier()
#define PG8_SCHED __builtin_amdgcn_sched_barrier(0)
#define PG8_SCHED8 do { if constexpr (FP8) __builtin_amdgcn_sched_barrier(0); } while (0)
#define PG8_PIN(ai) do { if constexpr (FP8) { _Pragma("unroll") for (int bj_ = 0; bj_ < 2; ++bj_) _Pragma("unroll") for (int m_ = 0; m_ < 4; ++m_) _Pragma("unroll") for (int n_ = 0; n_ < 2; ++n_) asm volatile("" : "+v"(acc[ai][bj_][m_][n_])); } } while (0)
    Unit cur, nxt; int ui = 0;
    if (!S.next(0, cur)) return;
    S.prefetch(cur, 0, lds);
    f32x4 acc[2][2][4][2];
#pragma unroll
    for (int a = 0; a < 2; ++a)
#pragma unroll
        for (int b = 0; b < 2; ++b)
#pragma unroll
            for (int m = 0; m < 4; ++m)
#pragma unroll
                for (int n = 0; n < 2; ++n) acc[a][b][m][n] = (f32x4){0.f, 0.f, 0.f, 0.f};
    bf16x8 At[4][2], B0[2][2], B1[2][2]; v8i_t At8[4], B08[2], B18[2];
    unsigned ca00, ca01, ca10, ca11; PG8_AOFFS(cur, ca00, ca01, ca10, ca11);
    const char* cB = cur.bB;
    PG8_STAGE(PG8_SB(0, 0), cB, voffB); PG8_STAGE(PG8_SB(0, 1), cB + hstepB, voffB1); PG8_STAGEA(PG8_SA(0, 0), ca00, ca01, (size_t)0); PG8_STAGEA(PG8_SA(0, 1), ca10, ca11, (size_t)0);
    if (wr == 1) PG8_BAR;
    PG8_WAIT_V(2); PG8_BAR;
    PG8_STAGE(PG8_SB(1, 0), cB + kstep, voffB); PG8_STAGEA(PG8_SA(1, 0), ca00, ca01, kstepA); PG8_STAGE(PG8_SB(1, 1), cB + hstepB + kstep, voffB1);
    PG8_WAIT_V(6); PG8_BAR;
    for (;;) {
        const bool has_next = S.next(ui + 1, nxt);
        const char* nB = has_next ? nxt.bB : cB;
        const int npar = (ui + 1) & 1;
        if (has_next) S.prefetch(nxt, npar, lds);

#pragma unroll 1
        for (int t = 0; t < nt; t += 2) {
            const bool last = (t == nt - 2);
            const bool fromnext = last && has_next;
            const size_t k1 = (size_t)(t + 1) * kstepA;
            const size_t k2 = last ? (size_t)0 : (size_t)(t + 2) * kstepA;
            const size_t k3 = k2 + kstepA;
            const char* b2 = last ? nB : cB + (size_t)(t + 2) * kstep; const char* b3 = b2 + kstep;
            unsigned y0, y1;
            PG8_LDB_(B0, B08, 0, 0); PG8_LDB_(B1, B18, 0, 1); PG8_SCHED; PG8_LDA_(At, At8, 0, 0); PG8_STAGEA(PG8_SA(1, 1), ca10, ca11, k1);
            PG8_WAIT_V(8); PG8_WAIT_L(0); PG8_BAR; PG8_SCHED8; PG8_MMA(0, 0, At, B0); PG8_MMA(0, 1, At, B1); PG8_PIN(0); PG8_SCHED8; PG8_BAR; PG8_SCHED;
            y0 = ca00; y1 = ca01; if (fromnext) PG8_AOFF2T(nxt, 0, npar, y0, y1);
            PG8_LDA_(At, At8, 0, 1); PG8_STAGE(PG8_SB(0, 0), b2, voffB); PG8_STAGE(PG8_SB(0, 1), b2 + hstepB, voffB1); PG8_STAGEA(PG8_SA(0, 0), y0, y1, k2);
            PG8_WAIT_V(8); PG8_WAIT_L(0); PG8_BAR; PG8_SCHED8; PG8_MMA(1, 0, At, B0); PG8_MMA(1, 1, At, B1); PG8_PIN(1); PG8_SCHED8; PG8_BAR; PG8_SCHED;
            y0 = ca10; y1 = ca11; if (fromnext) PG8_AOFF2T(nxt, 1, npar, y0, y1);
            PG8_LDB_(B0, B08, 1, 0); PG8_LDB_(B1, B18, 1, 1); PG8_SCHED; PG8_LDA_(At, At8, 1, 0); PG8_STAGEA(PG8_SA(0, 1), y0, y1, k2);
            PG8_WAIT_V(8); PG8_WAIT_L(0); PG8_BAR; PG8_SCHED8; PG8_MMA(0, 0, At, B0); PG8_MMA(0, 1, At, B1); PG8_PIN(0); PG8_SCHED8; PG8_BAR; PG8_SCHED;
            y0 = ca00; y1 = ca01; if (fromnext) PG8_AOFF2T(nxt, 0, npar, y0, y1);
            PG8_LDA_(At, At8, 1, 1); PG8_STAGE(PG8_SB(1, 0), b3, voffB); PG8_STAGE(PG8_SB(1, 1), b3 + hstepB, voffB1); PG8_STAGEA(PG8_SA(1, 0), y0, y1, k3);
            PG8_WAIT_V(8); PG8_WAIT_L(0); PG8_BAR; PG8_SCHED8; PG8_MMA(1, 0, At, B0); PG8_MMA(1, 1, At, B1); PG8_PIN(1); PG8_SCHED8; PG8_BAR; PG8_SCHED;
        }
        if (ALIGN && wr == 0) PG8_BAR;
        if constexpr (!Epi::AFTER_DRAIN) { E(acc, cur, wr, wc, fr, fq); }
        if (!has_next) break;
#pragma unroll
        for (int a = 0; a < 2; ++a)
#pragma unroll
            for (int b = 0; b < 2; ++b)
#pragma unroll
                for (int m = 0; m < 4; ++m)
#pragma unroll
                    for (int n = 0; n < 2; ++n) acc[a][b][m][n] = (f32x4){0.f, 0.f, 0.f, 0.f};
        cur = nxt; cB = nB; ++ui; PG8_AOFF2T(cur, 0, npar, ca00, ca01); PG8_AOFF2T(cur, 1, npar, ca10, ca11);
        if (ALIGN && wr == 1) PG8_BAR;
    }
    PG8_WAIT_V(0);
    if (!ALIGN && wr == 0) PG8_BAR;
    PG8_BAR;
    if constexpr (Epi::AFTER_DRAIN) { E.fused(acc, cur, wr, wc, fr, fq, lds, wid, lane); }
#undef PG8_SA
#undef PG8_SB
#undef PG8_STAGE
#undef PG8_STAGEA
#undef PG8_AOFFS
#undef PG8_AOFF2
#undef PG8_AOFF2T
#undef PG8_LDA
#undef PG8_LDA8
#undef PG8_LDB8
#undef PG8_LDA_
#undef PG8_LDB_
#undef PG8_LDB
#undef PG8_MMA
#undef PG8_WAIT_V
#undef PG8_WAIT_L
#undef PG8_BAR
#undef PG8_SCHED
#undef PG8_SCHED8
#undef PG8_PIN
}

struct DenseOrder {
    int nM, nN, nwg, G, c, K; const char* Bt;
    __device__ void init(int M, int N, int K_, const void* Bt_, int G_, int c_) { nM = M / BM; nN = N / BM; nwg = nM * nN; G = G_; c = c_; K = K_; Bt = (const char*)Bt_; }
    __device__ __forceinline__ bool next(int i, Unit& u) const {
        const int L = i * G + c; if (L >= nwg) return false;
        int wgid = L; { const int q = nwg / 8, r = nwg % 8, xcd = wgid % 8, off = wgid / 8; wgid = (xcd < r ? xcd * (q + 1) : r * (q + 1) + (xcd - r) * q) + off; }
        const int nig = 8 * nN, gid = wgid / nig, fm = gid * 8, gsz = (nM - fm) < 8 ? (nM - fm) : 8;
        u.pm = fm + ((wgid % nig) % gsz); u.pn = (wgid % nig) / gsz; u.bB = Bt + (size_t)u.pn * BM * K * 2; u.e = 0; u.nvalid = 256; u.rowbase = 0; u.par = 0; return true;
    }
    __device__ __forceinline__ unsigned a_off(const Unit& u, int h, int R, int C) const { return (unsigned)(((u.pm * BM + h * HALF + R) * K + C) * 2); }
    __device__ __forceinline__ void prefetch(const Unit&, int, PG8_LAS unsigned char*) const {}
    __device__ __forceinline__ unsigned a_off_tab(const Unit& u, int h, int R, int C, int, PG8_LAS unsigned char*) const { return a_off(u, h, R, C); }
};
}
template <class RowMap>
__device__ __forceinline__ void transpose_item(const float* W, int K, int N, bf16_t* dst, const RowMap& rowmap, LAS float* scr, int kb, int nb, int lane) {
    const int k0 = 64 * kb, n0 = 64 * nb;
    const int cc = 4 * (lane & 15), rr = lane >> 4;
    const bool ok = (n0 + cc) < N;
    f32x4 v[16];
#pragma unroll
    for (int i = 0; i < 16; ++i) { v[i] = (f32x4){0.f, 0.f, 0.f, 0.f}; if (ok) v[i] = __builtin_nontemporal_load((const f32x4*)(W + (size_t)(k0 + 4 * i + rr) * N + n0 + cc)); }
#pragma unroll
    for (int i = 0; i < 16; ++i) { LAS float* s = scr + (4 * i + rr) * 65 + cc; s[0] = v[i].x; s[1] = v[i].y; s[2] = v[i].z; s[3] = v[i].w; }
    LDS_WAIT();
    const int c = lane & 7;
#pragma unroll
    for (int j = 0; j < 8; ++j) {
        const int n = (lane >> 3) + 8 * j;
        const LAS float* s = scr + (8 * c) * 65 + n;
        u32x4 o; o.x = pk2(s[0 * 65], s[1 * 65]); o.y = pk2(s[2 * 65], s[3 * 65]); o.z = pk2(s[4 * 65], s[5 * 65]); o.w = pk2(s[6 * 65], s[7 * 65]);
        if (n0 + n < N) *(u32x4*)(dst + (size_t)rowmap(n0 + n) * K + k0 + 8 * c) = o;
    }
    LDS_WAIT();
}
template <class RowMap>
__device__ __forceinline__ void transpose_item_fp8(const float* W, int K, int N, unsigned char* dst, const RowMap& rowmap, float scale, LAS float* scr, int kb, int nb, int lane) {
    const int k0 = 64 * kb, n0 = 64 * nb;
    const int cc = 4 * (lane & 15), rr = lane >> 4;
    const bool ok = (n0 + cc) < N;
    f32x4 v[16];
#pragma unroll
    for (int i = 0; i < 16; ++i) { v[i] = (f32x4){0.f, 0.f, 0.f, 0.f}; if (ok) v[i] = __builtin_nontemporal_load((const f32x4*)(W + (size_t)(k0 + 4 * i + rr) * N + n0 + cc)); }
#pragma unroll
    for (int i = 0; i < 16; ++i) { LAS float* s = scr + (4 * i + rr) * 65 + cc; s[0] = v[i].x; s[1] = v[i].y; s[2] = v[i].z; s[3] = v[i].w; }
    LDS_WAIT();
    const int c = lane & 7;
#pragma unroll
    for (int j = 0; j < 8; ++j) {
        const int n = (lane >> 3) + 8 * j;
        const LAS float* s = scr + (8 * c) * 65 + n;
        u32x2 o; o.x = pk4_fp8(s[0 * 65] * scale, s[1 * 65] * scale, s[2 * 65] * scale, s[3 * 65] * scale); o.y = pk4_fp8(s[4 * 65] * scale, s[5 * 65] * scale, s[6 * 65] * scale, s[7 * 65] * scale);
        if (n0 + n < N) *(u32x2*)(dst + (size_t)rowmap(n0 + n) * K + k0 + 8 * c) = o;
    }
    LDS_WAIT();
}
struct MapId { int off; __device__ __forceinline__ int operator()(int n) const { return off + n; } };
struct MapGU { int off; __device__ __forceinline__ int operator()(int n) const { return (n >> 7) * 256 + off + (n & 127); } };

struct XItem { const float* src; unsigned char* dst; int N, K; };
__device__ __forceinline__ XItem xitem(const Params& p, unsigned char* ws, int id_, int lane) {
    const int id = __builtin_amdgcn_readfirstlane(id_);
    const int t = id & 255, ew = id >> 8, e = ew / 3, which = ew - 3 * e;
    XItem it;
    if (which < 2) {
        const int kb = t >> 3, nb = t & 7;
        it.N = EFF; it.K = DM;
        it.src = (e < NEXP ? INP(23 + which) + (size_t)e * DM * EFF : INP(26 + which)) + (size_t)(64 * kb) * EFF + 64 * nb;
        const int n0 = 64 * nb; const int r0 = (n0 >> 7) * 256 + which * 128 + (n0 & 127);
        it.dst = (unsigned char*)(ws + OFF_WEUPT) + (size_t)e * 1024 * DM + (size_t)r0 * DM + 64 * kb;
    } else {
        const int kb = t >> 5, nb = t & 31;
        it.N = DM; it.K = EFF;
        it.src = (e < NEXP ? INP(25) + (size_t)e * EFF * DM : INP(28)) + (size_t)(64 * kb) * DM + 64 * nb;
        it.dst = (unsigned char*)(ws + OFF_WEDT) + (size_t)e * DM * EFF + (size_t)(64 * nb) * EFF + 64 * kb;
    }
    return it;
}
__device__ __forceinline__ void xload(f32x4 (&v)[16], const XItem& it, int lane) {
    const int cc = 4 * (lane & 15), rr = lane >> 4;
#pragma unroll
    for (int i = 0; i < 16; ++i) v[i] = __builtin_nontemporal_load((const f32x4*)(it.src + (size_t)(4 * i + rr) * it.N + cc));
}
__device__ __forceinline__ void xstore(const f32x4 (&v)[16], const XItem& it, LAS float* scr, int lane) {
    const int cc = 4 * (lane & 15), rr = lane >> 4;
#pragma unroll
    for (int i = 0; i < 16; ++i) { LAS float* s = scr + (4 * i + rr) * 65 + cc; s[0] = v[i].x; s[1] = v[i].y; s[2] = v[i].z; s[3] = v[i].w; }
    LDS_WAIT();
    const int c = lane & 7;
#pragma unroll
    for (int j = 0; j < 8; ++j) {
        const int n = (lane >> 3) + 8 * j;
        const LAS float* s = scr + (8 * c) * 65 + n;
        u32x2 o; o.x = pk4_fp8(s[0 * 65] * W8_SCALE, s[1 * 65] * W8_SCALE, s[2 * 65] * W8_SCALE, s[3 * 65] * W8_SCALE); o.y = pk4_fp8(s[4 * 65] * W8_SCALE, s[5 * 65] * W8_SCALE, s[6 * 65] * W8_SCALE, s[7 * 65] * W8_SCALE);
        *(u32x2*)(it.dst + (size_t)n * it.K + 8 * c) = o;
    }
    LDS_WAIT();
}
__device__ __forceinline__ void expert_convert(const Params& p, LAS unsigned char* lds, int vcu, int G, int first, int count) {
    const int tid = opqv(threadIdx.x), lane = tid & 63, wave = tid >> 6;
    const int gw = vcu * NWAVES + wave, NGW = G * NWAVES;
    unsigned char* ws = opqf(p.ws);
    LAS float* scr = (LAS float*)(lds + wave * 16640);
#ifdef PROBE_PH
    for (int rp = 0; rp < (PROBE_PH == 99 ? 2 : 1); ++rp) {
#endif
    int j = gw;
    if (j >= count) return;
    f32x4 va[16], vb[16];
    XItem ia = xitem(p, ws, first + j, lane), ib = ia;
    xload(va, ia, lane);
    for (;;) {
        const int j1 = j + NGW; const bool m1 = j1 < count;
        if (m1) { ib = xitem(p, ws, first + j1, lane); xload(vb, ib, lane); }
        xstore(va, ia, scr, lane);
        if (!m1) break;
        const int j2 = j1 + NGW; const bool m2 = j2 < count;
        if (m2) { ia = xitem(p, ws, first + j2, lane); xload(va, ia, lane); }
        xstore(vb, ib, scr, lane);
        if (!m2) break;
        j = j2;
    }
#ifdef PROBE_PH
    }
#endif
}
__device__ __forceinline__ void p0_prep(const Params& p, LAS unsigned char* lds, int vcu, int G) {
    const int tid = opqv(threadIdx.x), lane = tid & 63, wave = tid >> 6;
    const int gw = vcu * NWAVES + wave, NGW = G * NWAVES;
    const int gt = vcu * NTHREADS + tid, NGT = G * NTHREADS;
    unsigned char* ws = opqf(p.ws);
    if (vcu == 0 && tid < 64) ((unsigned*)(ws + OFF_CTL))[tid] = 0u;
    {
        const f32x4* x4 = (const f32x4*)INP(0);
        const int n8 = T_TOK * DM / 8;
        for (int i0 = gt; i0 < n8; i0 += 4 * NGT) {
            f32x4 a[4], b[4];
#pragma unroll
            for (int k = 0; k < 4; ++k) { const int i = i0 + k * NGT; if (i < n8) { a[k] = x4[2 * i]; b[k] = x4[2 * i + 1]; } }
#pragma unroll
            for (int k = 0; k < 4; ++k) { const int i = i0 + k * NGT; if (i < n8) {
                ((u32x2*)(ws + OFF_X8))[i] = (u32x2){pk4_fp8(a[k].x, a[k].y, a[k].z, a[k].w), pk4_fp8(b[k].x, b[k].y, b[k].z, b[k].w)}; } }
        }
    }
    {
        u32x4* z1 = (u32x4*)(ws + OFF_WINT + (size_t)IN_COLS * DM); const int n1 = (PROJ_LD - IN_COLS) * DM / 16;
        for (int i = gt; i < n1; i += NGT) z1[i] = (u32x4){0u, 0u, 0u, 0u};

    }
    for (int i = gt; i < NGRP * NSTATE; i += NGT) {
        const int g = i >> 6, pp = i & 63;
        const float lr = INP(3)[i], li = INP(4)[i], dt = expf(INP(5)[g]);
        const float mag = expf(lr * dt); float sn, cs; sincosf(li * dt, &sn, &cs);
        const float ar = mag * cs, ai = mag * sn;
        const float zr = ar - 1.f, zi = ai, den = lr * lr + li * li;
        const float fr = (zr * lr + zi * li) / den, fi = (zi * lr - zr * li) / den;
        ((f32x2*)(ws + OFF_S5A))[i] = (f32x2){ar, ai};
        float pr = ar, pi = ai;
#pragma unroll
        for (int k = 0; k < 8; ++k) { const float nr = pr * pr - pi * pi, ni = 2.f * pr * pi; pr = nr; pi = ni; }
        ((f32x2*)(ws + OFF_S5AC))[i] = (f32x2){pr, pi};
        (void)fr; (void)fi;
    }
    for (int i = gt; i < NGRP * 4 * 64; i += NGT) {
        const int g = i >> 8, v = (i >> 6) & 3, l = i & 63, pp = 32 * (v >> 1) + (l & 31), h0 = 8 * (l >> 5), gp = g * 64 + pp;
        const float lr = INP(3)[gp], li = INP(4)[gp], dt = expf(INP(5)[g]);
        const float mag = expf(lr * dt); float sn, cs; sincosf(li * dt, &sn, &cs);
        const float ar = mag * cs, ai = mag * sn, zr = ar - 1.f, zi = ai, den = lr * lr + li * li;
        const float fr = (zr * lr + zi * li) / den, fi = (zi * lr - zr * li) / den;
        const float* br = INP(6) + (size_t)gp * 16 + h0; const float* bi = INP(7) + (size_t)gp * 16 + h0;
        unsigned w[4];
#pragma unroll
        for (int jj = 0; jj < 4; ++jj) {
            const float r0 = fr * br[2 * jj] - fi * bi[2 * jj], i0 = fr * bi[2 * jj] + fi * br[2 * jj], r1 = fr * br[2 * jj + 1] - fi * bi[2 * jj + 1], i1 = fr * bi[2 * jj + 1] + fi * br[2 * jj + 1];
            w[jj] = (v & 1) ? pk2(i0, i1) : pk2(r0, r1);
        }
        ((u32x4*)(ws + OFF_S5BB))[i] = (u32x4){w[0], w[1], w[2], w[3]};
    }
    for (int i = gt; i < NGRP * 4 * 64; i += NGT) {
        const int g = i >> 8, ks = (i >> 6) & 3, l = i & 63, h = l & 15, q = l >> 4;
        const float* cre = INP(8) + ((size_t)g * 16 + h) * 64; const float* cim = INP(9) + ((size_t)g * 16 + h) * 64;
        unsigned w[4];
#pragma unroll
        for (int jj = 0; jj < 4; ++jj) { const int k = 32 * ks + 8 * q + 2 * jj, pp = k >> 1; w[jj] = pk2(cre[pp], -cim[pp]); }
        ((u32x4*)(ws + OFF_S5CF))[i] = (u32x4){w[0], w[1], w[2], w[3]};
    }
    if (vcu < 32) {
        const int which = vcu >> 4, pt = vcu & 15;
        const float* pe = INP(12 + which); const float* w1 = INP(which == 0 ? 14 : 16);
        LAS float* red = (LAS float*)lds;
        const int j = tid & 127, sub = tid >> 7; float s = 0.f;
        const int kb0 = pt * 128 + sub * 32;
        float wv[32];
#pragma unroll
        for (int k = 0; k < 32; ++k) wv[k] = w1[(size_t)(kb0 + k) * 128 + j];
#pragma unroll
        for (int k = 0; k < 32; ++k) s += pe[kb0 + k] * wv[k];
        red[tid] = s; __syncthreads();
        if (tid < 128) ((float*)(ws + OFF_CBIAS))[(which * 16 + pt) * 128 + tid] = red[tid] + red[tid + 128] + red[tid + 256] + red[tid + 384];
        __syncthreads();
    }
    LAS float* scr = (LAS float*)(lds + wave * 16640);
    auto run = [&](const float* W, int K, int N, bf16_t* dst, auto map, int& base) {
        const int nkb = K / 64, nnb = (N + 63) / 64, items = nkb * nnb;
        int j0 = (gw - (base % NGW) + NGW) % NGW;
        for (int j = j0; j < items; j += NGW) transpose_item(W, K, N, dst, map, scr, j / nnb, j % nnb, lane);
        base += items;
    };
    auto run8 = [&](const float* W, int K, int N, unsigned char* dst, auto map, int& base) {
        const int nnb = (N + 63) / 64, items = (K / 64) * nnb;
        int j0 = (gw - (base % NGW) + NGW) % NGW;
        for (int j = j0; j < items; j += NGW) transpose_item_fp8(W, K, N, dst, map, W8_SCALE, scr, j / nnb, j % nnb, lane);
        base += items;
    };
    int base = 0;
    run8(INP(2), DM, IN_COLS, (unsigned char*)(ws + OFF_WINT), MapId{0}, base);
    run(INP(11), 1024, 1024, (bf16_t*)(ws + OFF_WGLUT), MapId{0}, base);
    run8(INP(18), DM, DM, (unsigned char*)(ws + OFF_WOUTT), MapId{0}, base);
    run(INP(14), DM, 128, (bf16_t*)(ws + OFF_WC1T), MapId{0}, base);
    run(INP(16), DM, 128, (bf16_t*)(ws + OFF_WC1T), MapId{128}, base);
    run(INP(21), DM, NEXP, (bf16_t*)(ws + OFF_WRT), MapId{0}, base);
    (void)run8;
}
using pg8::Unit;
struct EpiStoreBf16 {
    static constexpr int PERM = 1; static constexpr bool AFTER_DRAIN = false;
    bf16_t* O; int ldc; float sc;
    __device__ __forceinline__ void operator()(const f32x4 (&acc)[2][2][4][2], const Unit& u, int wr, int wc, int fr, int fq) const {
        const int row0 = u.pm * 256 + wr * 64 + fr, col0 = u.pn * 256 + wc * 32 + 8 * fq;
#pragma unroll
        for (int ai = 0; ai < 2; ++ai)
#pragma unroll
            for (int m = 0; m < 4; ++m) { bf16_t* rowp = O + (size_t)(row0 + ai * 128 + m * 16) * ldc + col0;
#pragma unroll
                for (int bj = 0; bj < 2; ++bj) { const f32x4 v0 = acc[ai][bj][m][0] * sc, v1 = acc[ai][bj][m][1] * sc;
                    u32x4 w; w.x = cvt_pk_bf16(v0[0], v0[1]); w.y = cvt_pk_bf16(v0[2], v0[3]); w.z = cvt_pk_bf16(v1[0], v1[1]); w.w = cvt_pk_bf16(v1[2], v1[3]);
                    *(u32x4*)(rowp + bj * 128) = w; } }
    }
};
struct EpiGlu {
    static constexpr int PERM = 1; static constexpr bool AFTER_DRAIN = false;
    const bf16_t* Y; unsigned char* O;
    __device__ __forceinline__ void operator()(const f32x4 (&acc)[2][2][4][2], const Unit& u, int wr, int wc, int fr, int fq) const {
        const int row0 = u.pm * 256 + wr * 64 + fr, col0 = u.pn * 256 + wc * 32 + 8 * fq;
#pragma unroll
        for (int ai = 0; ai < 2; ++ai) {
            u32x4 yv[4][2];
#pragma unroll
            for (int m = 0; m < 4; ++m)
#pragma unroll
                for (int bj = 0; bj < 2; ++bj) yv[m][bj] = *(const u32x4*)(Y + (size_t)(row0 + ai * 128 + m * 16) * 1024 + col0 + bj * 128);
#pragma unroll
            for (int m = 0; m < 4; ++m) { const size_t r = (size_t)(row0 + ai * 128 + m * 16);
#pragma unroll
                for (int bj = 0; bj < 2; ++bj) { const f32x4 v0 = acc[ai][bj][m][0], v1 = acc[ai][bj][m][1];
                    const u32x4 y = yv[m][bj];
                    u32x2 w;
                    w.x = pk4_fp8(bflo(y.x) * sigmoidf_(v0[0]) * MIX8_SCALE, bfhi(y.x) * sigmoidf_(v0[1]) * MIX8_SCALE, bflo(y.y) * sigmoidf_(v0[2]) * MIX8_SCALE, bfhi(y.y) * sigmoidf_(v0[3]) * MIX8_SCALE);
                    w.y = pk4_fp8(bflo(y.z) * sigmoidf_(v1[0]) * MIX8_SCALE, bfhi(y.z) * sigmoidf_(v1[1]) * MIX8_SCALE, bflo(y.w) * sigmoidf_(v1[2]) * MIX8_SCALE, bfhi(y.w) * sigmoidf_(v1[3]) * MIX8_SCALE);
                    *(u32x2*)(O + r * 2048 + col0 + bj * 128) = w; } }
        }
    }
};
struct EpiResF32 {
    static constexpr int PERM = 0; static constexpr bool AFTER_DRAIN = false;
    const float* X; float* O;
    __device__ __forceinline__ void operator()(const f32x4 (&acc)[2][2][4][2], const Unit& u, int wr, int wc, int fr, int fq) const {
        const int row0 = u.pm * 256 + wr * 64 + fr, col0 = u.pn * 256 + wc * 32 + 4 * fq;
#pragma unroll
        for (int ai = 0; ai < 2; ++ai)
#pragma unroll
            for (int m = 0; m < 4; ++m) { const size_t off = (size_t)(row0 + ai * 128 + m * 16) * DM + col0;
#pragma unroll
                for (int bj = 0; bj < 2; ++bj)
#pragma unroll
                    for (int n = 0; n < 2; ++n) { const f32x4 xv = *(const f32x4*)(X + off + bj * 128 + n * 16); *(f32x4*)(O + off + bj * 128 + n * 16) = xv * ALPHA + acc[ai][bj][m][n]; } }
    }
};

struct EpiResBf16 {
    static constexpr int PERM = 1; static constexpr bool AFTER_DRAIN = false;
    const float* X; bf16_t* O;
    __device__ __forceinline__ void operator()(const f32x4 (&acc)[2][2][4][2], const Unit& u, int wr, int wc, int fr, int fq) const {
        const int row0 = u.pm * 256 + wr * 64 + fr, col0 = u.pn * 256 + wc * 32 + 8 * fq;
#pragma unroll
        for (int ai = 0; ai < 2; ++ai)
#pragma unroll
            for (int mh = 0; mh < 2; ++mh) {
                f32x4 xv[2][2][2];
#pragma unroll
                for (int m2 = 0; m2 < 2; ++m2)
#pragma unroll
                    for (int bj = 0; bj < 2; ++bj) { const float* xp = X + (size_t)(row0 + ai * 128 + (2 * mh + m2) * 16) * DM + col0 + bj * 128; xv[m2][bj][0] = *(const f32x4*)xp; xv[m2][bj][1] = *(const f32x4*)(xp + 4); }
#pragma unroll
                for (int m2 = 0; m2 < 2; ++m2) { const int m = 2 * mh + m2; const size_t off = (size_t)(row0 + ai * 128 + m * 16) * DM + col0;
#pragma unroll
                    for (int bj = 0; bj < 2; ++bj) { const f32x4 v0 = acc[ai][bj][m][0] * (1.f / (W8_SCALE * MIX8_SCALE)), v1 = acc[ai][bj][m][1] * (1.f / (W8_SCALE * MIX8_SCALE));
                        const f32x4 x0 = xv[m2][bj][0], x1 = xv[m2][bj][1];
                        u32x4 w; w.x = cvt_pk_bf16(x0[0] * ALPHA + v0[0], x0[1] * ALPHA + v0[1]); w.y = cvt_pk_bf16(x0[2] * ALPHA + v0[2], x0[3] * ALPHA + v0[3]);
                        w.z = cvt_pk_bf16(x1[0] * ALPHA + v1[0], x1[1] * ALPHA + v1[1]); w.w = cvt_pk_bf16(x1[2] * ALPHA + v1[2], x1[3] * ALPHA + v1[3]);
                        *(u32x4*)(O + off + bj * 128) = w; } }
            }
    }
};

template <int NSL>
__device__ __forceinline__ void ln_row(const bf16_t* inrow, float inscale, const unsigned char* slots  , const f32x4 (&gv)[8], const f32x4 (&bv)[8]  , float* outrow, bf16_t* outb, unsigned char* outq, int lane) {
    const u32x2* xr = (const u32x2*)inrow + lane;
    f32x4 v[8]; float s = 0.f;
#pragma unroll
    for (int j = 0; j < 8; ++j) { const u32x2 w = xr[64 * j]; v[j] = (f32x4){bflo(w.x), bfhi(w.x), bflo(w.y), bfhi(w.y)} * inscale; }
    if (NSL > 0) {
#pragma unroll
        for (int k = 0; k < NSL; ++k) { const unsigned* sr = (const unsigned*)(slots + (size_t)k * DM) + lane;
#pragma unroll
            for (int j = 0; j < 8; ++j) { const unsigned w = sr[64 * j]; const f32x2 lo = __builtin_amdgcn_cvt_pk_f32_fp8(w, false), hi = __builtin_amdgcn_cvt_pk_f32_fp8(w, true);
                v[j].x += lo.x * (1.f / SLOT_SCALE); v[j].y += lo.y * (1.f / SLOT_SCALE); v[j].z += hi.x * (1.f / SLOT_SCALE); v[j].w += hi.y * (1.f / SLOT_SCALE); } }
    }
#pragma unroll
    for (int j = 0; j < 8; ++j) s += (v[j].x + v[j].y) + (v[j].z + v[j].w);
    const float mean = wave_sum(s) * (1.f / DM); float s2 = 0.f;
#pragma unroll
    for (int j = 0; j < 8; ++j) { v[j] = v[j] - mean; s2 += (v[j].x * v[j].x + v[j].y * v[j].y) + (v[j].z * v[j].z + v[j].w * v[j].w); }
    const float rstd = 1.f / sqrtf(wave_sum(s2) * (1.f / DM) + LN_EPS);
    f32x4* o = (f32x4*)outrow + lane;
    u32x2* ob = (u32x2*)outb + lane; unsigned* oq = (unsigned*)outq + lane;
#pragma unroll
    for (int j = 0; j < 8; ++j) { const f32x4 r = v[j] * rstd * gv[j] + bv[j]; __builtin_nontemporal_store(r, &o[64 * j]); if (outb) ob[64 * j] = (u32x2){pk2(r.x, r.y), pk2(r.z, r.w)}; if (outq) oq[64 * j] = pk4_fp8(r.x, r.y, r.z, r.w); }
}
typedef float f32x16 __attribute__((ext_vector_type(16)));
constexpr int S5_WAVE_LDS = 2 * 16 * 272;
template <bool PASS2>
__device__ __forceinline__ void s5_pass(const Params& p, LAS unsigned char* lds, int vcu, int G) {
    const int tid = opqv(threadIdx.x), lane = tid & 63, wave = __builtin_amdgcn_readfirstlane(tid >> 6);
    const int gw = vcu * NWAVES + wave, NGW = G * NWAVES;
    unsigned char* ws = opqf(p.ws);
    const bf16_t* proj = (const bf16_t*)(ws + OFF_PROJ);
    LAS unsigned char* sl = lds + wave * S5_WAVE_LDS;
    f32x2* Ebuf = (f32x2*)(ws + OFF_E);
    const int c = lane & 31, hh = lane >> 5;
    const int arow = lane & 31, ab = (arow >> 2) & 1, atok = (arow & 3) + 4 * (arow >> 3), ak = 8 * (lane >> 5);
    const int h = lane & 15, q = lane >> 4;
    for (int task = gw; task < NGRP * S5_NSEG; task += NGW) {
        const int g = task % NGRP, sg = task / NGRP;
        bf16x8 bf[4];
#pragma unroll
        for (int v = 0; v < 4; ++v) bf[v] = ((const bf16x8*)(ws + OFF_S5BB))[(g * 4 + v) * 64 + lane];
        const f32x2 a0 = ((const f32x2*)(ws + OFF_S5A))[g * 64 + c], a1 = ((const f32x2*)(ws + OFF_S5A))[g * 64 + 32 + c];
        float s0r = 0.f, s0i = 0.f, s1r = 0.f, s1i = 0.f;
        bf16x8 cf[4]; float dsk = 0.f;
        if (PASS2) {
            const f32x2 c0 = ((const f32x2*)(ws + OFF_S5AC))[g * 64 + c], c1 = ((const f32x2*)(ws + OFF_S5AC))[g * 64 + 32 + c];
            const f32x2* Ep = Ebuf + ((size_t)(hh * NGRP + g) * S5_NSEG) * 64 + c;
#pragma unroll 1
            for (int cc = 0; cc < sg; cc += 4) {
                f32x2 e0[4], e1[4];
#pragma unroll
                for (int k = 0; k < 4; ++k) { e0[k] = (f32x2){0.f, 0.f}; e1[k] = e0[k]; if (cc + k < sg) { e0[k] = Ep[(size_t)(cc + k) * 64]; e1[k] = Ep[(size_t)(cc + k) * 64 + 32]; } }
#pragma unroll
                for (int k = 0; k < 4; ++k) if (cc + k < sg) {
                    const float n0r = c0.x * s0r - c0.y * s0i + e0[k].x, n0i = c0.x * s0i + c0.y * s0r + e0[k].y; s0r = n0r; s0i = n0i;
                    const float n1r = c1.x * s1r - c1.y * s1i + e1[k].x, n1i = c1.x * s1i + c1.y * s1r + e1[k].y; s1r = n1r; s1i = n1i;
                }
            }
#pragma unroll
            for (int ks = 0; ks < 4; ++ks) cf[ks] = ((const bf16x8*)(ws + OFF_S5CF))[(g * 4 + ks) * 64 + lane];
            dsk = INP(10)[g * 16 + h];
        }
        const bf16_t* ubase = proj + (size_t)(ab * SEQ + sg * S5_SEG + atok) * PROJ_LD + g * 16 + ak;
        bf16x8 ua = *(const bf16x8*)ubase;
#pragma unroll 1
        for (int st = 0; st < S5_SEG / 16; ++st) {
            const bf16x8 ucur = ua;
            if (st + 1 < S5_SEG / 16) ua = *(const bf16x8*)(ubase + (size_t)(st + 1) * 16 * PROJ_LD);
            unsigned short uraw[2][4];
            if (PASS2) {
#pragma unroll
                for (int bb = 0; bb < 2; ++bb)
#pragma unroll
                    for (int r = 0; r < 4; ++r) uraw[bb][r] = proj[(size_t)(bb * SEQ + sg * S5_SEG + st * 16 + 4 * q + r) * PROJ_LD + g * 16 + h];
            }
            f32x16 x0r = {0.f, 0.f, 0.f, 0.f, 0.f, 0.f, 0.f, 0.f, 0.f, 0.f, 0.f, 0.f, 0.f, 0.f, 0.f, 0.f}, x0i = x0r, x1r = x0r, x1i = x0r;
            asm volatile("" : "+v"(x0r), "+v"(x0i), "+v"(x1r), "+v"(x1i));
            x0r = __builtin_amdgcn_mfma_f32_32x32x16_bf16(ucur, bf[0], x0r, 0, 0, 0); x0i = __builtin_amdgcn_mfma_f32_32x32x16_bf16(ucur, bf[1], x0i, 0, 0, 0);
            x1r = __builtin_amdgcn_mfma_f32_32x32x16_bf16(ucur, bf[2], x1r, 0, 0, 0); x1i = __builtin_amdgcn_mfma_f32_32x32x16_bf16(ucur, bf[3], x1i, 0, 0, 0);
#pragma unroll
            for (int t = 0; t < 16; ++t) {
                const float n0r = a0.x * s0r - a0.y * s0i + x0r[t], n0i = a0.x * s0i + a0.y * s0r + x0i[t]; s0r = n0r; s0i = n0i;
                const float n1r = a1.x * s1r - a1.y * s1i + x1r[t], n1i = a1.x * s1i + a1.y * s1r + x1i[t]; s1r = n1r; s1i = n1i;
                if (PASS2) { *(LAS unsigned*)(sl + (hh * 16 + t) * 272 + c * 4) = cvt_pk_bf16(s0r, s0i); *(LAS unsigned*)(sl + (hh * 16 + t) * 272 + 128 + c * 4) = cvt_pk_bf16(s1r, s1i); }
            }
            if (PASS2) {
                LDS_WAIT();
#pragma unroll
                for (int bb = 0; bb < 2; ++bb) {
                    f32x4 acc = (f32x4){0.f, 0.f, 0.f, 0.f};
#pragma unroll
                    for (int ks = 0; ks < 4; ++ks) { const bf16x8 av = *(const LAS bf16x8*)(sl + (bb * 16 + h) * 272 + ks * 64 + q * 16); acc = __builtin_amdgcn_mfma_f32_16x16x32_bf16(av, cf[ks], acc, 0, 0, 0); }
                    const size_t trow = (size_t)(bb * SEQ + sg * S5_SEG + st * 16 + 4 * q);
                    bf16_t* yo = (bf16_t*)(ws + OFF_YGELU) + trow * SSM_W + g * 16 + h;
#pragma unroll
                    for (int r = 0; r < 4; ++r) { const float uu = bf2f(uraw[bb][r]); const float y = gelu_tanh(acc[r] + dsk * uu); yo[(size_t)r * SSM_W] = (bf16_t)f2bf(y); }
                }
                LDS_WAIT();
            }
        }
        if (!PASS2) { f32x2* Eo = Ebuf + ((size_t)(hh * NGRP + g) * S5_NSEG + sg) * 64 + c; Eo[0] = (f32x2){s0r, s0i}; Eo[32] = (f32x2){s1r, s1i}; }
    }
}
__device__ __forceinline__ int vperm32(int k) { return 8 * ((k >> 2) & 3) + 4 * (k >> 4) + (k & 3); }

__device__ __forceinline__ void rope8(const u32x4 a, const u32x4 b, const float* cs, const float* sn, float (&o1)[8], float (&o2)[8]) {
    const unsigned aw[4] = {a.x, a.y, a.z, a.w}, bw[4] = {b.x, b.y, b.z, b.w};
#pragma unroll
    for (int k = 0; k < 4; ++k) {
        const float x1l = bflo(aw[k]), x1h = bfhi(aw[k]), x2l = bflo(bw[k]), x2h = bfhi(bw[k]);
        o1[2 * k] = x1l * cs[2 * k] - x2l * sn[2 * k]; o2[2 * k] = x2l * cs[2 * k] + x1l * sn[2 * k];
        o1[2 * k + 1] = x1h * cs[2 * k + 1] - x2h * sn[2 * k + 1]; o2[2 * k + 1] = x2h * cs[2 * k + 1] + x1h * sn[2 * k + 1];
    }
}
__device__ __forceinline__ void nsa_rope_layout(const Params& p, LAS unsigned char* lds, int vcu, int G) {
    const int tid = opqv(threadIdx.x), lane = tid & 63, wave = __builtin_amdgcn_readfirstlane(tid >> 6);
    const int gw = vcu * NWAVES + wave, NGW = G * NWAVES;
    unsigned char* ws = opqp(p.ws);
    const bf16_t* proj = (const bf16_t*)(ws + OFF_PROJ);
    bf16_t* Qr = (bf16_t*)(ws + OFF_QR);
    unsigned char* Q8 = (unsigned char*)(ws + OFF_Q8);
    const int* positions = (const int*)INP(1);
    LAS float* tab = (LAS float*)(lds + wave * 256);
    const float inv = powf(10000.f, -(float)(lane & 31) * (1.f / 32.f));
    const int hd = lane >> 2, qq = lane & 3;
    const int kidx = (lane >> 2) & 3, ktype = kidx >> 1, kkvh = kidx & 1, kcol = (ktype == 0 ? COL_KS : COL_KW) + kkvh * 64;
    u32x4 qa, qb, ka, kb; unsigned short gr = 0;
    auto fetch = [&](int t, u32x4& qa_, u32x4& qb_, u32x4& ka_, u32x4& kb_, unsigned short& g_) {
        const bf16_t* prow = proj + (size_t)t * PROJ_LD;
        qa_ = *(const u32x4*)(prow + COL_Q + hd * 64 + 8 * qq); qb_ = *(const u32x4*)(prow + COL_Q + hd * 64 + 32 + 8 * qq);
        ka_ = (u32x4){0u, 0u, 0u, 0u}; kb_ = ka_;
        if (lane < 16) { ka_ = *(const u32x4*)(prow + kcol + 8 * qq); kb_ = *(const u32x4*)(prow + kcol + 32 + 8 * qq); }
        g_ = lane < 48 ? prow[COL_G + lane] : (unsigned short)0;
    };
    if (gw < T_TOK) fetch(gw, qa, qb, ka, kb, gr);
    for (int t = gw; t < T_TOK; t += NGW) {
        const int b = t / SEQ, tl = t % SEQ;
        const float pos = (float)positions[t];
        u32x4 nqa = qa, nqb = qb, nka = ka, nkb = kb; unsigned short ngr = gr;
        if (t + NGW < T_TOK) fetch(t + NGW, nqa, nqb, nka, nkb, ngr);
        if (lane < 32) { float sn, cs; sincosf(pos * inv, &sn, &cs); tab[lane] = cs; tab[32 + lane] = sn; }
        LDS_WAIT();
        float cs[8], sn[8];
        { const f32x4 c0 = *(const LAS f32x4*)(tab + 8 * qq), c1 = *(const LAS f32x4*)(tab + 8 * qq + 4), s0 = *(const LAS f32x4*)(tab + 32 + 8 * qq), s1 = *(const LAS f32x4*)(tab + 32 + 8 * qq + 4);
#pragma unroll
          for (int k = 0; k < 4; ++k) { cs[k] = c0[k]; cs[4 + k] = c1[k]; sn[k] = s0[k]; sn[4 + k] = s1[k]; } }
        {
            float o1[8], o2[8]; rope8(qa, qb, cs, sn, o1, o2);
            bf16_t* qd = Qr + (size_t)t * 1024 + hd * 64 + 8 * qq;
            *(u32x4*)qd = (u32x4){pk2(o1[0] * 0.125f, o1[1] * 0.125f), pk2(o1[2] * 0.125f, o1[3] * 0.125f), pk2(o1[4] * 0.125f, o1[5] * 0.125f), pk2(o1[6] * 0.125f, o1[7] * 0.125f)};
            *(u32x4*)(qd + 32) = (u32x4){pk2(o2[0] * 0.125f, o2[1] * 0.125f), pk2(o2[2] * 0.125f, o2[3] * 0.125f), pk2(o2[4] * 0.125f, o2[5] * 0.125f), pk2(o2[6] * 0.125f, o2[7] * 0.125f)};
            unsigned char* q8 = Q8 + (size_t)t * 1024 + hd * 64 + 8 * qq;
            *(u32x2*)q8 = (u32x2){pk4_fp8(o1[0], o1[1], o1[2], o1[3]), pk4_fp8(o1[4], o1[5], o1[6], o1[7])};
            *(u32x2*)(q8 + 32) = (u32x2){pk4_fp8(o2[0], o2[1], o2[2], o2[3]), pk4_fp8(o2[4], o2[5], o2[6], o2[7])};
        }
        if (lane < 16) {
            float o1[8], o2[8]; rope8(ka, kb, cs, sn, o1, o2);
            if (ktype == 0) {
                unsigned char* dst = (unsigned char*)(ws + OFF_KSEL) + ((size_t)(b * 2 + kkvh) * SEQ + (tl & ~63)) * 64 + ((tl & 63) >> 4) * 1024 + (qq * 16 + (tl & 15)) * 16;
                *(u32x4*)dst = (u32x4){pk4_fp8(o1[0], o1[1], o1[2], o1[3]), pk4_fp8(o1[4], o1[5], o1[6], o1[7]), pk4_fp8(o2[0], o2[1], o2[2], o2[3]), pk4_fp8(o2[4], o2[5], o2[6], o2[7])};
            } else {
                bf16_t* dst = (bf16_t*)(ws + OFF_KWIN) + ((size_t)(b * 2 + kkvh) * SEQ + tl) * 64 + 8 * qq;
                *(u32x4*)dst = (u32x4){pk2(o1[0], o1[1]), pk2(o1[2], o1[3]), pk2(o1[4], o1[5]), pk2(o1[6], o1[7])};
                *(u32x4*)(dst + 32) = (u32x4){pk2(o2[0], o2[1]), pk2(o2[2], o2[3]), pk2(o2[4], o2[5]), pk2(o2[6], o2[7])};
            }
        }
        if (lane < 48) ((float*)(ws + OFF_GATES))[(size_t)t * 48 + lane] = sigmoidf_(bf2f(gr));
        LDS_WAIT();
        qa = nqa; qb = nqb; ka = nka; kb = nkb; gr = ngr;
    }
}

__device__ __forceinline__ void nsa_vtranspose(const Params& p, LAS unsigned char* lds, int vcu, int G) {
    const int tid = opqv(threadIdx.x), lane = tid & 63, wave = __builtin_amdgcn_readfirstlane(tid >> 6);
    const int gw = vcu * NWAVES + wave, NGW = G * NWAVES;
    unsigned char* ws = opqp(p.ws);
    const bf16_t* proj = (const bf16_t*)(ws + OFF_PROJ);
    LAS unsigned char* sl = lds + wave * 9216;
    for (int task = gw; task < 2 * 4 * 128; task += NGW) {
        const int blk = task & 127, bk = (task >> 7) & 3, type = task >> 9, b = bk >> 1, kvh = bk & 1;
        const bf16_t* src = proj + (size_t)(b * SEQ + blk * 64 + lane) * PROJ_LD + (type == 0 ? COL_VS : COL_VW) + kvh * 64;
#pragma unroll
        for (int i = 0; i < 8; ++i) *(LAS u32x4*)(sl + lane * 144 + 16 * i) = *(const u32x4*)(src + 8 * i);
        LDS_WAIT();
        if (type == 0) {
            unsigned char* dst8 = (unsigned char*)(ws + OFF_VSELT) + (size_t)(bk * 128 + blk) * 4096 + (lane >> 4) * 1024 + (lane & 15) * 16;
#pragma unroll
            for (int qv = 0; qv < 4; ++qv) {
                unsigned w[4];
#pragma unroll
                for (int jj = 0; jj < 4; ++jj) {
                    float f[4];
#pragma unroll
                    for (int e = 0; e < 4; ++e) { const int p0 = 32 * (jj >> 1) + 8 * qv + 4 * (jj & 1) + e; const int k0 = 32 * (p0 >> 5) + ((p0 & 7) >> 2) * 16 + 4 * ((p0 >> 3) & 3) + (p0 & 3); f[e] = bf2f(*(const LAS bf16_t*)(sl + k0 * 144 + lane * 2)); }
                    w[jj] = pk4_fp8(f[0], f[1], f[2], f[3]);
                }
                *(u32x4*)(dst8 + 256 * qv) = (u32x4){w[0], w[1], w[2], w[3]};
            }
            LDS_WAIT();
            continue;
        }
        bf16_t* dst = (bf16_t*)(ws + OFF_VWINT) + ((size_t)(bk * 128 + blk) * 64 + lane) * 64;
#pragma unroll
        for (int c8 = 0; c8 < 8; ++c8) {
            unsigned w[4];
#pragma unroll
            for (int jj = 0; jj < 4; ++jj) {
                const int p0 = c8 * 8 + 2 * jj, p1 = p0 + 1;
                const int k0 = 32 * (p0 >> 5) + ((p0 & 7) >> 2) * 16 + 4 * ((p0 >> 3) & 3) + (p0 & 3), k1 = 32 * (p1 >> 5) + ((p1 & 7) >> 2) * 16 + 4 * ((p1 >> 3) & 3) + (p1 & 3);
                const unsigned lo = *(const LAS bf16_t*)(sl + k0 * 144 + lane * 2), hi = *(const LAS bf16_t*)(sl + k1 * 144 + lane * 2);
                w[jj] = lo | (hi << 16);
            }
            *(u32x4*)(dst + 8 * c8) = (u32x4){w[0], w[1], w[2], w[3]};
        }
        LDS_WAIT();
    }
}

__device__ __forceinline__ void nsa_compress(const Params& p, LAS unsigned char* lds, int vcu, int G) {
    const int tid = opqv(threadIdx.x), lane = tid & 63, wave = __builtin_amdgcn_readfirstlane(tid >> 6), fr = lane & 15, fq = lane >> 4;
    unsigned char* ws = opqp(p.ws);
    const bf16_t* proj = (const bf16_t*)(ws + OFF_PROJ);
    LAS float* hid = (LAS float*)lds;
    LAS float* w2s = (LAS float*)(lds + 16384);
    for (int rt = vcu; rt < 256; rt += G) {
        const int rr0 = rt * 16, which = rr0 >> 11, bk = (rr0 >> 9) & 3, b = bk >> 1, kvh = bk & 1, n0 = rr0 & 511;
        const int na = (n0 + fr) > (NCMP - 1) ? (NCMP - 1) : (n0 + fr);
        const bf16_t* arow = proj + (size_t)(b * SEQ + 16 * na) * PROJ_LD + COL_KC + which * 128 + kvh * 64 + 8 * fq;
        const bf16_t* brow = (const bf16_t*)(ws + OFF_WC1T) + (size_t)(which * 128 + wave * 16 + fr) * DM + 8 * fq;
        {
            const float* w2 = INP(which ? 17 : 15);
            f32x4 wv[4];
#pragma unroll
            for (int i = 0; i < 4; ++i) wv[i] = *(const f32x4*)(w2 + 4 * (tid + i * NTHREADS));
#pragma unroll
            for (int i = 0; i < 4; ++i) *(LAS f32x4*)(w2s + 4 * (tid + i * NTHREADS)) = wv[i];
        }
        f32x4 acc = (f32x4){0.f, 0.f, 0.f, 0.f};
#pragma unroll 8
        for (int ks = 0; ks < 64; ++ks) {
            const bf16x8 a = *(const bf16x8*)(arow + (size_t)(ks >> 1) * PROJ_LD + (ks & 1) * 32);
            const bf16x8 bv = *(const bf16x8*)(brow + ks * 32);
            acc = __builtin_amdgcn_mfma_f32_16x16x32_bf16(a, bv, acc, 0, 0, 0);
        }
        float bias = 0.f;
#pragma unroll
        for (int pt = 0; pt < 16; ++pt) bias += ((const float*)(ws + OFF_CBIAS))[(which * 16 + pt) * 128 + wave * 16 + fr];
#pragma unroll
        for (int r = 0; r < 4; ++r) hid[(4 * fq + r) * 132 + wave * 16 + fr] = gelu_tanh(acc[r] + bias);
        __syncthreads();
        {
            const int row = tid >> 5, d = tid & 31;
            float o1 = 0.f, o2 = 0.f;
#pragma unroll 8
            for (int c = 0; c < 128; ++c) { const float hv = hid[row * 132 + c]; o1 += hv * w2s[c * 64 + d]; o2 += hv * w2s[c * 64 + 32 + d]; }
            const int n = n0 + row; const bool valid = n < NCMP;
            if (which == 0) {
                const int* positions = (const int*)INP(1);
                const int nn = valid ? n : NCMP - 1;
                float ps = 0.f;
#pragma unroll
                for (int t = 0; t < 32; ++t) ps += (float)positions[b * SEQ + 16 * nn + t];
                const float posm = ps * (1.f / 32.f);
                const float inv = powf(10000.f, -(float)d * (1.f / 32.f));
                float sn, cs; sincosf(posm * inv, &sn, &cs);
                bf16_t* dst = (bf16_t*)(ws + OFF_KC) + ((size_t)bk * 512 + n) * 64;
                dst[d] = valid ? (bf16_t)f2bf(o1 * cs - o2 * sn) : (bf16_t)0;
                dst[32 + d] = valid ? (bf16_t)f2bf(o2 * cs + o1 * sn) : (bf16_t)0;
            } else {
                const int pos = 32 * (n >> 5) + vperm32(n & 31);
                bf16_t* dst = (bf16_t*)(ws + OFF_VCT) + (size_t)bk * 64 * 512 + pos;
                dst[(size_t)d * 512] = valid ? (bf16_t)f2bf(o1) : (bf16_t)0;
                dst[(size_t)(d + 32) * 512] = valid ? (bf16_t)f2bf(o2) : (bf16_t)0;
            }
        }
        __syncthreads();
    }
}
__device__ __forceinline__ bf16x8 pack_p(const f32x4 a, const f32x4 b) {
    u32x4 w; w.x = cvt_pk_bf16(a[0], a[1]); w.y = cvt_pk_bf16(a[2], a[3]); w.z = cvt_pk_bf16(b[0], b[1]); w.w = cvt_pk_bf16(b[2], b[3]);
    return __builtin_bit_cast(bf16x8, w);
}
__device__ __forceinline__ f32x4 mfma16(const bf16x8 a, const bf16x8 b, const f32x4 c) { return __builtin_amdgcn_mfma_f32_16x16x32_bf16(a, b, c, 0, 0, 0); }
#define ZERO4 ((f32x4){0.f, 0.f, 0.f, 0.f})
__device__ __forceinline__ float xq_max(float x) {
    float a = x, b = x; swap16(a, b); float y = fmaxf(a, b);
    a = y; b = y; swap32(a, b); return fmaxf(a, b);
}
__device__ __forceinline__ float xq_sum(float x) {
    float a = x, b = x; swap16(a, b); float y = a + b;
    a = y; b = y; swap32(a, b); return a + b;
}
__device__ __forceinline__ float oct_sum(float x) {
    x += __builtin_bit_cast(float, __builtin_amdgcn_update_dpp(0, __builtin_bit_cast(int, x), 0xB1, 0xf, 0xf, false));
    x += __builtin_bit_cast(float, __builtin_amdgcn_update_dpp(0, __builtin_bit_cast(int, x), 0x4E, 0xf, 0xf, false));
    x += __builtin_bit_cast(float, __builtin_amdgcn_update_dpp(0, __builtin_bit_cast(int, x), 0x141, 0xf, 0xf, false));
    return x;
}
__device__ __forceinline__ unsigned wave_umax(unsigned x) {
    unsigned t;
    t = (unsigned)__builtin_amdgcn_update_dpp(0, (int)x, 0xB1, 0xf, 0xf, false); x = t > x ? t : x;
    t = (unsigned)__builtin_amdgcn_update_dpp(0, (int)x, 0x4E, 0xf, 0xf, false); x = t > x ? t : x;
    t = (unsigned)__builtin_amdgcn_update_dpp(0, (int)x, 0x141, 0xf, 0xf, false); x = t > x ? t : x;
    t = (unsigned)__builtin_amdgcn_update_dpp(0, (int)x, 0x140, 0xf, 0xf, false); x = t > x ? t : x;
    const unsigned a = __builtin_amdgcn_readlane(x, 0), b = __builtin_amdgcn_readlane(x, 16), c = __builtin_amdgcn_readlane(x, 32), d = __builtin_amdgcn_readlane(x, 48);
    const unsigned ab = a > b ? a : b, cd = c > d ? c : d; return ab > cd ? ab : cd;
}
__device__ __forceinline__ int swz128(int row, int ch) { return row * 128 + ((ch ^ ((row >> 1) & 7)) << 4); }
__device__ __forceinline__ int swz1024(int row, int ch) { return row * 1024 + ((ch ^ (row & 15)) << 4); }

constexpr int CMP_LDS_K = 0, CMP_LDS_V = 65536, CMP_LDS_IMP = 131072, CMP_LDS_SC = 131072 + 8192;
__device__ __forceinline__ void nsa_cmp_stage(const Params& p, LAS unsigned char* lds, int bk) {
    const int tid = opqv(threadIdx.x);
    const u32x4* kc = (const u32x4*)(opqp(p.ws) + OFF_KC) + (size_t)bk * 4096;
    const u32x4* vc = (const u32x4*)(opqp(p.ws) + OFF_VCT) + (size_t)bk * 4096;
    for (int i = tid; i < 4096; i += NTHREADS) {
        *(LAS u32x4*)(lds + CMP_LDS_K + swz128(i >> 3, i & 7)) = kc[i];
        *(LAS u32x4*)(lds + CMP_LDS_V + swz1024(i >> 6, i & 63)) = vc[i];
    }
}
__device__ __forceinline__ void nsa_cmp_unit(const Params& p, LAS unsigned char* lds, int bk, int qt) {
    const int tid = opqv(threadIdx.x), lane = tid & 63, wave = __builtin_amdgcn_readfirstlane(tid >> 6);
    const int qrow = lane & 15, q = lane >> 4, b = bk >> 1, kvh = bk & 1;
    unsigned char* ws = opqp(p.ws);
    const int t0 = qt * 16 + wave * 2, tok = t0 + (qrow >> 3), head = kvh * 8 + (qrow & 7);
    const bf16_t* qp = (const bf16_t*)(ws + OFF_QR) + (size_t)(b * SEQ + tok) * 1024 + head * 64 + 8 * q;
    const bf16x8 qf0 = *(const bf16x8*)qp, qf1 = *(const bf16x8*)(qp + 32);
    const float gate = ((const float*)(ws + OFF_GATES))[(size_t)(b * SEQ + tok) * 48 + head * 3 + 0];
    const int nv = tok >= 31 ? ((tok - 31) >> 4) + 1 : 0;
    const int nvmax = (t0 + 1) >= 31 ? ((t0 + 1 - 31) >> 4) + 1 : 0;
    const int NBk = (nvmax + 15) >> 4;
    f32x4 S[32];
#pragma unroll
    for (int jb = 0; jb < 32; ++jb) {
        S[jb] = ZERO4;
        if (jb < NBk) {
            const bf16x8 a0 = *(const LAS bf16x8*)(lds + CMP_LDS_K + swz128(16 * jb + qrow, q)), a1 = *(const LAS bf16x8*)(lds + CMP_LDS_K + swz128(16 * jb + qrow, 4 + q));
            S[jb] = mfma16(a1, qf1, mfma16(a0, qf0, ZERO4));
        }
        if ((jb & 3) == 3) __builtin_amdgcn_sched_barrier(0);
    }
    float m = -1e30f;
    int c0 = opqv(4 * q), c1 = opqv(4 * q + 1), c2 = opqv(4 * q + 2), c3 = opqv(4 * q + 3);
    const int cr[4] = {c0, c1, c2, c3};
    const int nv0 = t0 >= 31 ? ((t0 - 31) >> 4) + 1 : 0;
#pragma unroll
    for (int jb = 0; jb < 32; ++jb) if (jb < NBk) {
        if (16 * jb + 16 > nv0) {
            const int rem = nv - 16 * jb;
#pragma unroll
            for (int r = 0; r < 4; ++r) S[jb][r] = (cr[r] < rem) ? S[jb][r] : -1e30f;
        }
        m = fmaxf(m, fmaxf(fmaxf(S[jb][0], S[jb][1]), fmaxf(S[jb][2], S[jb][3])));
        if ((jb & 7) == 7) __builtin_amdgcn_sched_barrier(0);
    }
    m = xq_max(m);
    float l = 0.f;
    constexpr float L2E = 1.4426950408889634f;
#pragma unroll
    for (int jb = 0; jb < 32; ++jb) if (jb < NBk) {
#pragma unroll
        for (int r = 0; r < 4; ++r) { const float e = __builtin_amdgcn_exp2f((S[jb][r] - m) * L2E); S[jb][r] = e; l += e; }
        if ((jb & 3) == 3) __builtin_amdgcn_sched_barrier(0);
    }
    l = xq_sum(l);
    const float linv = (l > 0.f && nv > 0) ? 1.f / l : 0.f;
#pragma unroll
    for (int jb = 0; jb < 32; ++jb) if (jb < NBk) S[jb] = S[jb] * linv;
    LAS float* impL = (LAS float*)(lds + CMP_LDS_IMP + wave * 1024);
#pragma unroll
    for (int jb = 0; jb < 32; ++jb) {
        const float rs = (S[jb][0] + S[jb][1]) + (S[jb][2] + S[jb][3]);
        const float prev3 = jb > 0 ? S[jb > 0 ? jb - 1 : 0][3] : 0.f;
        const float prov = (q == 3) ? prev3 : S[jb][3];
        const float nbv = __shfl(prov, (lane - 16) & 63);
        float im = rs + nbv;
        im = oct_sum(im);
        if ((lane & 7) == 0) impL[(qrow >> 3) * 128 + 4 * jb + q] = im;
        if ((jb & 3) == 3) __builtin_amdgcn_sched_barrier(0);
    }
    LDS_WAIT();
    int* selo = (int*)(ws + OFF_SEL);
#pragma unroll 1
    for (int tk = 0; tk < 2; ++tk) {
        const int tokn = t0 + tk, cur = tokn >> 6;
        const int sa = lane, sb = lane + 64;
        const bool fa = (sa == 0) | (sa == cur) | (sa == cur - 1), fb = (sb == cur) | (sb == cur - 1);
        const float ia = impL[tk * 128 + sa], ib = impL[tk * 128 + sb];
        unsigned ka = (!fa && sa <= cur) ? (0x80000000u | ((__builtin_bit_cast(unsigned, ia) >> 8) << 7) | (unsigned)(127 - sa)) : 0u;
        unsigned kb = (!fb && sb <= cur) ? (0x80000000u | ((__builtin_bit_cast(unsigned, ib) >> 8) << 7) | (unsigned)(127 - sb)) : 0u;
        int* so = selo + ((size_t)bk * SEQ + tokn) * 16;
        int nf = 1;
        if (lane == 0) { so[0] = 0; if (cur >= 2) { so[1] = cur - 1; so[2] = cur; } else if (cur == 1) so[1] = 1; }
        nf = cur >= 2 ? 3 : (cur == 1 ? 2 : 1);
#pragma unroll 1
        for (int r = nf; r < 16; ++r) {
            const unsigned k = wave_umax(ka > kb ? ka : kb);
            if (k == 0u) { if (lane == 0) so[r] = 127; continue; }
            if (ka == k) ka = 0u;
            if (kb == k) kb = 0u;
            if (lane == 0) so[r] = 127 - (int)(k & 127u);
        }
    }
    f32x4 O[4] = {ZERO4, ZERO4, ZERO4, ZERO4};
#pragma unroll
    for (int s32 = 0; s32 < 16; ++s32) if (2 * s32 < NBk) {
        const bf16x8 pb = pack_p(S[2 * s32], S[2 * s32 + 1]);
#pragma unroll
        for (int dg = 0; dg < 4; ++dg) { const bf16x8 va = *(const LAS bf16x8*)(lds + CMP_LDS_V + swz1024(16 * dg + qrow, 4 * s32 + q)); O[dg] = mfma16(va, pb, O[dg]); }
    }
    bf16_t* yo = (bf16_t*)(ws + OFF_SLOT64) + (size_t)(b * SEQ + tok) * 1024 + head * 64 + 4 * q;
#pragma unroll
    for (int dg = 0; dg < 4; ++dg) *(u32x2*)(yo + 16 * dg) = (u32x2){pk2(O[dg][0] * gate, O[dg][1] * gate), pk2(O[dg][2] * gate, O[dg][3] * gate)};
}

__device__ __forceinline__ void nsa_win_unit(const Params& p, LAS unsigned char* lds, int bk, int kb64) {
    const int tid = opqv(threadIdx.x), lane = tid & 63, wave = __builtin_amdgcn_readfirstlane(tid >> 6);
    const int qrow = lane & 15, q = lane >> 4, b = bk >> 1, kvh = bk & 1;
    unsigned char* ws = opqp(p.ws);
    const int t0 = kb64 * 64, kt_lo = kb64 > 8 ? kb64 - 8 : 0, ntile = kb64 - kt_lo + 1;
    const u32x4* Kg = (const u32x4*)(ws + OFF_KWIN) + (size_t)bk * SEQ * 8 + (size_t)kt_lo * 512;
    const u32x4* Vg = (const u32x4*)(ws + OFF_VWINT) + (size_t)bk * 128 * 512 + (size_t)kt_lo * 512;
    bf16x8 qv0[4], qv1[4]; float gv[4];
#pragma unroll
    for (int ss = 0; ss < 4; ++ss) {
        const int tok = t0 + 16 * ss + wave * 2 + (qrow >> 3), head = kvh * 8 + (qrow & 7);
        const bf16_t* qp = (const bf16_t*)(ws + OFF_QR) + (size_t)(b * SEQ + tok) * 1024 + head * 64 + 8 * q;
        qv0[ss] = *(const bf16x8*)qp; qv1[ss] = *(const bf16x8*)(qp + 32);
        gv[ss] = ((const float*)(ws + OFF_GATES))[(size_t)(b * SEQ + tok) * 48 + head * 3 + 2];
    }
    __syncthreads();
    for (int i = 0; i < ntile; ++i) {
        *(LAS u32x4*)(lds + i * 16384 + swz128(tid >> 3, tid & 7)) = Kg[(size_t)i * 512 + tid];
        *(LAS u32x4*)(lds + i * 16384 + 8192 + swz128(tid >> 3, tid & 7)) = Vg[(size_t)i * 512 + tid];
    }
    __syncthreads();
#pragma unroll
    for (int ss = 0; ss < 4; ++ss) {
        const int tok = t0 + 16 * ss + wave * 2 + (qrow >> 3), head = kvh * 8 + (qrow & 7);
        const bf16x8 qf0 = qv0[ss], qf1 = qv1[ss];
        float m_run = -1e30f, l_run = 0.f;
        f32x4 O[4] = {ZERO4, ZERO4, ZERO4, ZERO4};
#pragma unroll 1
        for (int i = 0; i < ntile; ++i) {
            const int kt = kt_lo + i;
            LAS unsigned char* kl = lds + i * 16384; LAS unsigned char* vl = kl + 8192;
            f32x4 S[4]; float mt = -1e30f;
#pragma unroll
            for (int kb = 0; kb < 4; ++kb) {
                const bf16x8 a0 = *(const LAS bf16x8*)(kl + swz128(16 * kb + qrow, q)), a1 = *(const LAS bf16x8*)(kl + swz128(16 * kb + qrow, 4 + q));
                S[kb] = mfma16(a1, qf1, mfma16(a0, qf0, ZERO4));
            }
            if (kt == kb64 || kt + 8 <= kb64) {
#pragma unroll
                for (int kb = 0; kb < 4; ++kb)
#pragma unroll
                    for (int r = 0; r < 4; ++r) { const int kp = kt * 64 + 16 * kb + 4 * q + r; const bool ok = (kp <= tok) & (kp > tok - WINDOW); S[kb][r] = ok ? S[kb][r] : -1e30f; }
            }
#pragma unroll
            for (int kb = 0; kb < 4; ++kb) mt = fmaxf(mt, fmaxf(fmaxf(S[kb][0], S[kb][1]), fmaxf(S[kb][2], S[kb][3])));
            mt = xq_max(mt);
            constexpr float L2E = 1.4426950408889634f;
            const float m_new = fmaxf(m_run, mt), alpha = __builtin_amdgcn_exp2f((m_run - m_new) * L2E);
            float ls = 0.f;
            if (m_new > -1e29f) {
#pragma unroll
                for (int kb = 0; kb < 4; ++kb)
#pragma unroll
                    for (int r = 0; r < 4; ++r) { const float e = __builtin_amdgcn_exp2f((S[kb][r] - m_new) * L2E); S[kb][r] = e; ls += e; }
            } else {
#pragma unroll
                for (int kb = 0; kb < 4; ++kb) S[kb] = ZERO4;
            }
            l_run = l_run * alpha + ls; m_run = m_new;
#pragma unroll
            for (int dg = 0; dg < 4; ++dg) O[dg] = O[dg] * alpha;
#pragma unroll
            for (int s32 = 0; s32 < 2; ++s32) {
                const bf16x8 pb = pack_p(S[2 * s32], S[2 * s32 + 1]);
#pragma unroll
                for (int dg = 0; dg < 4; ++dg) { const bf16x8 va = *(const LAS bf16x8*)(vl + swz128(16 * dg + qrow, 4 * s32 + q)); O[dg] = mfma16(va, pb, O[dg]); }
            }
        }
        l_run = xq_sum(l_run);
        const float gate = gv[ss];
        const float sc = l_run > 0.f ? gate / l_run : 0.f;
        bf16_t* yo = (bf16_t*)(ws + OFF_SLOT64) + (size_t)T_TOK * 1024 + (size_t)(b * SEQ + tok) * 1024 + head * 64 + 4 * q;
#pragma unroll
        for (int dg = 0; dg < 4; ++dg) *(u32x2*)(yo + 16 * dg) = (u32x2){pk2(O[dg][0] * sc, O[dg][1] * sc), pk2(O[dg][2] * sc, O[dg][3] * sc)};
    }
}

typedef long l2 __attribute__((ext_vector_type(2)));
__device__ __forceinline__ f32x4 mfma8(long a, long b, const f32x4 c) { return __builtin_amdgcn_mfma_f32_16x16x32_fp8_fp8(a, b, c, 0, 0, 0); }
__device__ __forceinline__ long pack_p8(const f32x4 a, const f32x4 b) { const unsigned lo = pk4_fp8(a[0], a[1], a[2], a[3]), hi = pk4_fp8(b[0], b[1], b[2], b[3]); return (long)(((unsigned long long)hi << 32) | lo); }
__device__ __forceinline__ void sel_ld(l2 (&d)[4], const char* gblk, int lane) {
    const GAS l2* src = (const GAS l2*)(unsigned long long)gblk + lane;
#pragma unroll
    for (int i = 0; i < 4; ++i) d[i] = src[64 * i];
}
__device__ __forceinline__ void sel_iter(l2 (&kA)[4], l2 (&kB)[4], l2 (&vA)[4], l2 (&vB)[4], const long (&qA)[2], const long (&qB)[2], f32x4 (&O)[4], float& m_run, float& l_run,
                                         int s0, int s1, int sn0, int sn1, const char* Kg, const char* Vg, int cur, int tokm, bool lo, int q, int lane) {
    constexpr float SC = 0.125f * 1.4426950408889634f;
    f32x4 S[4];
#pragma unroll
    for (int kb = 0; kb < 4; ++kb) S[kb] = mfma8(kA[kb][0], qA[0], ZERO4);
#pragma unroll
    for (int kb = 0; kb < 4; ++kb) S[kb] = mfma8(kA[kb][1], qA[1], S[kb]);
#pragma unroll
    for (int kb = 0; kb < 4; ++kb) S[kb] = mfma8(kB[kb][0], qB[0], S[kb]);
#pragma unroll
    for (int kb = 0; kb < 4; ++kb) S[kb] = mfma8(kB[kb][1], qB[1], S[kb]);
    __builtin_amdgcn_sched_barrier(0);
    sel_ld(kA, Kg + (size_t)sn0 * 4096, lane); sel_ld(kB, Kg + (size_t)sn1 * 4096, lane);
    __builtin_amdgcn_sched_barrier(0);
    if (s0 == cur || s1 == cur) {
        const int lim = tokm - (lo ? s0 : s1) * 64 - 4 * q;
#pragma unroll
        for (int kb = 0; kb < 4; ++kb)
#pragma unroll
            for (int r = 0; r < 4; ++r) S[kb][r] = (16 * kb + r <= lim) ? S[kb][r] : -1e30f;
    }
    float mt = -1e30f;
#pragma unroll
    for (int kb = 0; kb < 4; ++kb) mt = fmaxf(mt, fmaxf(fmaxf(S[kb][0], S[kb][1]), fmaxf(S[kb][2], S[kb][3])));
    mt = xq_max(mt);
    const float m_new = fmaxf(m_run, mt), alpha = __builtin_amdgcn_exp2f((m_run - m_new) * SC);
    const float mb = m_new * SC;
    float ls = 0.f;
#pragma unroll
    for (int kb = 0; kb < 4; ++kb)
#pragma unroll
        for (int r = 0; r < 4; ++r) { const float e = __builtin_amdgcn_exp2f(S[kb][r] * SC - mb); S[kb][r] = e; ls += e; }
    l_run = l_run * alpha + ls; m_run = m_new;
#pragma unroll
    for (int dg = 0; dg < 4; ++dg) O[dg] = O[dg] * alpha;
    const long pb0 = pack_p8(S[0], S[1]), pb1 = pack_p8(S[2], S[3]);
    const long pA0 = lo ? pb0 : 0l, pA1 = lo ? pb1 : 0l, pB0 = lo ? 0l : pb0, pB1 = lo ? 0l : pb1;
#pragma unroll
    for (int dg = 0; dg < 4; ++dg) O[dg] = mfma8(vA[dg][0], pA0, O[dg]);
#pragma unroll
    for (int dg = 0; dg < 4; ++dg) O[dg] = mfma8(vA[dg][1], pA1, O[dg]);
#pragma unroll
    for (int dg = 0; dg < 4; ++dg) O[dg] = mfma8(vB[dg][0], pB0, O[dg]);
#pragma unroll
    for (int dg = 0; dg < 4; ++dg) O[dg] = mfma8(vB[dg][1], pB1, O[dg]);
    __builtin_amdgcn_sched_barrier(0);
    sel_ld(vA, Vg + (size_t)sn0 * 4096, lane); sel_ld(vB, Vg + (size_t)sn1 * 4096, lane);
    __builtin_amdgcn_sched_barrier(0);
}
struct SelTask { int bk, tok0, b, kvh, cur, nval; const char* Kg; const char* Vg; };
__device__ __forceinline__ SelTask sel_task(unsigned char* ws, int task) {
    SelTask t; t.bk = task / (SEQ / 2); t.tok0 = (task % (SEQ / 2)) * 2; t.b = t.bk >> 1; t.kvh = t.bk & 1; t.cur = t.tok0 >> 6; t.nval = t.cur + 1 < 16 ? t.cur + 1 : 16;
    t.Kg = (const char*)(ws + OFF_KSEL) + (size_t)t.bk * SEQ * 64; t.Vg = (const char*)(ws + OFF_VSELT) + (size_t)t.bk * 128 * 4096;
    return t;
}
struct SelOps { long q0, q1; int l0, l1; };
__device__ __forceinline__ SelOps sel_ops(unsigned char* ws, const SelTask& t, int lane) {
    const int qrow = lane & 15, q = lane >> 4;
    const GAS int* selg = (const GAS int*)(unsigned long long)(ws + OFF_SEL);
    const GAS unsigned char* qp = (const GAS unsigned char*)(unsigned long long)(ws + OFF_Q8) + (size_t)(t.b * SEQ + t.tok0 + (qrow >> 3)) * 1024 + (t.kvh * 8 + (qrow & 7)) * 64 + 8 * q;
    SelOps o; o.q0 = *(const GAS long*)qp; o.q1 = *(const GAS long*)(qp + 32);
    o.l0 = selg[((size_t)t.bk * SEQ + t.tok0) * 16 + qrow]; o.l1 = selg[((size_t)t.bk * SEQ + t.tok0 + 1) * 16 + qrow];
    return o;
}
__device__ __forceinline__ void nsa_sel_phase(const Params& p, LAS unsigned char* lds, int vcu, int G) {
    const int tid = opqv(threadIdx.x), lane = tid & 63, wave = __builtin_amdgcn_readfirstlane(tid >> 6);
    const int gw = vcu * NWAVES + wave, NGW = G * NWAVES;
    const int qrow = lane & 15, q = lane >> 4;
    const bool lo = qrow < 8;
    unsigned char* ws = opqp(p.ws);
    l2 kA0[4], kB0[4], vA0[4], vB0[4], kA1[4], kB1[4], vA1[4], vB1[4];
    SelOps oc = {0l, 0l, 0, 0}, on = {0l, 0l, 0, 0};
    if (gw < 2 * SEQ) oc = sel_ops(ws, sel_task(ws, gw), lane);
    if (gw + NGW < 2 * SEQ) on = sel_ops(ws, sel_task(ws, gw + NGW), lane);
    asm volatile("" : "+v"(oc.q0), "+v"(oc.q1), "+v"(oc.l0), "+v"(oc.l1), "+v"(on.q0), "+v"(on.q1), "+v"(on.l0), "+v"(on.l1));
    bool have = false;
    for (int task = gw; task < 2 * SEQ; task += NGW) {
        const SelTask t = sel_task(ws, task);
        const int tok0 = t.tok0, b = t.b, head = t.kvh * 8 + (qrow & 7), cur = t.cur, nval = t.nval;
        const int tokm = tok0 + (qrow >> 3);
        const char* Kg = t.Kg; const char* Vg = t.Vg;
        long qA[2], qB[2];
        qA[0] = lo ? oc.q0 : 0l; qA[1] = lo ? oc.q1 : 0l; qB[0] = lo ? 0l : oc.q0; qB[1] = lo ? 0l : oc.q1;
        const int taskN = task + NGW; const bool hasN = taskN < 2 * SEQ;
        const SelTask tn = sel_task(ws, hasN ? taskN : task);
        const bool chain = hasN && nval == 16 && tn.nval == 16;
        const float gate = ((const GAS float*)(unsigned long long)(ws + OFF_GATES))[(size_t)(b * SEQ + tokm) * 48 + head * 3 + 1];
        u32x2 cv[4], wv[4];
        {
            const GAS bf16_t* yc = (const GAS bf16_t*)(unsigned long long)(ws + OFF_SLOT64) + (size_t)(b * SEQ + tokm) * 1024 + head * 64 + 4 * q; const GAS bf16_t* yw = yc + (size_t)T_TOK * 1024;
#pragma unroll
            for (int dg = 0; dg < 4; ++dg) { cv[dg] = *(const GAS u32x2*)(yc + 16 * dg); wv[dg] = *(const GAS u32x2*)(yw + 16 * dg); }
        }
        const int selv0 = (lane & 16) ? on.l0 : oc.l0, selv1 = (lane & 16) ? on.l1 : oc.l1;
        if (!have) {
            const int a0 = __builtin_amdgcn_readlane(selv0, 0), a1 = __builtin_amdgcn_readlane(selv1, 0);
            const int j1 = nval > 1 ? 1 : 0;
            const int c0 = __builtin_amdgcn_readlane(selv0, j1), c1 = __builtin_amdgcn_readlane(selv1, j1);
            __builtin_amdgcn_sched_barrier(0);
            sel_ld(kA0, Kg + (size_t)a0 * 4096, lane); sel_ld(kB0, Kg + (size_t)a1 * 4096, lane);
            __builtin_amdgcn_sched_barrier(0);
            sel_ld(vA0, Vg + (size_t)a0 * 4096, lane); sel_ld(vB0, Vg + (size_t)a1 * 4096, lane);
            __builtin_amdgcn_sched_barrier(0);
            sel_ld(kA1, Kg + (size_t)c0 * 4096, lane); sel_ld(kB1, Kg + (size_t)c1 * 4096, lane);
            __builtin_amdgcn_sched_barrier(0);
            sel_ld(vA1, Vg + (size_t)c0 * 4096, lane); sel_ld(vB1, Vg + (size_t)c1 * 4096, lane);
            __builtin_amdgcn_sched_barrier(0);
        }
        float m_run = -1e30f, l_run = 0.f;
        f32x4 O[4] = {ZERO4, ZERO4, ZERO4, ZERO4};
        int j = 0;
#pragma unroll 1
        for (; j + 1 < nval; j += 2) {
            const bool in0 = j + 2 < nval, in1 = j + 3 < nval;
            const bool nx0 = !in0 && chain, nx1 = !in1 && chain;
            const int jn0 = in0 ? j + 2 : (chain ? 16 + j + 2 - nval : nval - 1), jn1 = in1 ? j + 3 : (chain ? 16 + j + 3 - nval : nval - 1);
            sel_iter(kA0, kB0, vA0, vB0, qA, qB, O, m_run, l_run, __builtin_amdgcn_readlane(selv0, j), __builtin_amdgcn_readlane(selv1, j),
                     __builtin_amdgcn_readlane(selv0, jn0), __builtin_amdgcn_readlane(selv1, jn0), nx0 ? tn.Kg : Kg, nx0 ? tn.Vg : Vg, cur, tokm, lo, q, lane);
            sel_iter(kA1, kB1, vA1, vB1, qA, qB, O, m_run, l_run, __builtin_amdgcn_readlane(selv0, j + 1), __builtin_amdgcn_readlane(selv1, j + 1),
                     __builtin_amdgcn_readlane(selv0, jn1), __builtin_amdgcn_readlane(selv1, jn1), nx1 ? tn.Kg : Kg, nx1 ? tn.Vg : Vg, cur, tokm, lo, q, lane);
        }
        if (j < nval) {
            const int sl0 = __builtin_amdgcn_readlane(selv0, j), sl1 = __builtin_amdgcn_readlane(selv1, j);
            sel_iter(kA0, kB0, vA0, vB0, qA, qB, O, m_run, l_run, sl0, sl1, sl0, sl1, Kg, Vg, cur, tokm, lo, q, lane);
        }
        SelOps onn = {0l, 0l, 0, 0};
        if (taskN + NGW < 2 * SEQ) onn = sel_ops(ws, sel_task(ws, taskN + NGW), lane);
        {
            const float lr = xq_sum(l_run);
            const float sc = lr > 0.f ? gate / lr : 0.f;
            GAS unsigned char* mo = (GAS unsigned char*)(unsigned long long)(ws + OFF_MIXIN) + (size_t)(b * SEQ + tokm) * 2048 + 1024 + head * 64 + 4 * q;
#pragma unroll
            for (int dg = 0; dg < 4; ++dg) {
                const u32x2 c = cv[dg], w = wv[dg];
                const float o0 = O[dg][0] * sc + bflo(c.x) + bflo(w.x), o1 = O[dg][1] * sc + bfhi(c.x) + bfhi(w.x), o2 = O[dg][2] * sc + bflo(c.y) + bflo(w.y), o3 = O[dg][3] * sc + bfhi(c.y) + bfhi(w.y);
                *(GAS unsigned*)(mo + 16 * dg) = pk4_fp8(o0 * MIX8_SCALE, o1 * MIX8_SCALE, o2 * MIX8_SCALE, o3 * MIX8_SCALE);
            }
        }
        asm volatile("" : "+v"(onn.q0), "+v"(onn.q1), "+v"(onn.l0), "+v"(onn.l1));
        have = chain; oc = on; on = onn;
    }
}
__device__ __forceinline__ float rl(float v, int l) { return __builtin_bit_cast(float, __builtin_amdgcn_readlane(__builtin_bit_cast(int, v), l)); }

__device__ __forceinline__ void route_token(const Params& p, unsigned char* ws, int t, float logit, float rb, int lane) {
    unsigned* cnt = (unsigned*)(ws + OFF_CTL);
    int* ltok = (int*)(ws + OFF_LTOK); float* lw = (float*)(ws + OFF_LW); int* lslot = (int*)(ws + OFF_LSLOT);
    const float affin = sigmoidf_(logit);
    const float biased = affin + rb;
    float m1 = biased; m1 = fmaxf(m1, __shfl_xor(m1, 1)); m1 = fmaxf(m1, __shfl_xor(m1, 2)); m1 = fmaxf(m1, __shfl_xor(m1, 4));
    const unsigned long long bal = __ballot(biased == m1);
    const unsigned grpbits = (unsigned)((bal >> (lane & ~7)) & 0xffull);
    const int first = (lane & ~7) + __builtin_ctz(grpbits);
    float m2 = (lane == first) ? -3e38f : biased; m2 = fmaxf(m2, __shfl_xor(m2, 1)); m2 = fmaxf(m2, __shfl_xor(m2, 2)); m2 = fmaxf(m2, __shfl_xor(m2, 4));
    const float gs = m1 + m2; const int myg = lane >> 3;
    int grank = 0;
#pragma unroll
    for (int gg = 0; gg < 8; ++gg) { const float og = rl(gs, 8 * gg); grank += (og > gs) | ((og == gs) & (gg < myg)); }
    const float mv = grank < 4 ? biased : -1e30f;
    int er = 0;
#pragma unroll
    for (int e2 = 0; e2 < 64; ++e2) { const float o = rl(mv, e2); er += (o > mv) | ((o == mv) & (e2 < lane)); }
    const bool sel = er < TOPK_E;
    const float wsum = wave_sum(sel ? affin : 0.f);
    if (sel) {
        const unsigned pos = atomicAdd(&cnt[lane], 1u);
        const size_t li = (size_t)lane * LISTCAP + pos;
        ltok[li] = t; lw[li] = affin / wsum * 2.5f; lslot[li] = t * NSLOT + er;
    }
    if (lane == 0) { const size_t li = (size_t)NEXP * LISTCAP + t; ltok[li] = t; lw[li] = 1.f; lslot[li] = t * NSLOT + TOPK_E; }
}

constexpr int RT_ROWB = 4096 + 16, RT_PART = 16 * RT_ROWB;
template <bool ROUTE>
__device__ __forceinline__ void ln1_route_phase(const Params& p, LAS unsigned char* lds, int vcu, int G) {
    const int tid = opqv(threadIdx.x), lane = tid & 63, wave = __builtin_amdgcn_readfirstlane(tid >> 6);
    unsigned char* ws = opqp(p.ws);
    const bf16_t* x1 = (const bf16_t*)(ws + OFF_X1);
    const float* g1 = INP(19); const float* b1 = INP(20);
    const float rb = INP(22)[lane];
    const bf16_t* WrT = (const bf16_t*)(ws + OFF_WRT);
    LAS float* part = (LAS float*)(lds + RT_PART);
    bf16x8 wfr[8][4];
    {
        const int fr = lane & 15, q = lane >> 4;
#pragma unroll
        for (int k8 = 0; k8 < 8; ++k8)
#pragma unroll
            for (int nb = 0; nb < 4; ++nb) wfr[k8][nb] = *(const bf16x8*)(WrT + (size_t)(16 * nb + fr) * DM + 256 * wave + 32 * k8 + 8 * q);
    }
    for (int tile = vcu; tile < T_TOK / 16; tile += G) {
        const int r0 = tile * 16;
#pragma unroll
        for (int rr = 0; rr < 2; ++rr) {
            const int rl_ = 2 * wave + rr; const size_t row = (size_t)(r0 + rl_);
            const u32x2* xr = (const u32x2*)(x1 + row * DM) + lane;
            f32x4 v[8]; float s = 0.f;
#pragma unroll
            for (int j = 0; j < 8; ++j) { const u32x2 w = xr[64 * j]; v[j] = (f32x4){bflo(w.x), bfhi(w.x), bflo(w.y), bfhi(w.y)}; s += (v[j].x + v[j].y) + (v[j].z + v[j].w); }
            const float mean = wave_sum(s) * (1.f / DM); float s2 = 0.f;
#pragma unroll
            for (int j = 0; j < 8; ++j) { v[j] = v[j] - mean; s2 += (v[j].x * v[j].x + v[j].y * v[j].y) + (v[j].z * v[j].z + v[j].w * v[j].w); }
            const float rstd = 1.f / sqrtf(wave_sum(s2) * (1.f / DM) + LN_EPS);
            const f32x4* gr = (const f32x4*)g1 + lane; const f32x4* br = (const f32x4*)b1 + lane;
            u32x2* o = (u32x2*)((bf16_t*)(ws + OFF_X1B) + row * DM) + lane; unsigned* oq = (unsigned*)(ws + OFF_X1Q + row * DM) + lane;
#pragma unroll
            for (int j = 0; j < 8; ++j) {
                const f32x4 r = v[j] * rstd * gr[64 * j] + br[64 * j]; const u32x2 rb2 = (u32x2){pk2(r.x, r.y), pk2(r.z, r.w)};
                o[64 * j] = rb2; oq[64 * j] = pk4_fp8(r.x, r.y, r.z, r.w);
                *(LAS u32x2*)(lds + rl_ * RT_ROWB + (64 * j + lane) * 8) = rb2;
            }
        }
        __syncthreads();
        {
            const int fr = lane & 15, q = lane >> 4;
            f32x4 acc[4] = {(f32x4){0.f, 0.f, 0.f, 0.f}, (f32x4){0.f, 0.f, 0.f, 0.f}, (f32x4){0.f, 0.f, 0.f, 0.f}, (f32x4){0.f, 0.f, 0.f, 0.f}};
#pragma unroll
            for (int k8 = 0; k8 < 8; ++k8) {
                const int k0 = 256 * wave + 32 * k8 + 8 * q;
                const bf16x8 a = *(const LAS bf16x8*)(lds + fr * RT_ROWB + k0 * 2);
#pragma unroll
                for (int nb = 0; nb < 4; ++nb) acc[nb] = __builtin_amdgcn_mfma_f32_16x16x32_bf16(a, wfr[k8][nb], acc[nb], 0, 0, 0);
            }
#pragma unroll
            for (int nb = 0; nb < 4; ++nb)
#pragma unroll
                for (int r = 0; r < 4; ++r) part[(wave * 16 + 4 * q + r) * 64 + 16 * nb + fr] = acc[nb][r];
        }
        __syncthreads();
#pragma unroll 1
        for (int rr = 0; rr < 2; ++rr) {
            const int rl_ = 2 * wave + rr;
            float lg = 0.f;
#pragma unroll
            for (int w = 0; w < 8; ++w) lg += part[(w * 16 + rl_) * 64 + lane];
            if (ROUTE) route_token(p, ws, r0 + rl_, lg, rb, lane); else asm volatile("" :: "v"(lg));
        }
        __syncthreads();
    }
}

constexpr int MOE_LDS = 131072;
__device__ __forceinline__ void moe_tables(const Params& p, LAS unsigned char* lds) {
    const int tid = opqv(threadIdx.x);
    LAS int* tstart = (LAS int*)(lds + MOE_LDS); LAS int* roff = (LAS int*)(lds + MOE_LDS + 272); LAS int* cn = (LAS int*)(lds + MOE_LDS + 544);
    if (tid < 64) {
        const int c = (int)__hip_atomic_load((unsigned*)(opqp(p.ws) + OFF_CTL) + tid, __ATOMIC_RELAXED, __HIP_MEMORY_SCOPE_AGENT);
        const int tl = (c + 255) >> 8;
        int st = tl, sr = c;
#pragma unroll
        for (int o = 1; o < 64; o <<= 1) { const int a = __shfl_up(st, o), b = __shfl_up(sr, o); if (tid >= o) { st += a; sr += b; } }
        cn[tid] = c; tstart[tid + 1] = st; roff[tid + 1] = sr;
        if (tid == 0) { tstart[0] = 0; roff[0] = 0; }
        if (tid == 63) { cn[64] = T_TOK; tstart[65] = st + T_TOK / 256; roff[65] = sr + T_TOK; }
    }
    __syncthreads();
}
__device__ __forceinline__ void MoeOrder_prefetch_impl(const int* ltok, const Unit& u, int parity, LAS unsigned char* lds);
__device__ __forceinline__ void MoeOrder_prefetch_sw(const int* lslot, const float* lw, const Unit& u, int parity, LAS unsigned char* lds);
constexpr int MOE_SW = MOE_LDS + 4096;
struct MoeOrder {
    LAS const int* tstart; LAS const int* roff; LAS const int* cn;
    int NT, nunits, G, c, K; const char* Bt; size_t bstride; const int* ltok; bool gather; const int* lslot = nullptr; const float* lw = nullptr;
    __device__ void init(LAS unsigned char* lds, int NT_, int K_, const void* Bt_, size_t bstride_, const int* ltok_, bool gather_, int G_, int c_) {
        tstart = (LAS const int*)(lds + MOE_LDS); roff = (LAS const int*)(lds + MOE_LDS + 272); cn = (LAS const int*)(lds + MOE_LDS + 544);
        NT = NT_; K = K_; Bt = (const char*)Bt_; bstride = bstride_; ltok = ltok_; gather = gather_; G = G_; c = c_; nunits = __builtin_amdgcn_readfirstlane(tstart[NEXPS] * NT_);
    }
    __device__ __forceinline__ bool next(int i, Unit& u) const {
        const int L = i * G + c; if (L >= nunits) return false;
        const int ti = L / NT, nt = L - ti * NT;
        int e = 0;
        if (ti >= tstart[NEXP]) e = NEXP;
        else {
#pragma unroll
            for (int s = 32; s >= 1; s >>= 1) { if (tstart[e + s] <= ti) e += s; }
        }
        e = __builtin_amdgcn_readfirstlane(e);
        const int mt = __builtin_amdgcn_readfirstlane(ti - tstart[e]);
        u.par = i % 3; u.e = e; u.pm = mt; u.pn = nt; u.nvalid = __builtin_amdgcn_readfirstlane(cn[e] - mt * 256); u.rowbase = __builtin_amdgcn_readfirstlane(roff[e] + mt * 256); u.bB = Bt + (size_t)e * bstride + (size_t)nt * 256 * K * 2; return true;
    }
    __device__ __forceinline__ void prefetch(const Unit& u, int parity, LAS unsigned char* lds) const { if (gather) MoeOrder_prefetch_impl(ltok, u, parity, lds); else if (lslot) MoeOrder_prefetch_sw(lslot, lw, u, u.par, lds); }
    __device__ __forceinline__ unsigned a_off_tab(const Unit& u, int h, int R, int C, int parity, LAS unsigned char* lds) const {
        if (!gather) return (unsigned)(((u.rowbase + h * 128 + R) * K + C) * 2);
        const int idx = *(const LAS int*)(lds + MOE_LDS + 1024 + parity * 1024 + (h * 128 + R) * 4); return (unsigned)((idx * K + C) * 2);
    }
    __device__ __forceinline__ unsigned a_off(const Unit& u, int h, int R, int C) const {
        const int r = h * 128 + R;
        if (gather) { const int tok = r < u.nvalid ? ltok[(size_t)u.e * LISTCAP + u.pm * 256 + r] : 0; return (unsigned)((tok * K + C) * 2); }
        return (unsigned)(((u.rowbase + r) * K + C) * 2);
    }
};
__device__ __forceinline__ void MoeOrder_prefetch_impl(const int* ltok, const Unit& u, int parity, LAS unsigned char* lds) {
    const int tid = threadIdx.x, wave = __builtin_amdgcn_readfirstlane(tid >> 6);
    if (wave < 4) {
        const int r = tid < u.nvalid ? tid : u.nvalid - 1;
        __builtin_amdgcn_global_load_lds((const unsigned*)(ltok + (size_t)u.e * LISTCAP + u.pm * 256 + r), (LAS unsigned*)(lds + MOE_LDS + 1024 + parity * 1024 + wave * 256), 4, 0, 0);
    }
}
__device__ __forceinline__ void MoeOrder_prefetch_sw(const int* lslot, const float* lw, const Unit& u, int parity, LAS unsigned char* lds) {
    const int tid = threadIdx.x, wave = __builtin_amdgcn_readfirstlane(tid >> 6), t = tid & 255;
    const int r = t < u.nvalid ? t : u.nvalid - 1;
    const size_t li = (size_t)u.e * LISTCAP + u.pm * 256 + r;
    const unsigned* src = wave < 4 ? (const unsigned*)(lslot + li) : (const unsigned*)(lw + li);
    __builtin_amdgcn_global_load_lds(src, (LAS unsigned*)(lds + MOE_SW + parity * 2048 + wave * 256), 4, 0, 0);
}
__device__ __forceinline__ float silu_mul(float g, float u) { return g * u * __builtin_amdgcn_rcpf(1.f + __expf(-g)); }
__device__ __forceinline__ f32x4 silu_mul4(const f32x4 ga, const f32x4 ua) {
    constexpr float IS = 1.f / W8_SCALE, C = IS * IS * H8_SCALE, IC = 1.f / C;
    const f32x4 t = ga * (-IS * 1.4426950408889634f);
    f32x4 e; e[0] = __builtin_amdgcn_exp2f(t[0]); e[1] = __builtin_amdgcn_exp2f(t[1]); e[2] = __builtin_amdgcn_exp2f(t[2]); e[3] = __builtin_amdgcn_exp2f(t[3]);
    const f32x4 d = e * IC + IC;
    f32x4 r; r[0] = __builtin_amdgcn_rcpf(d[0]); r[1] = __builtin_amdgcn_rcpf(d[1]); r[2] = __builtin_amdgcn_rcpf(d[2]); r[3] = __builtin_amdgcn_rcpf(d[3]);
    return (ga * ua) * r;
}
template <bool SHARED> struct EpiUp {
    static constexpr int PERM = 1; static constexpr bool AFTER_DRAIN = false;
    bf16_t* H; float* logits;
    __device__ __forceinline__ void operator()(const f32x4 (&acc)[2][2][4][2], const Unit& u, int wr, int wc, int fr, int fq) const {
        const int rbase = SHARED ? u.pm * 256 : u.rowbase;
        if (SHARED && u.pn == 4) {
            if (wc < 2) {
#pragma unroll
                for (int ai = 0; ai < 2; ++ai)
#pragma unroll
                    for (int m = 0; m < 4; ++m) { float* lp = logits + (size_t)(rbase + 128 * ai + 64 * wr + 16 * m + fr) * 64 + 32 * wc + 8 * fq;
                        *(f32x4*)lp = acc[ai][0][m][0]; *(f32x4*)(lp + 4) = acc[ai][0][m][1]; }
            }
            return;
        }
#pragma unroll
        for (int ai = 0; ai < 2; ++ai)
#pragma unroll
            for (int m = 0; m < 4; ++m) {
                const int r = 128 * ai + 64 * wr + 16 * m + fr;
                if (!SHARED) {
                    if (r < u.nvalid) {
                        const f32x4 h0 = silu_mul4(acc[ai][0][m][0], acc[ai][1][m][0]), h1 = silu_mul4(acc[ai][0][m][1], acc[ai][1][m][1]);
                        u32x2 w; w.x = pk4_fp8(h0[0], h0[1], h0[2], h0[3]); w.y = pk4_fp8(h1[0], h1[1], h1[2], h1[3]);
                        *(u32x2*)((unsigned char*)H + (size_t)(rbase + r) * EFF + 128 * u.pn + 32 * wc + 8 * fq) = w;
                    }
                } else {
                    const f32x4 g0 = acc[ai][0][m][0], g1 = acc[ai][0][m][1], u0 = acc[ai][1][m][0], u1 = acc[ai][1][m][1];
                    u32x4 w; w.x = cvt_pk_bf16(silu_mul(g0[0], u0[0]), silu_mul(g0[1], u0[1])); w.y = cvt_pk_bf16(silu_mul(g0[2], u0[2]), silu_mul(g0[3], u0[3]));
                    w.z = cvt_pk_bf16(silu_mul(g1[0], u1[0]), silu_mul(g1[1], u1[1])); w.w = cvt_pk_bf16(silu_mul(g1[2], u1[2]), silu_mul(g1[3], u1[3]));
                    *(u32x4*)(H + (size_t)(rbase + r) * EFF + 128 * u.pn + 32 * wc + 8 * fq) = w;
                }
            }
    }
};
struct EpiMoeDown {
    static constexpr int PERM = 2; static constexpr bool AFTER_DRAIN = false;
    unsigned char* Y; LAS unsigned char* lds;
    __device__ __forceinline__ void operator()(const f32x4 (&acc)[2][2][4][2], const Unit& u, int wr, int wc, int fr, int fq) const {
        const int col0 = u.pn * 256 + wc * 64 + 16 * fq;
        const LAS int* st = (const LAS int*)(lds + MOE_SW + u.par * 2048) + 64 * wr + fr; const LAS float* wt = (const LAS float*)(st + 256);
        int slot[8]; float w[8];
#pragma unroll
        for (int i = 0; i < 8; ++i) { const int r = 128 * (i >> 2) + 16 * (i & 3); const bool ok = (r + 64 * wr + fr) < u.nvalid; slot[i] = ok ? st[r] : -1; w[i] = ok ? wt[r] * (SLOT_SCALE / (W8_SCALE * H8_SCALE)) : 0.f; }
#pragma unroll
        for (int ai = 0; ai < 2; ++ai)
#pragma unroll
            for (int m = 0; m < 4; ++m) {
                const int i = ai * 4 + m;
                if (slot[i] >= 0) {
                    const f32x4 a0 = acc[ai][0][m][0] * w[i], a1 = acc[ai][0][m][1] * w[i], b0 = acc[ai][1][m][0] * w[i], b1 = acc[ai][1][m][1] * w[i];
                    u32x4 o; o.x = pk4_fp8(a0[0], a0[1], a0[2], a0[3]); o.y = pk4_fp8(a1[0], a1[1], a1[2], a1[3]); o.z = pk4_fp8(b0[0], b0[1], b0[2], b0[3]); o.w = pk4_fp8(b1[0], b1[1], b1[2], b1[3]);
                    __builtin_nontemporal_store(o, (u32x4*)(Y + (size_t)slot[i] * DM + col0));
                }
            }
    }
};
struct EpiNull {
    static constexpr int PERM = 1; static constexpr bool AFTER_DRAIN = false;
    __device__ __forceinline__ void operator()(const f32x4 (&acc)[2][2][4][2], const Unit&, int, int, int, int) const {
#pragma unroll
        for (int ai = 0; ai < 2; ++ai)
#pragma unroll
            for (int bj = 0; bj < 2; ++bj)
#pragma unroll
                for (int mm = 0; mm < 4; ++mm)
#pragma unroll
                    for (int n = 0; n < 2; ++n) asm volatile("" :: "v"(acc[ai][bj][mm][n]));
    }
};
constexpr int XC_ALL = NEXPS * 3 * 256, XC0 = 0, XC1 = XC_ALL / 4, XC2 = XC1 + (XC_ALL * 35) / 100, XC3 = XC2 + XC_ALL / 4, XC4 = XC_ALL;
#ifndef PROBE_PH
#define PROBE_PH (-1)
#endif
__global__ void __launch_bounds__(NTHREADS, 2) mega_fwd(Params p) {
    extern __shared__ __attribute__((aligned(16))) unsigned char lds_raw[];
    LAS unsigned char* lds = (LAS unsigned char*)lds_raw;
    cg::grid_group grid = cg::this_grid();
    const int G = gridDim.x, bx = blockIdx.x;
    volatile LAS unsigned* bst = (volatile LAS unsigned*)(lds + LDS_BYTES - 16);
    if (threadIdx.x < 4) bst[threadIdx.x] = 0u;
    __syncthreads();
    const XcdBarrier xbar = xcd_barrier_post((unsigned*)(opqp(p.ws) + OFF_CTL) + 4096, bst);
#define GRID_BAR() xcd_barrier(xbar)
    const int vcu = (G % 8 == 0) ? (bx % 8) * (G / 8) + bx / 8 : bx;
    const int NGW = G * NWAVES;
    unsigned char* ws = opqp(p.ws);

    for (int rep = 0; rep < (PROBE_PH == 0 ? 2 : 1); ++rep) {
    p0_prep(p, lds, vcu, G);
    if (PROBE_PH == 100) { __syncthreads(); p0_prep(p, lds, vcu, G); }
    asm volatile("s_waitcnt vmcnt(0)" ::: "memory");
    grid.sync();
    }
    for (int rep = 0; rep < (PROBE_PH == 1 ? 2 : 1); ++rep)
    {
        pg8::Gemm g{(const char*)(ws + OFF_X8)}; constexpr int K_g = DM / 2, KS_g = 128; pg8::DenseOrder S; S.init(T_TOK, PROJ_LD, DM / 2, ws + OFF_WINT, G, bx);
        EpiStoreBf16 E{(bf16_t*)(ws + OFF_PROJ), PROJ_LD, 1.f / W8_SCALE};
        if ((vcu & 1) && rep == 0) { expert_convert(p, lds, vcu, G, XC0, XC1 - XC0); __syncthreads(); }
        pg8::gemm_phase<K_g, KS_g, true>(lds, g, S, E);
        if (!(vcu & 1) && rep == 0) { __syncthreads(); expert_convert(p, lds, vcu, G, XC0, XC1 - XC0); }
        GRID_BAR();
    }
    for (int rep = 0; rep < (PROBE_PH == 2 ? 2 : 1); ++rep) {
    nsa_rope_layout(p, lds, vcu, G);
    if (PROBE_PH == 20) nsa_rope_layout(p, lds, vcu, G);
    __syncthreads();
    nsa_vtranspose(p, lds, vcu, G);
    __syncthreads();
    s5_pass<false>(p, lds, vcu, G);
    if (PROBE_PH == 22) s5_pass<false>(p, lds, vcu, G);
    __syncthreads();
    nsa_compress(p, lds, vcu, G);
    if (PROBE_PH == 23) nsa_compress(p, lds, vcu, G);
    GRID_BAR();
    }
    for (int rep = 0; rep < (PROBE_PH == 4 ? 2 : 1); ++rep) {
    if ((vcu & 1) && rep == 0) { expert_convert(p, lds, vcu, G, XC1, XC2 - XC1); __syncthreads(); }
    s5_pass<true>(p, lds, vcu, G);
    if (PROBE_PH == 40) s5_pass<true>(p, lds, vcu, G);
    for (int r1 = 0; r1 < (PROBE_PH == 41 ? 2 : 1); ++r1) {
        if (G == 256) {
            const int bk = vcu >> 6, w6 = vcu & 63;
            __syncthreads();
            nsa_cmp_stage(p, lds, bk);
            __syncthreads();
#pragma unroll 1
            for (int k = 0; k < 8; ++k) nsa_cmp_unit(p, lds, bk, 64 * k + ((k & 1) ? 63 - w6 : w6));
        } else {
            for (int bk = 0; bk < 4; ++bk) {
                __syncthreads();
                nsa_cmp_stage(p, lds, bk);
                __syncthreads();
                for (int qt = vcu; qt < 512; qt += G) nsa_cmp_unit(p, lds, bk, qt);
            }
        }
    }
    for (int r2 = 0; r2 < (PROBE_PH == 42 ? 2 : 1); ++r2)
    for (int k = 0; k < 2; ++k) { const int u = k ? 511 - vcu : vcu; if (G == 256 || k == 0) for (int uu = u; uu < 512; uu += (G == 256 ? 512 : G)) nsa_win_unit(p, lds, uu >> 7, uu & 127); }
    if (!(vcu & 1) && rep == 0) { __syncthreads(); expert_convert(p, lds, vcu, G, XC1, XC2 - XC1); }
    GRID_BAR();
    }
    for (int rep = 0; rep < (PROBE_PH == 5 ? 2 : 1); ++rep) {
    if ((vcu & 1) && rep == 0) { expert_convert(p, lds, vcu, G, XC2, XC3 - XC2); __syncthreads(); }
    {
        pg8::Gemm g{(const char*)(ws + OFF_YGELU)}; constexpr int K_g = 1024, KS_g = 128; pg8::DenseOrder S; S.init(T_TOK, 1024, 1024, ws + OFF_WGLUT, G, bx);
        EpiGlu E{(const bf16_t*)(ws + OFF_YGELU), (unsigned char*)(ws + OFF_MIXIN)};
        pg8::gemm_phase<K_g, KS_g>(lds, g, S, E);
    }
    nsa_sel_phase(p, lds, vcu, G);
    if (PROBE_PH == 51) nsa_sel_phase(p, lds, vcu, G);
    if (!(vcu & 1) && rep == 0) { __syncthreads(); expert_convert(p, lds, vcu, G, XC2, XC3 - XC2); }
    GRID_BAR();
    }
    {
        pg8::Gemm g{(const char*)(ws + OFF_MIXIN)}; constexpr int K_g = DM / 2, KS_g = 128; pg8::DenseOrder S; S.init(T_TOK, DM, DM / 2, ws + OFF_WOUTT, G, bx);
        EpiResBf16 E{INP(0), (bf16_t*)(ws + OFF_X1)};
        if (vcu & 1) { expert_convert(p, lds, vcu, G, XC3, XC4 - XC3); __syncthreads(); }
        pg8::gemm_phase<K_g, KS_g, true>(lds, g, S, E);
        if (!(vcu & 1)) { __syncthreads(); expert_convert(p, lds, vcu, G, XC3, XC4 - XC3); }
        if (PROBE_PH == 6) { GRID_BAR(); pg8::gemm_phase<K_g, KS_g, true>(lds, g, S, E); }
    }
    GRID_BAR();
    if (PROBE_PH == 7) { ln1_route_phase<false>(p, lds, vcu, G); GRID_BAR(); }
    ln1_route_phase<true>(p, lds, vcu, G);
    GRID_BAR();
    for (int rep = 0; rep < (PROBE_PH == 11 ? 2 : 1); ++rep) {
    {
        moe_tables(p, lds);
        pg8::Gemm g{(const char*)(ws + OFF_X1Q)}; constexpr int K_g = DM / 2, KS_g = 128; MoeOrder S; S.init(lds, 4, DM / 2, ws + OFF_WEUPT, (size_t)1024 * DM, (const int*)(ws + OFF_LTOK), true, G, bx);
        EpiUp<false> E{(bf16_t*)(ws + OFF_H), nullptr};
        pg8::gemm_phase<K_g, KS_g, true>(lds, g, S, E);
        if (PROBE_PH == 112) { EpiNull EN; pg8::gemm_phase<K_g, KS_g, true>(lds, g, S, EN); }
    }
    GRID_BAR();
    }
    for (int rep = 0; rep < (PROBE_PH == 12 ? 2 : 1); ++rep) {
    {
        pg8::Gemm g{(const char*)(ws + OFF_H)}; constexpr int K_g = EFF / 2, KS_g = 128; MoeOrder S; S.init(lds, 8, EFF / 2, ws + OFF_WEDT, (size_t)DM * EFF, nullptr, false, G, bx);
        S.lslot = (const int*)(ws + OFF_LSLOT); S.lw = (const float*)(ws + OFF_LW);
        EpiMoeDown E{(unsigned char*)(ws + OFF_YSLOT), lds};
        pg8::gemm_phase<K_g, KS_g, true>(lds, g, S, E);
        if (PROBE_PH == 120) pg8::gemm_phase<K_g, KS_g, true>(lds, g, S, E);
        if (PROBE_PH == 122) { EpiNull EN; pg8::gemm_phase<K_g, KS_g, true>(lds, g, S, EN); }
    }
    GRID_BAR();
    }
    const int tid = opqv(threadIdx.x), lane = tid & 63, gw = vcu * NWAVES + (tid >> 6);
    f32x4 g2v[8], b2v[8];
#pragma unroll
    for (int j = 0; j < 8; ++j) { g2v[j] = ((const f32x4*)INP(29))[lane + 64 * j]; b2v[j] = ((const f32x4*)INP(30))[lane + 64 * j]; }
    for (int rep = 0; rep < (PROBE_PH == 14 ? 2 : 1); ++rep)
    for (int m = gw; m < T_TOK; m += NGW) ln_row<NSLOT>((const bf16_t*)(ws + OFF_X1B) + (size_t)m * DM, ALPHA, (const unsigned char*)(ws + OFF_YSLOT) + (size_t)m * NSLOT * DM, g2v, b2v, p.out + (size_t)m * DM, nullptr, nullptr, lane);
}
extern "C" void kernel_launch(void* const* d_in, const int* in_sizes, int n_in, void* d_out, int out_size, void* d_ws, size_t ws_size, hipStream_t stream) {
    static int grid = 0;
    if (grid == 0) {
        int dev = 0, cus = 0, per_cu = 0;
        (void)hipGetDevice(&dev);
        (void)hipDeviceGetAttribute(&cus, hipDeviceAttributeMultiprocessorCount, dev);
        (void)hipFuncSetAttribute((const void*)mega_fwd, hipFuncAttributeMaxDynamicSharedMemorySize, LDS_BYTES);
        (void)hipOccupancyMaxActiveBlocksPerMultiprocessor(&per_cu, (const void*)mega_fwd, NTHREADS, LDS_BYTES);
        if (per_cu < 1) { fprintf(stderr, "kernel_launch: occupancy query says %d blocks/CU\n", per_cu); }
        grid = cus;
        if (n_in != 31 || ws_size < WS_NEED) { fprintf(stderr, "kernel_launch: n_in %d ws %zu (need %zu): nothing launched\n", n_in, ws_size, (size_t)WS_NEED); grid = -1; }
    }
    if (grid < 0) return;
    if (hipMemsetAsync(d_ws, 0, 65536, stream) != hipSuccess) { fprintf(stderr, "kernel_launch: memset failed\n"); return; }
    Params p{};
    for (int i = 0; i < 31; ++i) p.in[i] = (const float*)d_in[i];
    p.out = (float*)d_out; p.ws = (unsigned char*)d_ws; p.ws_size = ws_size;
    void* args[] = {&p};
    hipError_t e = hipLaunchCooperativeKernel((const void*)mega_fwd, dim3(grid), dim3(NTHREADS), args, LDS_BYTES, stream);
    if (e != hipSuccess) fprintf(stderr, "kernel_launch: cooperative launch failed: %s (grid %d)\n", hipGetErrorString(e), grid);
}
```
